# Optimizing an MI355X kernel written in HIP

```python
import math
import jax, jax.numpy as jnp
from jax import lax
import numpy as np

D_MODEL = 2048
BATCH = 32
SEQ = 256
DEPTH = 4
DEC_BATCH = 2
DEC_SEQ = 4096
PAST_LEN = 256

GRID_W = 64
N_MIXERS = 2
N_FOURIER_LAYERS = (DEPTH + 1) // 2
N_SSM_LAYERS = DEPTH // 2
FOURIER_GROUPS = 8
FOURIER_CH = D_MODEL // FOURIER_GROUPS
SSM_CH = 16
SSM_GROUPS = D_MODEL // SSM_CH
SSM_STATE = 64
N_DIR = 2
D_FF = 5632
N_SUB = 3
N_MOD = 3 * N_SUB
RMS_EPS = 1e-6
DT_MIN = 1e-3
DT_MAX = 1e-1
POS_BASE = 10000.0

kernel_name = 'fnet_s5_macaron_prefix_diffusion_step'


def _rmsnorm(x, g):
    xf = x.astype(jnp.float32)
    y = xf * lax.rsqrt(jnp.mean(xf * xf, axis=-1, keepdims=True) + RMS_EPS)
    return (y * g.astype(jnp.float32)).astype(x.dtype)


def _modulate(x, g, shift, scale):
    return _rmsnorm(x, g) * (1 + scale) + shift


def _swiglu(h, w_in, w_out):
    gu = h @ w_in
    gate, up = jnp.split(gu, 2, axis=-1)
    return (jax.nn.silu(gate) * up) @ w_out


def _fourier_mix(h, w_o):
    b, n, _ = h.shape
    hg = h.astype(jnp.float32).reshape(b, n, FOURIER_GROUPS, FOURIER_CH)
    f = jnp.fft.fft2(hg, axes=(1, 3), norm='ortho').real
    return f.reshape(b, n, D_MODEL).astype(h.dtype) @ w_o


def _diag_scan(a_bar, bu, reverse):
    a = jnp.broadcast_to(a_bar, bu.shape)

    def combine(e1, e2):
        a1, b1 = e1
        a2, b2 = e2
        return a1 * a2, a2 * b1 + b2

    _, s = lax.associative_scan(combine, (a, bu), reverse=reverse, axis=1)
    return s


def _ssm_mix(h, a_re, a_im, log_dt, b_w, c_w, d_w, w_glu, s0):
    b, n, _ = h.shape
    f32 = jnp.float32
    lam = lax.complex(a_re.astype(f32), a_im.astype(f32))
    dt = jnp.exp(log_dt.astype(f32))[..., None]
    a_bar = jnp.exp(lam * dt)
    b_c = lax.complex(b_w[..., 0].astype(f32), b_w[..., 1].astype(f32))
    b_bar = ((a_bar - 1) / lam)[..., None] * b_c
    c_c = lax.complex(c_w[..., 0].astype(f32), c_w[..., 1].astype(f32))
    u = h.astype(f32).reshape(b, n, SSM_GROUPS, SSM_CH)
    y = u * d_w.astype(f32).reshape(SSM_GROUPS, SSM_CH)
    u_c = u.astype(jnp.complex64)
    finals = []
    for k in range(N_DIR):
        reverse = k == 1
        bu = jnp.einsum('bngh,gph->bngp', u_c, b_bar[k])
        if s0 is not None:
            edge = -1 if reverse else 0
            bu = bu.at[:, edge].add(a_bar[k] * s0[:, k])
        s = _diag_scan(a_bar[k], bu, reverse)
        y = y + jnp.einsum('bngp,ghp->bngh', s, c_c[k]).real
        finals.append(s[:, 0] if reverse else s[:, -1])
    g = jax.nn.gelu(y.reshape(b, n, D_MODEL)).astype(h.dtype)
    gv = g @ w_glu
    out = gv[..., :D_MODEL] * jax.nn.sigmoid(gv[..., D_MODEL:])
    return out, jnp.stack(finals, axis=1)


def _grid_pos_embed(n_tokens):
    rows = n_tokens // GRID_W
    f32 = jnp.float32
    r = jnp.broadcast_to(jnp.arange(rows, dtype=f32)[:, None], (rows, GRID_W)).reshape(-1)
    col = jnp.broadcast_to(jnp.arange(GRID_W, dtype=f32)[None, :], (rows, GRID_W)).reshape(-1)
    nf = D_MODEL // 4
    freqs = POS_BASE ** (-jnp.arange(nf, dtype=f32) / nf)
    ar = r[:, None] * freqs
    ac = col[:, None] * freqs
    return jnp.concatenate([jnp.sin(ar), jnp.cos(ar), jnp.sin(ac), jnp.cos(ac)], axis=-1)


def _trunk(x, cond, s0_all, w_ada, b_ada, norm_g, ffn_w_in, ffn_w_out, fourier_w_o,
           ssm_a_re, ssm_a_im, ssm_log_dt, ssm_b, ssm_c, ssm_d, ssm_w_glu, final_g):
    f32 = jnp.float32
    finals = []
    for l in range(DEPTH):
        mod = jax.nn.silu(cond) @ w_ada[l] + b_ada[l]
        mod = mod.reshape(cond.shape[0], N_MOD, 1, D_MODEL)
        h = _modulate(x, norm_g[l, 0], mod[:, 0], mod[:, 1])
        x = x + 0.5 * mod[:, 2] * _swiglu(h, ffn_w_in[l, 0], ffn_w_out[l, 0])
        h = _modulate(x, norm_g[l, 1], mod[:, 3], mod[:, 4])
        k = l // N_MIXERS
        if l % N_MIXERS == 0:
            y = _fourier_mix(h, fourier_w_o[k])
        else:
            if s0_all is None:
                s0 = None
            else:
                s0 = lax.complex(s0_all[:, k, ..., 0].astype(f32), s0_all[:, k, ..., 1].astype(f32))
            y, fin = _ssm_mix(h, ssm_a_re[k], ssm_a_im[k], ssm_log_dt[k], ssm_b[k], ssm_c[k],
                              ssm_d[k], ssm_w_glu[k], s0)
            if s0_all is None:
                finals.append(fin)
        x = x + mod[:, 5] * y
        h = _modulate(x, norm_g[l, 2], mod[:, 6], mod[:, 7])
        x = x + 0.5 * mod[:, 8] * _swiglu(h, ffn_w_in[l, 1], ffn_w_out[l, 1])
    return _rmsnorm(x, final_g), finals


def setup_inputs(seed: int = 0) -> dict:
    key = jax.random.key(seed)
    ks = jax.random.split(key, 20)
    f32 = jnp.float32
    D = D_MODEL
    G, P, H = SSM_GROUPS, SSM_STATE, SSM_CH
    nrm = jax.random.normal
    x_prompt = nrm(ks[0], (BATCH, SEQ, D), f32)
    x_sample = nrm(ks[1], (DEC_BATCH, DEC_SEQ, D), f32)
    state_ssm = 0.1 * nrm(ks[2], (DEC_BATCH, N_SSM_LAYERS, N_DIR, G, P, 2), f32)
    c = nrm(ks[3], (DEC_BATCH, D), f32)
    c_ctx = nrm(ks[4], (D,), f32)
    w_ada = (0.5 * D ** -0.5) * nrm(ks[5], (DEPTH, D, N_MOD * D), f32)
    b_ada = 0.02 * nrm(ks[6], (DEPTH, N_MOD * D), f32)
    norm_g = 1.0 + 0.02 * nrm(ks[7], (DEPTH, N_SUB, D), f32)
    ffn_w_in = (D ** -0.5) * nrm(ks[8], (DEPTH, 2, D, 2 * D_FF), f32)
    ffn_w_out = (D_FF ** -0.5) * nrm(ks[9], (DEPTH, 2, D_FF, D), f32)
    fourier_w_o = (D ** -0.5) * nrm(ks[10], (N_FOURIER_LAYERS, D, D), f32)
    ssm_a_re = -0.5 + 0.01 * nrm(ks[11], (N_SSM_LAYERS, N_DIR, G, P), f32)
    ssm_a_im = math.pi * jnp.arange(P, dtype=f32) + 0.01 * nrm(ks[12], (N_SSM_LAYERS, N_DIR, G, P), f32)
    ssm_log_dt = jax.random.uniform(ks[13], (N_SSM_LAYERS, N_DIR, G), f32,
                                    minval=math.log(DT_MIN), maxval=math.log(DT_MAX))
    ssm_b = ((2 * H) ** -0.5) * nrm(ks[14], (N_SSM_LAYERS, N_DIR, G, P, H, 2), f32)
    ssm_c = (P ** -0.5) * nrm(ks[15], (N_SSM_LAYERS, N_DIR, G, H, P, 2), f32)
    ssm_d = nrm(ks[16], (N_SSM_LAYERS, D), f32)
    ssm_w_glu = (D ** -0.5) * nrm(ks[17], (N_SSM_LAYERS, D, 2 * D), f32)
    final_g = 1.0 + 0.02 * nrm(ks[18], (D,), f32)
    return {'x_prompt': x_prompt, 'x_sample': x_sample, 'state_ssm': state_ssm, 'c': c, 'c_ctx': c_ctx,
            'w_ada': w_ada, 'b_ada': b_ada, 'norm_g': norm_g, 'ffn_w_in': ffn_w_in, 'ffn_w_out': ffn_w_out,
            'fourier_w_o': fourier_w_o, 'ssm_a_re': ssm_a_re, 'ssm_a_im': ssm_a_im, 'ssm_log_dt': ssm_log_dt,
            'ssm_b': ssm_b, 'ssm_c': ssm_c, 'ssm_d': ssm_d, 'ssm_w_glu': ssm_w_glu, 'final_g': final_g}


def reference(x_prompt, x_sample, state_ssm, c, c_ctx, w_ada, b_ada, norm_g, ffn_w_in, ffn_w_out,
              fourier_w_o, ssm_a_re, ssm_a_im, ssm_log_dt, ssm_b, ssm_c, ssm_d, ssm_w_glu, final_g):
    y_prompt, ctx_finals = _trunk(x_prompt, c_ctx[None, :], None, w_ada, b_ada, norm_g, ffn_w_in,
                                  ffn_w_out, fourier_w_o, ssm_a_re, ssm_a_im, ssm_log_dt, ssm_b,
                                  ssm_c, ssm_d, ssm_w_glu, final_g)
    fin = jnp.stack(ctx_finals, axis=1)
    new_state_ssm = jnp.stack([fin.real, fin.imag], axis=-1)
    n_lat = x_sample.shape[1]
    xs = x_sample + _grid_pos_embed(n_lat).astype(x_sample.dtype)
    y_sample, _ = _trunk(xs, c, state_ssm, w_ada, b_ada, norm_g, ffn_w_in, ffn_w_out, fourier_w_o,
                         ssm_a_re, ssm_a_im, ssm_log_dt, ssm_b, ssm_c, ssm_d, ssm_w_glu, final_g)
    return (y_prompt, y_sample, new_state_ssm)
```

```cpp
#include <hip/hip_runtime.h>
#include <cstdio>
#include <cstdint>

#define LAS __attribute__((address_space(3)))
#define GAS __attribute__((address_space(1)))
typedef _Float16 f16;
typedef _Float16 f16x8 __attribute__((ext_vector_type(8)));
typedef _Float16 f16x4 __attribute__((ext_vector_type(4)));
typedef _Float16 f16x2 __attribute__((ext_vector_type(2)));
typedef float f32x4 __attribute__((ext_vector_type(4)));
typedef float f32x2 __attribute__((ext_vector_type(2)));
typedef unsigned u32x4 __attribute__((ext_vector_type(4)));
typedef unsigned u32x2 __attribute__((ext_vector_type(2)));

constexpr int D = 2048, DFF = 5632, MTOK = 16384, NPROMPT = 8192, SEQ_P = 256, SEQ_S = 4096, NB_P = 32, NB_S = 2;
constexpr int DEPTH = 4, NMOD = 9, SSM_G = 128, SSM_P = 64, SSM_H = 16;
constexpr float RMS_EPS = 1e-6f;
constexpr int NWAVES = 8, NTHR = 512;

constexpr size_t MiB = 1u << 20;
constexpr size_t WS_CTL = 0, CTL_ZERO_BYTES = 1 * MiB;
constexpr size_t WS_MOD = 1 * MiB;
constexpr size_t WS_MODP = 2 * MiB;
constexpr size_t WS_AL = 18 * MiB;
constexpr size_t WS_W2T = 19 * MiB;
constexpr size_t WS_CS256 = 19 * MiB + 512 * 1024;
constexpr size_t WS_CS4096 = 20 * MiB;
constexpr size_t WS_W1 = 84 * MiB;
constexpr size_t WS_TW = 116 * MiB;
constexpr size_t WS_WO = 180 * MiB;
constexpr size_t WS_WGLU = 196 * MiB;
constexpr size_t WS_WIN = 228 * MiB;
constexpr size_t WS_WOUT = 580 * MiB;
constexpr size_t WS_H = 756 * MiB;
constexpr size_t WS_ACT = 820 * MiB;
constexpr size_t WS_HT = 820 * MiB;
constexpr size_t WS_F = 948 * MiB;
constexpr size_t WS_S = 820 * MiB;
constexpr size_t WS_CC = 948 * MiB;
constexpr size_t WS_G = 1012 * MiB;
constexpr size_t WS_END = 1076 * MiB;
constexpr int CW_BAR = 4096;

constexpr int STAGE_BYTES = 131072;
constexpr int MISC_OFF = STAGE_BYTES;
constexpr int LDS_BYTES = 147456;

namespace pg8 {
constexpr int BM = 256, BK = 64, HALF = 128, HTB = HALF * BK * 2, NXCD = 8, WGM = 8;
__host__ __device__ __forceinline__ int lds_byte(int r, int c) { const int st = (r >> 4) * 2 + (c >> 5), rr = r & 15, cc = c & 31, ob = rr * 64 + cc * 2; return st * 1024 + (ob ^ (((ob >> 9) & 1) << 5)); }
__host__ __device__ __forceinline__ void stage_rc(int b, int& R, int& C) { const int st = b / 1024, sb = b % 1024, swz = sb ^ (((sb >> 9) & 1) << 5); R = (st >> 1) * 16 + swz / 64; C = (st & 1) * 32 + (swz % 64) / 2; }
__host__ __device__ __forceinline__ int perm32(int rho) { const int n = rho >> 4, i = rho & 15; return 8 * (i >> 2) + 4 * n + (i & 3); }

struct Unit { int pm, pn, z; };

template <bool CHUNK> struct Prob {
    const char* A; const char* A2; const char* B; int nt, ksplit; unsigned lda2, ldb2; size_t a_t, a_z, b_t, b_z; unsigned a_k, b_k;
    __device__ __forceinline__ const char* a_ptr(const Unit& u, int t) const { const char* p = (t < ksplit) ? A + (size_t)t * a_k : A2 + (size_t)(t - ksplit) * a_k; return p + (size_t)u.pm * a_t + (size_t)u.z * a_z; }
    __device__ __forceinline__ const char* b_ptr(const Unit& u, int t) const { return B + (size_t)t * b_k + (size_t)u.pn * b_t + (size_t)u.z * b_z; }
    __device__ __forceinline__ unsigned a_off(int R, int C) const { return CHUNK ? (unsigned)R * lda2 + (unsigned)(C >> 4) * 4096u + (unsigned)(C & 15) * 2u : (unsigned)R * lda2 + (unsigned)C * 2u; }
    __device__ __forceinline__ unsigned b_off(int R, int C) const { return (unsigned)R * ldb2 + (unsigned)C * 2u; }
};

struct StaticOrder {
    int nM, nN, nwg, G, c;
    __device__ void init(int M, int N, int G_, int c_) { nM = M / BM; nN = N / BM; nwg = nM * nN; G = G_; c = c_; }
    __device__ bool next(int i, Unit& u) const {
        const long L = (long)i * G + c; if (L >= nwg) return false;
        int wgid = (int)L; { const int q = nwg / NXCD, r = nwg % NXCD, xcd = wgid % NXCD, off = wgid / NXCD; wgid = (xcd < r ? xcd * (q + 1) : r * (q + 1) + (xcd - r) * q) + off; }
        const int nig = WGM * nN, gid = wgid / nig, fm = gid * WGM, gsz = (nM - fm) < WGM ? (nM - fm) : WGM;
        u.pm = fm + ((wgid % nig) % gsz); u.pn = (wgid % nig) / gsz; u.z = 0; return true;
    }
};

template <class P, class Epi, class Sched, bool ALIGN_EPI, bool SP2>
__device__ __forceinline__ void gemm_phase(LAS unsigned char* lds, const P& p, const Sched& S, const Epi& E) {
    int tid_ = threadIdx.x; asm volatile("" : "+v"(tid_));
    const int tid = tid_, wid = __builtin_amdgcn_readfirstlane(tid >> 6), lane = tid & 63, wr = wid >> 2, wc = wid & 3, fr = lane & 15, fq = lane >> 4;
    int nt = p.nt; asm volatile("" : "+s"(nt));
    unsigned voffA[2], voffB[2];
#pragma unroll
    for (int i = 0; i < 2; ++i) { int R, C; stage_rc(tid * 16 + i * 8192, R, C); const int Rb = Epi::PERM ? ((R & ~31) + perm32(R & 31)) : R;
        voffA[i] = p.a_off(R, C); voffB[i] = p.b_off(Rb, C); }
    const size_t ahs = (size_t)HALF * p.lda2, bhs = (size_t)HALF * p.ldb2;
    const unsigned ldsw = (unsigned)wid * 1024u;
    const int aoff = lds_byte(wr * 64 + fr, fq * 8), boff = lds_byte(wc * 32 + fr, fq * 8);
#define PG8_SA(b, h) (((b) * 2 + (h)) * HTB)
#define PG8_SB(b, h) ((4 + (b) * 2 + (h)) * HTB)
#define PG8_STAGE(bufoff, gbase, voff) do { _Pragma("unroll") for (int _i = 0; _i < 2; ++_i) \
        __builtin_amdgcn_global_load_lds((const unsigned*)((const char*)(gbase) + (voff)[_i]), (LAS unsigned*)(lds + (bufoff) + ldsw + _i * 8192), 16, 0, 0); } while (0)
#define PG8_LDA(dst, b, h) do { _Pragma("unroll") for (int m = 0; m < 4; ++m) _Pragma("unroll") for (int k = 0; k < 2; ++k) dst[m][k] = *(const LAS f16x8*)(lds + PG8_SA(b, h) + aoff + m * 2048 + k * 1024); } while (0)
#define PG8_LDB(dst, b, h) do { _Pragma("unroll") for (int n = 0; n < 2; ++n) _Pragma("unroll") for (int k = 0; k < 2; ++k) dst[n][k] = *(const LAS f16x8*)(lds + PG8_SB(b, h) + boff + n * 2048 + k * 1024); } while (0)
#define PG8_MMA(ai, bj, At, Bt) do { __builtin_amdgcn_s_setprio(1); _Pragma("unroll") for (int m = 0; m < 4; ++m) _Pragma("unroll") for (int n = 0; n < 2; ++n) _Pragma("unroll") for (int k = 0; k < 2; ++k) \
        acc[ai][bj][m][n] = __builtin_amdgcn_mfma_f32_16x16x32_f16(Bt[n][k], At[m][k], acc[ai][bj][m][n], 0, 0, 0); __builtin_amdgcn_s_setprio(0); } while (0)
#define PG8_WAIT_V(n) asm volatile("s_waitcnt vmcnt(" #n ")" ::: "memory")
#define PG8_WAIT_L(n) asm volatile("s_waitcnt lgkmcnt(" #n ")" ::: "memory")
#define PG8_BAR __builtin_amdgcn_s_barrier()
#define PG8_SCHED __builtin_amdgcn_sched_barrier(0)
    Unit cur, nxt; int ui = 0;
    if (!S.next(0, cur)) return;
    f32x4 acc[2][2][4][2];
#pragma unroll
    for (int a = 0; a < 2; ++a)
#pragma unroll
        for (int b = 0; b < 2; ++b)
#pragma unroll
            for (int m = 0; m < 4; ++m)
#pragma unroll
                for (int n = 0; n < 2; ++n) acc[a][b][m][n] = (f32x4){0.f, 0.f, 0.f, 0.f};
    f16x8 At[4][2], B0[2][2], B1[2][2];
    {
        const char* cA0 = p.a_ptr(cur, 0); const char* cB0 = p.b_ptr(cur, 0); const char* cA1 = p.a_ptr(cur, 1); const char* cB1 = p.b_ptr(cur, 1);
        if constexpr (SP2) {
            PG8_STAGE(PG8_SB(0, 0), cB0, voffB); PG8_STAGE(PG8_SB(0, 1), cB0 + bhs, voffB); PG8_STAGE(PG8_SA(0, 0), cA0, voffA); PG8_STAGE(PG8_SA(0, 1), cA0 + ahs, voffA);
            if (wr == 1) PG8_BAR;
            PG8_WAIT_V(2); PG8_BAR;
            PG8_STAGE(PG8_SB(1, 0), cB1, voffB); PG8_STAGE(PG8_SA(1, 0), cA1, voffA); PG8_STAGE(PG8_SB(1, 1), cB1 + bhs, voffB);
            PG8_WAIT_V(6); PG8_BAR;
        } else {
            PG8_STAGE(PG8_SB(0, 0), cB0, voffB); PG8_STAGE(PG8_SA(0, 0), cA0, voffA); PG8_STAGE(PG8_SB(0, 1), cB0 + bhs, voffB); PG8_STAGE(PG8_SA(0, 1), cA0 + ahs, voffA);
            if (wr == 1) PG8_BAR;
            PG8_WAIT_V(4); PG8_BAR;
            PG8_STAGE(PG8_SB(1, 0), cB1, voffB); PG8_STAGE(PG8_SA(1, 0), cA1, voffA); PG8_STAGE(PG8_SB(1, 1), cB1 + bhs, voffB);
            PG8_WAIT_V(6); PG8_BAR;
        }
    }
    for (;;) {
        const bool has_next = S.next(ui + 1, nxt);
        const Unit nu = has_next ? nxt : cur;
#pragma nounroll
        for (int t = 0; t < nt; t += 2) {
            const bool last = (t == nt - 2);
            const char* a1 = p.a_ptr(cur, t + 1);
            const char* a2 = last ? p.a_ptr(nu, 0) : p.a_ptr(cur, t + 2); const char* b2 = last ? p.b_ptr(nu, 0) : p.b_ptr(cur, t + 2);
            const char* a3 = last ? p.a_ptr(nu, 1) : p.a_ptr(cur, t + 3); const char* b3 = last ? p.b_ptr(nu, 1) : p.b_ptr(cur, t + 3);
            if constexpr (SP2) {
            PG8_LDB(B0, 0, 0); PG8_LDB(B1, 0, 1); PG8_SCHED; PG8_LDA(At, 0, 0); PG8_STAGE(PG8_SA(1, 1), a1 + ahs, voffA);
            PG8_WAIT_V(8); PG8_WAIT_L(0); PG8_BAR; PG8_MMA(0, 0, At, B0); PG8_MMA(0, 1, At, B1); PG8_BAR; PG8_SCHED;
            PG8_LDA(At, 0, 1); PG8_STAGE(PG8_SB(0, 0), b2, voffB); PG8_STAGE(PG8_SB(0, 1), b2 + bhs, voffB); PG8_STAGE(PG8_SA(0, 0), a2, voffA);
            PG8_WAIT_V(8); PG8_WAIT_L(0); PG8_BAR; PG8_MMA(1, 0, At, B0); PG8_MMA(1, 1, At, B1); PG8_BAR; PG8_SCHED;
            PG8_LDB(B0, 1, 0); PG8_LDB(B1, 1, 1); PG8_SCHED; PG8_LDA(At, 1, 0); PG8_STAGE(PG8_SA(0, 1), a2 + ahs, voffA);
            PG8_WAIT_V(8); PG8_WAIT_L(0); PG8_BAR; PG8_MMA(0, 0, At, B0); PG8_MMA(0, 1, At, B1); PG8_BAR; PG8_SCHED;
            PG8_LDA(At, 1, 1); PG8_STAGE(PG8_SB(1, 0), b3, voffB); PG8_STAGE(PG8_SB(1, 1), b3 + bhs, voffB); PG8_STAGE(PG8_SA(1, 0), a3, voffA);
            PG8_WAIT_V(8); PG8_WAIT_L(0); PG8_BAR; PG8_MMA(1, 0, At, B0); PG8_MMA(1, 1, At, B1); PG8_BAR; PG8_SCHED;
            } else {
            PG8_LDB(B0, 0, 0); PG8_SCHED; PG8_LDA(At, 0, 0); PG8_STAGE(PG8_SA(1, 1), a1 + ahs, voffA);
            PG8_WAIT_L(8); PG8_BAR; PG8_WAIT_L(0); PG8_MMA(0, 0, At, B0); PG8_BAR; PG8_SCHED;
            PG8_LDB(B1, 0, 1); PG8_STAGE(PG8_SB(0, 0), b2, voffB);
            PG8_BAR; PG8_WAIT_L(0); PG8_MMA(0, 1, At, B1); PG8_BAR;
            PG8_LDA(At, 0, 1); PG8_STAGE(PG8_SA(0, 0), a2, voffA);
            PG8_BAR; PG8_WAIT_L(0); PG8_MMA(1, 0, At, B0); PG8_BAR; PG8_SCHED;
            PG8_STAGE(PG8_SB(0, 1), b2 + bhs, voffB);
            PG8_WAIT_V(6); PG8_BAR; PG8_MMA(1, 1, At, B1); PG8_BAR;
            PG8_LDB(B0, 1, 0); PG8_SCHED; PG8_LDA(At, 1, 0); PG8_STAGE(PG8_SA(0, 1), a2 + ahs, voffA);
            PG8_WAIT_L(8); PG8_BAR; PG8_WAIT_L(0); PG8_MMA(0, 0, At, B0); PG8_BAR; PG8_SCHED;
            PG8_LDB(B1, 1, 1); PG8_STAGE(PG8_SB(1, 0), b3, voffB);
            PG8_BAR; PG8_WAIT_L(0); PG8_MMA(0, 1, At, B1); PG8_BAR;
            PG8_LDA(At, 1, 1); PG8_STAGE(PG8_SA(1, 0), a3, voffA);
            PG8_BAR; PG8_WAIT_L(0); PG8_MMA(1, 0, At, B0); PG8_BAR; PG8_SCHED;
            PG8_STAGE(PG8_SB(1, 1), b3 + bhs, voffB);
            PG8_WAIT_V(6); PG8_BAR; PG8_MMA(1, 1, At, B1); PG8_BAR;
            }
        }
        if constexpr (ALIGN_EPI) { if (wr == 0) PG8_BAR; }
        E(acc, cur, wr, wc, fr, fq);
        if (!has_next) break;
#pragma unroll
        for (int a = 0; a < 2; ++a)
#pragma unroll
            for (int b = 0; b < 2; ++b)
#pragma unroll
                for (int m = 0; m < 4; ++m)
#pragma unroll
                    for (int n = 0; n < 2; ++n) acc[a][b][m][n] = (f32x4){0.f, 0.f, 0.f, 0.f};
        cur = nxt; ++ui;
        if constexpr (ALIGN_EPI) { if (wr == 1) PG8_BAR; }
    }
    PG8_WAIT_V(0);
    if constexpr (!ALIGN_EPI) { if (wr == 0) PG8_BAR; }
    PG8_BAR;
#undef PG8_SA
#undef PG8_SB
#undef PG8_STAGE
#undef PG8_LDA
#undef PG8_LDB
#undef PG8_MMA
#undef PG8_WAIT_V
#undef PG8_WAIT_L
#undef PG8_BAR
#undef PG8_SCHED
}
}
using pg8::Unit;

#define RLX_AGENT __ATOMIC_RELAXED, __HIP_MEMORY_SCOPE_AGENT
#define LDS_WAIT() asm volatile("s_waitcnt lgkmcnt(0)" ::: "memory")
#define VM_WAIT() asm volatile("s_waitcnt vmcnt(0)" ::: "memory")
__device__ __forceinline__ unsigned pk2h(float lo, float hi) { f32x2 v = {lo, hi}; f16x2 h = __builtin_convertvector(v, f16x2); return __builtin_bit_cast(unsigned, h); }
__device__ __forceinline__ float wave_sum(float v, int lane) {
#pragma unroll
    for (int o = 1; o < 64; o <<= 1) v += __builtin_bit_cast(float, __builtin_amdgcn_ds_bpermute((lane ^ o) << 2, __builtin_bit_cast(int, v)));
    return v;
}
__device__ __forceinline__ float sigmoid_f(float x) { return __builtin_amdgcn_rcpf(1.0f + __builtin_amdgcn_exp2f(-1.4426950408889634f * x)); }
__device__ __forceinline__ float gelu_tanh_f(float x) {
    const float u2 = 1.5957691216057308f * (x + 0.044715f * x * x * x);
    return x * sigmoid_f(u2);
}
__device__ __forceinline__ int cond_of_panel(int pm) { return pm < 32 ? 0 : (pm < 48 ? 1 : 2); }

#define XB_TMO      128
#define XB_XCNT(j)  (256  + 64 * (j))
#define XB_XSUB(j)  (1280 + 64 * (j))
#define XB_XGEN(j)  (2304 + 64 * (j))
#define XB_TOP      3328
#define XB_TOPGEN   3392
#define XCD_BAR_WORDS 3456
#define XB_SPIN_CAP (1u << 18)
__device__ __forceinline__ unsigned xb_ld(unsigned* p)              { return __hip_atomic_load(p, __ATOMIC_RELAXED, __HIP_MEMORY_SCOPE_AGENT); }
__device__ __forceinline__ unsigned xb_add(unsigned* p, unsigned v) { return __hip_atomic_fetch_add(p, v, __ATOMIC_RELAXED, __HIP_MEMORY_SCOPE_AGENT); }
__device__ __forceinline__ unsigned xb_xcc_id() { return (unsigned)__builtin_amdgcn_s_getreg((3 << 11) | 20) & 0xFu; }
#define XB_SPIN(cond, bar) do { unsigned _sp = 0; while (cond) { __builtin_amdgcn_s_sleep(1); \
    if ((++_sp & 255u) == 0u) { if (xb_ld(&(bar)[XB_TMO])) break; if (_sp > XB_SPIN_CAP) { atomicAdd(&(bar)[XB_TMO], 1u); break; } } } } while (0)
struct XcdBarrier { unsigned* bar; unsigned x; volatile LAS unsigned* st; };
__device__ __forceinline__ XcdBarrier xcd_barrier_post(unsigned* bar, volatile LAS unsigned* st) {
    XcdBarrier b; b.bar = bar; b.x = xb_xcc_id(); b.st = st;
    if (threadIdx.x == 0) (void)xb_add(&bar[XB_XCNT(b.x)], 1u);
    return b;
}
__device__ __forceinline__ void xcd_barrier_complete(unsigned* bar, unsigned x, unsigned& nloc, unsigned& nx) {
    const unsigned G = gridDim.x * gridDim.y * gridDim.z;
    unsigned sum, cnt, mine, sp = 0u;
    for (;;) {
        sum = 0u; cnt = 0u; mine = 0u;
#pragma unroll
        for (unsigned j = 0; j < 16; ++j) { const unsigned c = xb_ld(&bar[XB_XCNT(j)]); sum += c; cnt += (c > 0u) ? 1u : 0u; mine = (j == x) ? c : mine; }
        if (sum == G) break;
        __builtin_amdgcn_s_sleep(1);
        if ((++sp & 255u) == 0u) { if (xb_ld(&bar[XB_TMO])) break; if (sp > XB_SPIN_CAP) { atomicAdd(&bar[XB_TMO], 1u); break; } }
    }
    nloc = mine > 0u ? mine : 1u; nx = cnt > 0u ? cnt : 1u;
}
__device__ __forceinline__ void xcd_barrier(const XcdBarrier& b) {
    asm volatile("s_waitcnt vmcnt(0)" ::: "memory");
    __syncthreads();
    if (threadIdx.x == 0) {
        unsigned* bar = b.bar;
        __builtin_amdgcn_s_waitcnt(0);
        unsigned nloc = b.st[0], nx = b.st[1];
        if (nloc == 0u) { xcd_barrier_complete(bar, b.x, nloc, nx); b.st[0] = nloc; b.st[1] = nx; }
        const unsigned old = xb_add(&bar[XB_XSUB(b.x)], 1u);
        const unsigned gen = old / nloc;
        if (old + 1u == (gen + 1u) * nloc) {
            __builtin_amdgcn_fence(__ATOMIC_RELEASE, "agent");
            asm volatile("s_waitcnt vmcnt(0)" ::: "memory");
            const unsigned og = xb_add(&bar[XB_TOP], 1u);
            const unsigned tg = og / nx;
            if (og + 1u == (tg + 1u) * nx) xb_add(&bar[XB_TOPGEN], 1u);
            else XB_SPIN(xb_ld(&bar[XB_TOPGEN]) == tg, bar);
            __builtin_amdgcn_fence(__ATOMIC_ACQUIRE, "agent");
            xb_add(&bar[XB_XGEN(b.x)], 1u);
            asm volatile("s_waitcnt vmcnt(0)" ::: "memory");
        } else {
            XB_SPIN(xb_ld(&bar[XB_XGEN(b.x)]) == gen, bar);
            __builtin_amdgcn_fence(__ATOMIC_ACQUIRE, "agent");
            asm volatile("s_waitcnt vmcnt(0)" ::: "memory");
        }
    }
    __syncthreads();
}

struct Args {
    const float* x_prompt; const float* x_sample; const float* state_ssm; const float* c; const float* c_ctx;
    const float* w_ada; const float* b_ada; const float* norm_g; const float* ffn_w_in; const float* ffn_w_out;
    const float* fourier_w_o; const float* ssm_a_re; const float* ssm_a_im; const float* ssm_log_dt;
    const float* ssm_b; const float* ssm_c; const float* ssm_d; const float* ssm_w_glu; const float* final_g;
    float* out; unsigned char* ws; int ph_lo, ph_hi;
};
struct Frame {
    LAS unsigned char* lds; int tid, lane, wave, vcu, G, bx;
};

struct EpiSwiGLU {
    static constexpr bool PERM = true;
    f16* O;
    __device__ __forceinline__ void operator()(const f32x4 (&acc)[2][2][4][2], const Unit& u, int wr, int wc, int fr, int fq) const {
        const int row0 = u.pm * 256 + wr * 64 + fr, col0 = u.pn * 128 + wc * 32 + 8 * fq;
#pragma unroll
        for (int ai = 0; ai < 2; ++ai)
#pragma unroll
            for (int m = 0; m < 4; ++m) {
                const f32x4 g0 = acc[ai][0][m][0], g1 = acc[ai][0][m][1], u0 = acc[ai][1][m][0], u1 = acc[ai][1][m][1];
                float r[8];
#pragma unroll
                for (int j = 0; j < 4; ++j) { r[j] = g0[j] * sigmoid_f(g0[j]) * u0[j]; r[4 + j] = g1[j] * sigmoid_f(g1[j]) * u1[j]; }
                u32x4 w; w.x = pk2h(r[0], r[1]); w.y = pk2h(r[2], r[3]); w.z = pk2h(r[4], r[5]); w.w = pk2h(r[6], r[7]);
                *(u32x4*)(O + (size_t)(row0 + ai * 128 + m * 16) * DFF + col0) = w;
            }
    }
};
struct EpiResid {
    static constexpr bool PERM = false;
    float* X; const float* modv; float coef;
    __device__ __forceinline__ void operator()(const f32x4 (&acc)[2][2][4][2], const Unit& u, int wr, int wc, int fr, int fq) const {
        const int row0 = u.pm * 256 + wr * 64 + fr, col0 = u.pn * 256 + wc * 32 + 4 * fq;
        const float* mv = modv + (size_t)cond_of_panel(u.pm) * (NMOD * D) + col0;
        f32x4 gv[2][2];
#pragma unroll
        for (int bj = 0; bj < 2; ++bj)
#pragma unroll
            for (int n = 0; n < 2; ++n) gv[bj][n] = *(const f32x4*)(mv + bj * 128 + n * 16) * coef;
#pragma unroll
        for (int ai = 0; ai < 2; ++ai)
#pragma unroll
            for (int m = 0; m < 4; ++m) { float* rowp = X + (size_t)(row0 + ai * 128 + m * 16) * D + col0;
#pragma unroll
                for (int bj = 0; bj < 2; ++bj)
#pragma unroll
                    for (int n = 0; n < 2; ++n) { f32x4* q = (f32x4*)(rowp + bj * 128 + n * 16); *q = *q + gv[bj][n] * acc[ai][bj][m][n]; } }
    }
};
struct EpiGLUResid {
    static constexpr bool PERM = true;
    float* X; const float* modv;
    __device__ __forceinline__ void operator()(const f32x4 (&acc)[2][2][4][2], const Unit& u, int wr, int wc, int fr, int fq) const {
        const int row0 = u.pm * 256 + wr * 64 + fr, col0 = u.pn * 128 + wc * 32 + 8 * fq;
        const float* mv = modv + (size_t)cond_of_panel(u.pm) * (NMOD * D) + col0;
        const f32x4 m0 = *(const f32x4*)mv, m1 = *(const f32x4*)(mv + 4);
#pragma unroll
        for (int ai = 0; ai < 2; ++ai)
#pragma unroll
            for (int m = 0; m < 4; ++m) { float* rowp = X + (size_t)(row0 + ai * 128 + m * 16) * D + col0;
                const f32x4 v0 = acc[ai][0][m][0], v1 = acc[ai][0][m][1], g0 = acc[ai][1][m][0], g1 = acc[ai][1][m][1];
                f32x4 o0, o1;
#pragma unroll
                for (int j = 0; j < 4; ++j) { o0[j] = v0[j] * sigmoid_f(g0[j]); o1[j] = v1[j] * sigmoid_f(g1[j]); }
                f32x4* q = (f32x4*)rowp; q[0] = q[0] + m0 * o0; q[1] = q[1] + m1 * o1; }
    }
};
struct EpiFA {
    static constexpr bool PERM = true;
    f16* HT;
    __device__ __forceinline__ void operator()(const f32x4 (&acc)[2][2][4][2], const Unit& u, int wr, int wc, int fr, int fq) const {
        const int P = u.pn; const int n = P < 32 ? SEQ_P : SEQ_S;
        const size_t hb = P < 32 ? (size_t)P * (D * 2 * SEQ_P) : (size_t)NB_P * (D * 2 * SEQ_P) + (size_t)((P - 32) >> 4) * ((size_t)D * 2 * SEQ_S);
        const int t0 = (P < 32 ? 0 : ((P - 32) & 15) * 256) + wc * 32 + 8 * fq;
        const int q0 = wr * 64 + fr;
#pragma unroll
        for (int ai = 0; ai < 2; ++ai)
#pragma unroll
            for (int m = 0; m < 4; ++m) { const int q = q0 + ai * 128 + m * 16;
                f16* rowp = HT + hb + ((size_t)(u.z * 256 + q) * 2 + u.pm) * n + t0;
#pragma unroll
                for (int bj = 0; bj < 2; ++bj) { const f32x4 v0 = acc[ai][bj][m][0], v1 = acc[ai][bj][m][1];
                    u32x4 w; w.x = pk2h(v0[0], v0[1]); w.y = pk2h(v0[2], v0[3]); w.z = pk2h(v1[0], v1[1]); w.w = pk2h(v1[2], v1[3]);
                    *(u32x4*)(rowp + bj * 128) = w; } }
    }
};
struct EpiFB {
    static constexpr bool PERM = true;
    f16* F; int row0, zrows; float scale;
    __device__ __forceinline__ void operator()(const f32x4 (&acc)[2][2][4][2], const Unit& u, int wr, int wc, int fr, int fq) const {
        const int r0 = row0 + u.z * zrows + u.pm * 256 + wr * 64 + fr, col0 = u.pn * 256 + wc * 32 + 8 * fq;
#pragma unroll
        for (int ai = 0; ai < 2; ++ai)
#pragma unroll
            for (int m = 0; m < 4; ++m) { f16* rowp = F + (size_t)(r0 + ai * 128 + m * 16) * D + col0;
#pragma unroll
                for (int bj = 0; bj < 2; ++bj) { const f32x4 v0 = acc[ai][bj][m][0] * scale, v1 = acc[ai][bj][m][1] * scale;
                    u32x4 w; w.x = pk2h(v0[0], v0[1]); w.y = pk2h(v0[2], v0[3]); w.z = pk2h(v1[0], v1[1]); w.w = pk2h(v1[2], v1[3]);
                    *(u32x4*)(rowp + bj * 128) = w; } }
    }
};
struct EpiS1 {
    static constexpr bool PERM = false;
    float* S;
    __device__ __forceinline__ void operator()(const f32x4 (&acc)[2][2][4][2], const Unit& u, int wr, int wc, int fr, int fq) const {
        const int r0 = u.pm * 256 + wr * 64 + fr, col0 = wc * 32 + 4 * fq;
#pragma unroll
        for (int ai = 0; ai < 2; ++ai)
#pragma unroll
            for (int m = 0; m < 4; ++m) { float* rowp = S + ((size_t)(r0 + ai * 128 + m * 16) * SSM_G + u.z) * 256 + col0;
#pragma unroll
                for (int bj = 0; bj < 2; ++bj)
#pragma unroll
                    for (int n = 0; n < 2; ++n) *(f32x4*)(rowp + bj * 128 + n * 16) = acc[ai][bj][m][n]; }
    }
};
struct EpiS3 {
    static constexpr bool PERM = true;
    f16* Gm;
    __device__ __forceinline__ void operator()(const f32x4 (&acc)[2][2][4][2], const Unit& u, int wr, int wc, int fr, int fq) const {
        const int r0 = u.pm * 256 + wr * 64 + fr;
#pragma unroll
        for (int ai = 0; ai < 2; ++ai)
#pragma unroll
            for (int m = 0; m < 4; ++m) { const int r = r0 + ai * 128 + m * 16;
#pragma unroll
                for (int bj = 0; bj < 2; ++bj) { const int np = bj * 128 + wc * 32 + 8 * fq; const int j = np >> 4, h0 = np & 15;
                    const f32x4 v0 = acc[ai][bj][m][0], v1 = acc[ai][bj][m][1];
                    float rr[8];
#pragma unroll
                    for (int k = 0; k < 4; ++k) { rr[k] = gelu_tanh_f(v0[k]); rr[4 + k] = gelu_tanh_f(v1[k]); }
                    u32x4 w; w.x = pk2h(rr[0], rr[1]); w.y = pk2h(rr[2], rr[3]); w.z = pk2h(rr[4], rr[5]); w.w = pk2h(rr[6], rr[7]);
                    *(u32x4*)(Gm + (size_t)(r * 16 + j) * D + u.z * 16 + h0) = w; } }
    }
};

struct SchedFA {
    int vcu;
    __device__ bool next(int i, Unit& u) const { const int idx = i * 256 + vcu; if (idx >= 1024) return false; u.pm = idx & 1; u.z = (idx >> 1) & 7; u.pn = idx >> 4; return true; }
};
struct SchedFBs {
    int vcu;
    __device__ bool next(int i, Unit& u) const { if (i > 0) return false; u.z = vcu >> 7; u.pm = (vcu >> 3) & 15; u.pn = vcu & 7; return true; }
};
struct SchedFBp {
    int vcu;
    __device__ bool next(int i, Unit& u) const { if (i > 0) return false; u.z = vcu >> 3; u.pm = 0; u.pn = vcu & 7; return true; }
};
struct SchedS {
    int vcu;
    __device__ bool next(int i, Unit& u) const { const int idx = i * 256 + vcu; if (idx >= 512) return false; u.pm = idx & 3; u.z = idx >> 2; u.pn = 0; return true; }
};

__device__ __forceinline__ void transpose_item(const float* W, int K, int N, f16* WT, int half, LAS float* scr, int item, int lane) {
    const int nblk = N / 32, kb = item / nblk, nb = item % nblk, k0 = 64 * kb, n0 = 32 * nb;
    int d0 = n0;
    if (half > 0) { const int bj = n0 / half, rem = n0 % half; d0 = (rem / 128) * 256 + bj * 128 + (rem % 128); }
#pragma unroll 8
    for (int i = 0; i < 32; ++i) { const int kk = 2 * i + (lane >> 5); scr[kk * 33 + (lane & 31)] = W[(size_t)(k0 + kk) * N + n0 + (lane & 31)]; }
    LDS_WAIT(); asm volatile("" ::: "memory");
    const int c = lane & 7;
#pragma unroll
    for (int j = 0; j < 4; ++j) { const int n = (lane >> 3) + 8 * j; const LAS float* s = scr + (8 * c) * 33 + n;
        u32x4 o; o.x = pk2h(s[0 * 33], s[1 * 33]); o.y = pk2h(s[2 * 33], s[3 * 33]); o.z = pk2h(s[4 * 33], s[5 * 33]); o.w = pk2h(s[6 * 33], s[7 * 33]);
        *(u32x4*)(WT + (size_t)(d0 + n) * K + k0 + 8 * c) = o; }
    LDS_WAIT(); asm volatile("" ::: "memory");
}

__device__ __forceinline__ void ssm_tables_item(const Args& a, int kk, int g, LAS unsigned char* sl, int tid) {
    LAS f32x2* apow = (LAS f32x2*)sl;
    LAS f32x2* bbar = (LAS f32x2*)(sl + 17408);
    LAS f32x2* cc   = (LAS f32x2*)(sl + 17408 + 16384);
    LAS float* klag = (LAS float*)(sl + 17408 + 32768);
    if (tid < 128) {
        const int d = tid >> 6, p = tid & 63;
        const size_t ia = ((size_t)(kk * 2 + d) * SSM_G + g) * SSM_P + p;
        const double are = (double)a.ssm_a_re[ia], aim = (double)a.ssm_a_im[ia];
        const double dt = exp((double)a.ssm_log_dt[(kk * 2 + d) * SSM_G + g]);
        double abr = 1.0, abi = 0.0;
        for (int m = 0; m <= 16; ++m) {
            const double mag = exp(m * are * dt), ang = m * aim * dt;
            const double cr = mag * cos(ang), ci = mag * sin(ang);
            apow[(d * 64 + p) * 17 + m] = (f32x2){(float)cr, (float)ci};
            if (m == 1) { abr = cr; abi = ci; }
            if (m == 16) ((f32x2*)(a.ws + WS_AL))[((size_t)(kk * 2 + d) * SSM_G + g) * SSM_P + p] = (f32x2){(float)cr, (float)ci};
        }
        const double nr = abr - 1.0, ni = abi, den = are * are + aim * aim;
        const double qr = (nr * are + ni * aim) / den, qi = (ni * are - nr * aim) / den;
        const float* bp = a.ssm_b + (ia * SSM_H) * 2;
        for (int h = 0; h < 16; ++h) { const double br = (double)bp[2 * h], bi = (double)bp[2 * h + 1];
            bbar[(d * 64 + p) * 16 + h] = (f32x2){(float)(qr * br - qi * bi), (float)(qr * bi + qi * br)}; }
    }
    for (int i = tid; i < 2048; i += NTHR) {
        const int d = i >> 10, r = i & 1023;
        const float* cp = a.ssm_c + ((((size_t)(kk * 2 + d) * SSM_G + g) * SSM_H) * SSM_P + r) * 2;
        cc[i] = (f32x2){cp[0], cp[1]};
    }
    __syncthreads();
    for (int e = tid; e < 8192; e += NTHR) {
        const int h = e & 15, hp = (e >> 4) & 15, lag = (e >> 8) & 15, d = e >> 12;
        float s = 0.f;
        for (int p = 0; p < 64; ++p) {
            const f32x2 c = cc[(d * 16 + hp) * 64 + p], ap = apow[(d * 64 + p) * 17 + lag], bb = bbar[(d * 64 + p) * 16 + h];
            const float zr = ap.x * bb.x - ap.y * bb.y, zi = ap.x * bb.y + ap.y * bb.x;
            s += c.x * zr - c.y * zi;
        }
        klag[e] = s;
    }
    __syncthreads();
    f16* W1 = (f16*)(a.ws + WS_W1) + ((size_t)(kk * SSM_G + g) << 16);
    for (int e = tid; e < 65536; e += NTHR) {
        const int k = e & 255, np = e >> 8, h = k & 15, j = k >> 4, p = np & 63, ri = (np >> 6) & 1, d = np >> 7;
        const f32x2 ap = apow[(d * 64 + p) * 17 + (d == 0 ? 15 - j : j)], bb = bbar[(d * 64 + p) * 16 + h];
        const float zr = ap.x * bb.x - ap.y * bb.y, zi = ap.x * bb.y + ap.y * bb.x;
        W1[e] = (f16)(ri == 0 ? zr : zi);
    }
    f16* TW = (f16*)(a.ws + WS_TW) + ((size_t)(kk * SSM_G + g) << 17);
    const float* dw = a.ssm_d + kk * D + g * 16;
    for (int e = tid; e < 131072; e += NTHR) {
        const int k = e & 511, np = e >> 9, hp = np & 15, j = np >> 4;
        float v;
        if (k < 256) { const int h = k & 15, j2 = k >> 4;
            v = (j2 == j && h == hp) ? dw[h] : 0.f;
            if (j2 <= j) v += klag[((0 * 16 + (j - j2)) * 16 + hp) * 16 + h];
            if (j2 >= j) v += klag[((1 * 16 + (j2 - j)) * 16 + hp) * 16 + h];
        } else { const int k2 = k - 256, p = k2 & 63, ri = (k2 >> 6) & 1, d = k2 >> 7;
            const f32x2 c = cc[(d * 16 + hp) * 64 + p], ap = apow[(d * 64 + p) * 17 + (d == 0 ? j + 1 : 16 - j)];
            const float zr = c.x * ap.x - c.y * ap.y, zi = c.x * ap.y + c.y * ap.x;
            v = ri == 0 ? zr : -zi;
        }
        TW[e] = (f16)v;
    }
    __syncthreads();
}

__device__ __forceinline__ void p0a_phase(const Args& a, Frame& F) {
    LAS float* sc = (LAS float*)F.lds;
    for (int i = F.tid; i < 3 * D; i += NTHR) { const int c = i >> 11, k = i & (D - 1); const float v = (c == 0) ? a.c_ctx[k] : a.c[(c - 1) * D + k]; sc[i] = v * sigmoid_f(v); }
    __syncthreads();
    for (int it = F.vcu; it < 2 * SSM_G; it += F.G) ssm_tables_item(a, it >> 7, it & 127, F.lds + 24576, F.tid);
    const int gw = F.vcu * NWAVES + F.wave, NGW = F.G * NWAVES;
    float* modp = (float*)(a.ws + WS_MODP);
    for (int it = gw; it < 4 * 16 * 72; it += NGW) {
        const int nc = it % 72, kc = (it / 72) & 15, l = it / 1152;
        const float* wp = a.w_ada + ((size_t)(l * D + kc * 128)) * (NMOD * D) + nc * 256 + F.lane * 4;
        f32x4 s0 = {0.f, 0.f, 0.f, 0.f}, s1 = s0, s2 = s0;
        for (int k8 = 0; k8 < 128; k8 += 8) {
            f32x4 w[8];
#pragma unroll
            for (int j = 0; j < 8; ++j) w[j] = __builtin_nontemporal_load((const f32x4*)(wp + (size_t)(k8 + j) * (NMOD * D)));
#pragma unroll
            for (int j = 0; j < 8; ++j) { const int k = kc * 128 + k8 + j; s0 += w[j] * sc[k]; s1 += w[j] * sc[D + k]; s2 += w[j] * sc[2 * D + k]; }
        }
        float* op = modp + ((size_t)(kc * 4 + l) * 3) * (NMOD * D) + nc * 256 + F.lane * 4;
        *(f32x4*)op = s0; *(f32x4*)(op + NMOD * D) = s1; *(f32x4*)(op + 2 * NMOD * D) = s2;
    }
    __syncthreads();
    {
        const int gt = F.vcu * NTHR + F.tid, NGT = F.G * NTHR;
        f16* cs4 = (f16*)(a.ws + WS_CS4096);
        for (int ch = gt; ch < 4096 * 1024; ch += NGT) {
            const int k = ch >> 10, col0 = (ch & 1023) * 8, cs = col0 >> 12, t0 = col0 & 4095; float v[8];
#pragma unroll
            for (int j = 0; j < 8; ++j) { const int mm = (k * (t0 + j)) & 4095; const float x = (float)mm * (1.0f / 2048.0f); v[j] = cs == 0 ? cospif(x) : -sinpif(x); }
            u32x4 o; o.x = pk2h(v[0], v[1]); o.y = pk2h(v[2], v[3]); o.z = pk2h(v[4], v[5]); o.w = pk2h(v[6], v[7]);
            *(u32x4*)(cs4 + (size_t)ch * 8) = o;
        }
        f16* cs2 = (f16*)(a.ws + WS_CS256);
        for (int ch = gt; ch < 256 * 64; ch += NGT) {
            const int k = ch >> 6, col0 = (ch & 63) * 8, cs = col0 >> 8, t0 = col0 & 255; float v[8];
#pragma unroll
            for (int j = 0; j < 8; ++j) { const int mm = (k * (t0 + j)) & 255; const float x = (float)mm * (1.0f / 128.0f); v[j] = cs == 0 ? cospif(x) : -sinpif(x); }
            u32x4 o; o.x = pk2h(v[0], v[1]); o.y = pk2h(v[2], v[3]); o.z = pk2h(v[4], v[5]); o.w = pk2h(v[6], v[7]);
            *(u32x4*)(cs2 + (size_t)ch * 8) = o;
        }
        f16* w2t = (f16*)(a.ws + WS_W2T);
        for (int ch = gt; ch < 512 * 32; ch += NGT) {
            const int row = ch >> 5, c0 = (ch & 31) * 8, cs = row >> 8, q = row & 255; float v[8];
#pragma unroll
            for (int j = 0; j < 8; ++j) { const int mm = (q * (c0 + j)) & 255; const float x = (float)mm * (1.0f / 128.0f); v[j] = cs == 0 ? cospif(x) : sinpif(x); }
            u32x4 o; o.x = pk2h(v[0], v[1]); o.y = pk2h(v[2], v[3]); o.z = pk2h(v[4], v[5]); o.w = pk2h(v[6], v[7]);
            *(u32x4*)(w2t + (size_t)ch * 8) = o;
        }
    }
    {
        LAS float* scr = (LAS float*)(F.lds + F.wave * 16384);
        constexpr int I_IN = (D / 64) * (2 * DFF / 32), I_OUT = (DFF / 64) * (D / 32), I_O = (D / 64) * (D / 32), I_GLU = (D / 64) * (2 * D / 32);
        constexpr int NITEMS = 8 * I_IN + 8 * I_OUT + 2 * I_O + 2 * I_GLU;
        for (int it = gw; it < NITEMS; it += NGW) {
            int r = it;
            if (r < 8 * I_IN) { const int mi = r / I_IN; transpose_item(a.ffn_w_in + (size_t)mi * D * 2 * DFF, D, 2 * DFF, (f16*)(a.ws + WS_WIN) + (size_t)mi * D * 2 * DFF, DFF, scr, r % I_IN, F.lane); continue; } r -= 8 * I_IN;
            if (r < 8 * I_OUT) { const int mi = r / I_OUT; transpose_item(a.ffn_w_out + (size_t)mi * DFF * D, DFF, D, (f16*)(a.ws + WS_WOUT) + (size_t)mi * DFF * D, 0, scr, r % I_OUT, F.lane); continue; } r -= 8 * I_OUT;
            if (r < 2 * I_O) { const int mi = r / I_O; transpose_item(a.fourier_w_o + (size_t)mi * D * D, D, D, (f16*)(a.ws + WS_WO) + (size_t)mi * D * D, 0, scr, r % I_O, F.lane); continue; } r -= 2 * I_O;
            { const int mi = r / I_GLU; transpose_item(a.ssm_w_glu + (size_t)mi * D * 2 * D, D, 2 * D, (f16*)(a.ws + WS_WGLU) + (size_t)mi * D * 2 * D, D, scr, r % I_GLU, F.lane); }
        }
    }
    for (int m = gw; m < MTOK; m += NGW) {
        float* xo = a.out + (size_t)m * D;
        if (m < NPROMPT) {
            const float* xi = a.x_prompt + (size_t)m * D;
#pragma unroll
            for (int j = 0; j < 8; ++j) *(f32x4*)(xo + j * 256 + F.lane * 4) = *(const f32x4*)(xi + j * 256 + F.lane * 4);
        } else {
            const int ms = m - NPROMPT, t = ms & (SEQ_S - 1);
            const float rr = (float)(t >> 6), cl = (float)(t & 63);
            const float* xi = a.x_sample + (size_t)ms * D;
#pragma unroll
            for (int j = 0; j < 8; ++j) { const int c0 = j * 256 + F.lane * 4; f32x4 v = *(const f32x4*)(xi + c0);
                const int q = c0 >> 9; const float pos = q < 2 ? rr : cl;
#pragma unroll
                for (int e = 0; e < 4; ++e) { const int i = (c0 + e) & 511; const float fr = exp2f(-(float)i * (13.287712379549449f / 512.0f)); const float ar = pos * fr; v[e] += (q & 1) ? cosf(ar) : sinf(ar); }
                *(f32x4*)(xo + c0) = v; }
        }
    }
}

__device__ __forceinline__ void p0b_phase(const Args& a, Frame& F) {
    const float* modp = (const float*)(a.ws + WS_MODP); float* mod = (float*)(a.ws + WS_MOD);
    for (int i = F.vcu * NTHR + F.tid; i < 4 * 3 * NMOD * D; i += F.G * NTHR) {
        const int n = i % (NMOD * D), lc = i / (NMOD * D), l = lc / 3;
        float s = a.b_ada[l * (NMOD * D) + n];
#pragma unroll
        for (int kc = 0; kc < 16; ++kc) s += modp[((size_t)kc * 12 + lc) * (NMOD * D) + n];
        mod[i] = s;
    }
}

__device__ __forceinline__ void norm_phase(const Args& a, Frame& F, int l, int j) {
    const int gw = F.vcu * NWAVES + F.wave; const int row0 = gw * 8;
    const int cond = cond_of_panel(row0 >> 8);
    const float* gp = a.norm_g + (size_t)(l * 3 + j) * D;
    const float* sh = (const float*)(a.ws + WS_MOD) + ((size_t)(l * 3 + cond) * NMOD + 3 * j) * D;
    const float* scl = sh + D;
    f32x4 gs[4][2], sv[4][2];
#pragma unroll
    for (int q = 0; q < 4; ++q)
#pragma unroll
        for (int e = 0; e < 2; ++e) { const int c = q * 512 + F.lane * 8 + e * 4; gs[q][e] = *(const f32x4*)(gp + c) * (*(const f32x4*)(scl + c) + 1.0f); sv[q][e] = *(const f32x4*)(sh + c); }
    f16* H = (f16*)(a.ws + WS_H);
    for (int r = 0; r < 8; ++r) {
        const float* xr = a.out + (size_t)(row0 + r) * D;
        f32x4 v[4][2]; float ss = 0.f;
#pragma unroll
        for (int q = 0; q < 4; ++q)
#pragma unroll
            for (int e = 0; e < 2; ++e) { v[q][e] = *(const f32x4*)(xr + q * 512 + F.lane * 8 + e * 4); const f32x4 t = v[q][e] * v[q][e]; ss += (t[0] + t[1]) + (t[2] + t[3]); }
        const float rstd = 1.0f / sqrtf(wave_sum(ss, F.lane) * (1.0f / D) + RMS_EPS);
#pragma unroll
        for (int q = 0; q < 4; ++q) { const f32x4 o0 = v[q][0] * rstd * gs[q][0] + sv[q][0], o1 = v[q][1] * rstd * gs[q][1] + sv[q][1];
            u32x4 w; w.x = pk2h(o0[0], o0[1]); w.y = pk2h(o0[2], o0[3]); w.z = pk2h(o1[0], o1[1]); w.w = pk2h(o1[2], o1[3]);
            *(u32x4*)(H + (size_t)(row0 + r) * D + q * 512 + F.lane * 8) = w; }
    }
}

__device__ __forceinline__ void final_phase(const Args& a, Frame& F) {
    const int gw = F.vcu * NWAVES + F.wave; const int row0 = gw * 8;
    f32x4 gs[8];
#pragma unroll
    for (int q = 0; q < 8; ++q) gs[q] = *(const f32x4*)(a.final_g + q * 256 + F.lane * 4);
    for (int r = 0; r < 8; ++r) {
        float* xr = a.out + (size_t)(row0 + r) * D;
        f32x4 v[8]; float ss = 0.f;
#pragma unroll
        for (int q = 0; q < 8; ++q) { v[q] = *(const f32x4*)(xr + q * 256 + F.lane * 4); const f32x4 t = v[q] * v[q]; ss += (t[0] + t[1]) + (t[2] + t[3]); }
        const float rstd = 1.0f / sqrtf(wave_sum(ss, F.lane) * (1.0f / D) + RMS_EPS);
#pragma unroll
        for (int q = 0; q < 8; ++q) *(f32x4*)(xr + q * 256 + F.lane * 4) = v[q] * rstd * gs[q];
    }
}

__device__ __forceinline__ void scan_phase(const Args& a, Frame& F, int kk) {
    const int gw = F.vcu * NWAVES + F.wave, NGW = F.G * NWAVES;
    const float* S = (const float*)(a.ws + WS_S); f16* CC = (f16*)(a.ws + WS_CC);
    const f32x2* AL = (const f32x2*)(a.ws + WS_AL);
    float* ns = a.out + (size_t)MTOK * D;
    const int p = F.lane;
    for (int it = gw; it < 34 * SSM_G * 2; it += NGW) {
        int sq, g, d;
        if (it < 512) { sq = 32 + (it >> 8); g = (it >> 1) & 127; d = it & 1; }
        else { const int r = it - 512; sq = r >> 8; g = (r >> 1) & 127; d = r & 1; }
        const int c0 = sq < 32 ? sq * 16 : 512 + (sq - 32) * 256, cnt = sq < 32 ? 16 : 256;
        const f32x2 al = AL[((size_t)(kk * 2 + d) * SSM_G + g) * SSM_P + p];
        float cr = 0.f, ci = 0.f;
        if (sq >= 32) { const float* sp = a.state_ssm + (((((size_t)(sq - 32) * 2 + kk) * 2 + d) * SSM_G + g) * SSM_P + p) * 2; cr = sp[0]; ci = sp[1]; }
        const size_t sbase = (size_t)g * 256 + d * 128 + p;
        f16* ccb = CC + (size_t)(d * 8 + (p >> 4)) * D + g * 16 + (p & 15);
        for (int s8 = 0; s8 < cnt; s8 += 8) {
            float sr[8], si[8];
#pragma unroll
            for (int j = 0; j < 8; ++j) { const int c = d == 0 ? c0 + s8 + j : c0 + cnt - 1 - s8 - j; const float* q = S + (size_t)c * (SSM_G * 256) + sbase; sr[j] = q[0]; si[j] = q[64]; }
#pragma unroll
            for (int j = 0; j < 8; ++j) { const int c = d == 0 ? c0 + s8 + j : c0 + cnt - 1 - s8 - j;
                f16* o = ccb + (size_t)c * 16 * D; o[0] = (f16)cr; o[4 * D] = (f16)ci;
                const float nr = al.x * cr - al.y * ci + sr[j], ni = al.x * ci + al.y * cr + si[j]; cr = nr; ci = ni; }
        }
        if (sq < 32) { float* o = ns + (((((size_t)sq * 2 + kk) * 2 + d) * SSM_G + g) * SSM_P + p) * 2; *(f32x2*)o = (f32x2){cr, ci}; }
    }
}

constexpr int N_PHASES = 45;
#ifndef MK_PER_PHASE
#define MK_PER_PHASE 0
#endif

#ifndef EN_MASK
#define EN_MASK 0xFFFF
#endif
#define EN(bit) if constexpr (((EN_MASK) >> (bit)) & 1)
typedef pg8::Prob<false> ProbStd;
typedef pg8::Prob<true> ProbChunk;

__device__ __forceinline__ ProbStd make_std(const void* A, unsigned lda2, size_t a_t, size_t a_z, const void* B, unsigned ldb2, size_t b_t, size_t b_z, int nt) {
    ProbStd p; p.A = (const char*)A; p.A2 = (const char*)A; p.B = (const char*)B; p.nt = nt; p.ksplit = nt; p.lda2 = lda2; p.ldb2 = ldb2; p.a_t = a_t; p.a_z = a_z; p.b_t = b_t; p.b_z = b_z; p.a_k = 128u; p.b_k = 128u; return p;
}

struct ArgsK {
    const GAS float* x_prompt; const GAS float* x_sample; const GAS float* state_ssm; const GAS float* c; const GAS float* c_ctx;
    const GAS float* w_ada; const GAS float* b_ada; const GAS float* norm_g; const GAS float* ffn_w_in; const GAS float* ffn_w_out;
    const GAS float* fourier_w_o; const GAS float* ssm_a_re; const GAS float* ssm_a_im; const GAS float* ssm_log_dt;
    const GAS float* ssm_b; const GAS float* ssm_c; const GAS float* ssm_d; const GAS float* ssm_w_glu; const GAS float* final_g;
    GAS float* out; GAS unsigned char* ws; int ph_lo, ph_hi;
};
static_assert(sizeof(ArgsK) == sizeof(Args), "ArgsK mirrors Args");
__device__ __forceinline__ Args kargs() {
    const __attribute__((address_space(4))) ArgsK* p = (const __attribute__((address_space(4))) ArgsK*)__builtin_amdgcn_kernarg_segment_ptr(); asm volatile("" : "+s"(p));
    Args a;
    a.x_prompt = (const float*)p->x_prompt; a.x_sample = (const float*)p->x_sample; a.state_ssm = (const float*)p->state_ssm; a.c = (const float*)p->c; a.c_ctx = (const float*)p->c_ctx;
    a.w_ada = (const float*)p->w_ada; a.b_ada = (const float*)p->b_ada; a.norm_g = (const float*)p->norm_g; a.ffn_w_in = (const float*)p->ffn_w_in; a.ffn_w_out = (const float*)p->ffn_w_out;
    a.fourier_w_o = (const float*)p->fourier_w_o; a.ssm_a_re = (const float*)p->ssm_a_re; a.ssm_a_im = (const float*)p->ssm_a_im; a.ssm_log_dt = (const float*)p->ssm_log_dt;
    a.ssm_b = (const float*)p->ssm_b; a.ssm_c = (const float*)p->ssm_c; a.ssm_d = (const float*)p->ssm_d; a.ssm_w_glu = (const float*)p->ssm_w_glu; a.final_g = (const float*)p->final_g;
    a.out = (float*)p->out; a.ws = (unsigned char*)p->ws; a.ph_lo = p->ph_lo; a.ph_hi = p->ph_hi;
    return a;
}

__global__ void __launch_bounds__(NTHR, 2) fwd_kernel(ArgsK a_unused) {
    extern __shared__ __attribute__((aligned(16))) unsigned char lds_raw[];
    Frame F0;
    F0.lds = (LAS unsigned char*)lds_raw;
    F0.tid = threadIdx.x; F0.lane = F0.tid & 63; F0.wave = __builtin_amdgcn_readfirstlane(F0.tid >> 6);
    F0.G = gridDim.x; F0.bx = blockIdx.x; { const int bx = blockIdx.x; F0.vcu = (F0.G % 8 == 0) ? (bx % 8) * (F0.G / 8) + bx / 8 : bx; }
    volatile LAS unsigned* MISC = (volatile LAS unsigned*)(F0.lds + MISC_OFF);
    if (F0.tid < 64) MISC[F0.tid] = 0u;
    __syncthreads();
    unsigned bar_x; int lo, hi;
    { const Args a = kargs(); unsigned* ctl = (unsigned*)(a.ws + WS_CTL); const XcdBarrier b0 = xcd_barrier_post(ctl + CW_BAR, MISC + 8); bar_x = b0.x; lo = a.ph_lo; hi = a.ph_hi; }
#define GRID_BAR() do { const Args ab = kargs(); XcdBarrier bb; bb.bar = (unsigned*)(ab.ws + WS_CTL) + CW_BAR; unsigned bx_ = bar_x; asm volatile("" : "+s"(bx_)); bb.x = bx_; bb.st = MISC + 8; xcd_barrier(bb); } while (0)
    int ph = 0;
#define PH_BEGIN if (ph >= lo && ph < hi) { const Args a = kargs(); unsigned char* ws = a.ws; \
    Frame F = F0; asm volatile("" : "+s"(F.vcu), "+s"(F.wave), "+s"(F.G), "+s"(F.bx)); asm volatile("" : "+v"(F.tid)); F.lane = F.tid & 63;   \
    f16* H = (f16*)(ws + WS_H); f16* ACT = (f16*)(ws + WS_ACT); f16* HT = (f16*)(ws + WS_HT); f16* Fm = (f16*)(ws + WS_F); \
    float* Sm = (float*)(ws + WS_S); f16* CC = (f16*)(ws + WS_CC); f16* Gm = (f16*)(ws + WS_G); \
    const float* modl = (const float*)(ws + WS_MOD) + (size_t)l * 3 * NMOD * D; \
    (void)H; (void)ACT; (void)HT; (void)Fm; (void)Sm; (void)CC; (void)Gm; (void)modl;
#define PH_END   if (ph + 1 < hi) GRID_BAR(); } ++ph;

    { const int l = 0;
    PH_BEGIN EN(0) p0a_phase(a, F); PH_END
    PH_BEGIN EN(1) p0b_phase(a, F); PH_END
    }
    for (int l = 0; l < DEPTH; ++l) {
        for (int s = 0; s < 2; ++s) {
            PH_BEGIN EN(2) norm_phase(a, F, l, 2 * s); PH_END
            PH_BEGIN EN(3) {
                const f16* Wt = (const f16*)(ws + WS_WIN) + (size_t)(l * 2 + s) * D * 2 * DFF;
                ProbStd p = make_std(H, D * 2, (size_t)256 * D * 2, 0, Wt, D * 2, (size_t)256 * D * 2, 0, D / 64);
                pg8::StaticOrder S; S.init(MTOK, 2 * DFF, F.G, F.bx);
                EpiSwiGLU E{ACT};
                pg8::gemm_phase<ProbStd, EpiSwiGLU, pg8::StaticOrder, true, true>(F.lds, p, S, E);
            } PH_END
            PH_BEGIN EN(4) {
                const f16* Wt = (const f16*)(ws + WS_WOUT) + (size_t)(l * 2 + s) * DFF * D;
                ProbStd p = make_std(ACT, DFF * 2, (size_t)256 * DFF * 2, 0, Wt, DFF * 2, (size_t)256 * DFF * 2, 0, DFF / 64);
                pg8::StaticOrder S; S.init(MTOK, D, F.G, F.bx);
                EpiResid E{a.out, modl + (size_t)(2 + 6 * s) * D, 0.5f};
                pg8::gemm_phase<ProbStd, EpiResid, pg8::StaticOrder, true, true>(F.lds, p, S, E);
            } PH_END
            if (s == 0) {
                PH_BEGIN EN(2) norm_phase(a, F, l, 1); PH_END
                const int kk = l >> 1;
                if ((l & 1) == 0) {
                    PH_BEGIN EN(5) {
                        ProbStd p = make_std(ws + WS_W2T, 512, (size_t)256 * 512, 0, H, D * 2, (size_t)256 * D * 2, 512, 4);
                        SchedFA S{F.vcu}; EpiFA E{HT};
                        pg8::gemm_phase<ProbStd, EpiFA, SchedFA, true, true>(F.lds, p, S, E);
                    } PH_END
                    PH_BEGIN EN(6) {
                        {
                            ProbStd p = make_std(ws + WS_CS4096, 16384, (size_t)256 * 16384, 0, HT + (size_t)NB_P * D * 2 * SEQ_P, 16384, (size_t)256 * 16384, (size_t)D * 16384, 128);
                            SchedFBs S{F.vcu}; EpiFB E{Fm, NPROMPT, SEQ_S, 1.0f / 1024.0f};
                            pg8::gemm_phase<ProbStd, EpiFB, SchedFBs, false, true>(F.lds, p, S, E);
                        }
                        {
                            ProbStd p = make_std(ws + WS_CS256, 1024, (size_t)256 * 1024, 0, HT, 1024, (size_t)256 * 1024, (size_t)D * 1024, 8);
                            SchedFBp S{F.vcu}; EpiFB E{Fm, 0, SEQ_P, 1.0f / 256.0f};
                            pg8::gemm_phase<ProbStd, EpiFB, SchedFBp, false, true>(F.lds, p, S, E);
                        }
                    } PH_END
                    PH_BEGIN EN(7) {
                        const f16* Wt = (const f16*)(ws + WS_WO) + (size_t)kk * D * D;
                        ProbStd p = make_std(Fm, D * 2, (size_t)256 * D * 2, 0, Wt, D * 2, (size_t)256 * D * 2, 0, D / 64);
                        pg8::StaticOrder S; S.init(MTOK, D, F.G, F.bx);
                        EpiResid E{a.out, modl + (size_t)5 * D, 1.0f};
                        pg8::gemm_phase<ProbStd, EpiResid, pg8::StaticOrder, true, true>(F.lds, p, S, E);
                    } PH_END
                } else {
                    PH_BEGIN EN(8) {
                        ProbChunk p; p.A = (const char*)H; p.A2 = (const char*)H; p.B = (const char*)(ws + WS_W1) + (size_t)kk * SSM_G * 256 * 512; p.nt = 4; p.ksplit = 4;
                        p.lda2 = 65536u; p.ldb2 = 512u; p.a_t = (size_t)256 * 65536; p.a_z = 32; p.b_t = 0; p.b_z = (size_t)256 * 512; p.a_k = 16384u; p.b_k = 128u;
                        SchedS S{F.vcu}; EpiS1 E{Sm};
                        pg8::gemm_phase<ProbChunk, EpiS1, SchedS, true, true>(F.lds, p, S, E);
                    } PH_END
                    PH_BEGIN EN(9) scan_phase(a, F, kk); PH_END
                    PH_BEGIN EN(10) {
                        ProbChunk p; p.A = (const char*)H; p.A2 = (const char*)CC; p.B = (const char*)(ws + WS_TW) + (size_t)kk * SSM_G * 256 * 1024; p.nt = 8; p.ksplit = 4;
                        p.lda2 = 65536u; p.ldb2 = 1024u; p.a_t = (size_t)256 * 65536; p.a_z = 32; p.b_t = 0; p.b_z = (size_t)256 * 1024; p.a_k = 16384u; p.b_k = 128u;
                        SchedS S{F.vcu}; EpiS3 E{Gm};
                        pg8::gemm_phase<ProbChunk, EpiS3, SchedS, true, true>(F.lds, p, S, E);
                    } PH_END
                    PH_BEGIN EN(11) {
                        const f16* Wt = (const f16*)(ws + WS_WGLU) + (size_t)kk * D * 2 * D;
                        ProbStd p = make_std(Gm, D * 2, (size_t)256 * D * 2, 0, Wt, D * 2, (size_t)256 * D * 2, 0, D / 64);
                        pg8::StaticOrder S; S.init(MTOK, 2 * D, F.G, F.bx);
                        EpiGLUResid E{a.out, modl + (size_t)5 * D};
                        pg8::gemm_phase<ProbStd, EpiGLUResid, pg8::StaticOrder, true, true>(F.lds, p, S, E);
                    } PH_END
                }
            }
        }
    }
    { const int l = 0;
    PH_BEGIN EN(12) final_phase(a, F); PH_END
    }
#undef PH_BEGIN
#undef PH_END
}

extern "C" void kernel_launch(void* const* d_in, const int* in_sizes, int n_in, void* d_out, int out_size, void* d_ws, size_t ws_size, hipStream_t stream) {
    static int grid = 0;
    if (grid == 0) {
        if (n_in != 19 || ws_size < WS_END) { fprintf(stderr, "kernel_launch: unexpected n_in %d or ws_size %zu (need %zu)\n", n_in, ws_size, (size_t)WS_END); grid = -1; return; }
        int dev = 0, cus = 0, per_cu = 0;
        if (hipGetDevice(&dev) != hipSuccess || hipDeviceGetAttribute(&cus, hipDeviceAttributeMultiprocessorCount, dev) != hipSuccess) { grid = -1; return; }
        if (hipFuncSetAttribute((const void*)fwd_kernel, hipFuncAttributeMaxDynamicSharedMemorySize, LDS_BYTES) != hipSuccess) { fprintf(stderr, "kernel_launch: hipFuncSetAttribute failed\n"); grid = -1; return; }
        if (hipOccupancyMaxActiveBlocksPerMultiprocessor(&per_cu, (const void*)fwd_kernel, NTHR, LDS_BYTES) != hipSuccess || per_cu < 1) fprintf(stderr, "kernel_launch: occupancy query reports %d\n", per_cu);
        (void)hipGetLastError();
        grid = cus < 256 ? cus : 256;
    }
    if (grid < 0) return;
    (void)hipMemsetAsync((char*)d_ws + WS_CTL, 0, CTL_ZERO_BYTES, stream);
    ArgsK a{};
    a.x_prompt = (const GAS float*)d_in[0]; a.x_sample = (const GAS float*)d_in[1]; a.state_ssm = (const GAS float*)d_in[2]; a.c = (const GAS float*)d_in[3]; a.c_ctx = (const GAS float*)d_in[4];
    a.w_ada = (const GAS float*)d_in[5]; a.b_ada = (const GAS float*)d_in[6]; a.norm_g = (const GAS float*)d_in[7]; a.ffn_w_in = (const GAS float*)d_in[8]; a.ffn_w_out = (const GAS float*)d_in[9];
    a.fourier_w_o = (const GAS float*)d_in[10]; a.ssm_a_re = (const GAS float*)d_in[11]; a.ssm_a_im = (const GAS float*)d_in[12]; a.ssm_log_dt = (const GAS float*)d_in[13];
    a.ssm_b = (const GAS float*)d_in[14]; a.ssm_c = (const GAS float*)d_in[15]; a.ssm_d = (const GAS float*)d_in[16]; a.ssm_w_glu = (const GAS float*)d_in[17]; a.final_g = (const GAS float*)d_in[18];
    a.out = (GAS float*)d_out; a.ws = (GAS unsigned char*)d_ws;
#if MK_PER_PHASE
    for (int i = 0; i < N_PHASES; ++i) { a.ph_lo = i; a.ph_hi = i + 1; hipLaunchKernelGGL(fwd_kernel, dim3(grid), dim3(NTHR), LDS_BYTES, stream, a); }
#else
    a.ph_lo = 0; a.ph_hi = N_PHASES;
    hipLaunchKernelGGL(fwd_kernel, dim3(grid), dim3(NTHR), LDS_BYTES, stream, a);
#endif
    const hipError_t le = hipPeekAtLastError();
    if (le != hipSuccess) fprintf(stderr, "kernel_launch: launch failed: %s\n", hipGetErrorName(le));
}
```

```cpp
#include <hip/hip_runtime.h>
#include <cstdio>
#include <cstdint>

#define LAS __attribute__((address_space(3)))
#define GAS __attribute__((address_space(1)))
typedef _Float16 f16;
typedef _Float16 f16x8 __attribute__((ext_vector_type(8)));
typedef _Float16 f16x4 __attribute__((ext_vector_type(4)));
typedef _Float16 f16x2 __attribute__((ext_vector_type(2)));
typedef float f32x4 __attribute__((ext_vector_type(4)));
typedef float f32x2 __attribute__((ext_vector_type(2)));
typedef unsigned u32x4 __attribute__((ext_vector_type(4)));
typedef unsigned u32x2 __attribute__((ext_vector_type(2)));

constexpr int D = 2048, DFF = 5632, MTOK = 16384, NPROMPT = 8192, SEQ_P = 256, SEQ_S = 4096, NB_P = 32, NB_S = 2;
constexpr int DEPTH = 4, NMOD = 9, SSM_G = 128, SSM_P = 64, SSM_H = 16;
constexpr float RMS_EPS = 1e-6f;
constexpr int NWAVES = 8, NTHR = 512;

constexpr size_t MiB = 1u << 20;
constexpr size_t WS_CTL = 0, CTL_ZERO_BYTES = 1 * MiB;
constexpr size_t WS_MOD = 1 * MiB;
constexpr size_t WS_MODP = 2 * MiB;
constexpr size_t WS_AL = 18 * MiB;
constexpr size_t WS_W2T = 19 * MiB;
constexpr size_t WS_CS256 = 19 * MiB + 512 * 1024;
constexpr size_t WS_PE = 19 * MiB + 768 * 1024;
constexpr size_t WS_CS4096 = 20 * MiB;
constexpr size_t WS_W1 = 84 * MiB;
constexpr size_t WS_TW = 116 * MiB;
constexpr size_t WS_WO = 180 * MiB;
constexpr size_t WS_WGLU = 196 * MiB;
constexpr size_t WS_WIN = 228 * MiB;
constexpr size_t WS_WOUT = 580 * MiB;
constexpr size_t WS_H = 756 * MiB;
constexpr size_t WS_ACT = 820 * MiB;
constexpr size_t WS_HT = 820 * MiB;
constexpr size_t WS_F = 948 * MiB;
constexpr size_t WS_S = 820 * MiB;
constexpr size_t WS_CC = 948 * MiB;
constexpr size_t WS_G = 1012 * MiB;
constexpr size_t WS_END = 1076 * MiB;
constexpr int CW_BAR = 4096;

constexpr int STAGE_BYTES = 131072;
constexpr int MISC_OFF = STAGE_BYTES;
constexpr int LDS_BYTES = 147456;

namespace pg8 {
constexpr int BM = 256, BK = 64, HALF = 128, HTB = HALF * BK * 2, NXCD = 8, WGM = 8;
__host__ __device__ __forceinline__ int lds_byte(int r, int c) { const int st = (r >> 4) * 2 + (c >> 5), rr = r & 15, cc = c & 31, ob = rr * 64 + cc * 2; return st * 1024 + (ob ^ (((ob >> 9) & 1) << 5)); }
__host__ __device__ __forceinline__ void stage_rc(int b, int& R, int& C) { const int st = b / 1024, sb = b % 1024, swz = sb ^ (((sb >> 9) & 1) << 5); R = (st >> 1) * 16 + swz / 64; C = (st & 1) * 32 + (swz % 64) / 2; }
__host__ __device__ __forceinline__ int perm32(int rho) { const int n = rho >> 4, i = rho & 15; return 8 * (i >> 2) + 4 * n + (i & 3); }

struct Unit { int pm, pn, z; };

template <bool CHUNK> struct Prob {
    const char* A; const char* A2; const char* B; int nt, ksplit; unsigned lda2, ldb2; size_t a_t, a_z, b_t, b_z; unsigned a_k, b_k;
    __device__ __forceinline__ const char* a_ptr(const Unit& u, int t) const { const char* p = (t < ksplit) ? A + (size_t)t * a_k : A2 + (size_t)(t - ksplit) * a_k; return p + (size_t)u.pm * a_t + (size_t)u.z * a_z; }
    __device__ __forceinline__ const char* b_ptr(const Unit& u, int t) const { return B + (size_t)t * b_k + (size_t)u.pn * b_t + (size_t)u.z * b_z; }
    __device__ __forceinline__ unsigned a_off(int R, int C) const { return CHUNK ? (unsigned)R * lda2 + (unsigned)(C >> 4) * 4096u + (unsigned)(C & 15) * 2u : (unsigned)R * lda2 + (unsigned)C * 2u; }
    __device__ __forceinline__ unsigned b_off(int R, int C) const { return (unsigned)R * ldb2 + (unsigned)C * 2u; }
};

struct StaticOrder {
    int nM, nN, nwg, G, c;
    __device__ void init(int M, int N, int G_, int c_) { nM = M / BM; nN = N / BM; nwg = nM * nN; G = G_; c = c_; }
    __device__ bool next(int i, Unit& u) const {
        const long L = (long)i * G + c; if (L >= nwg) return false;
        int wgid = (int)L; { const int q = nwg / NXCD, r = nwg % NXCD, xcd = wgid % NXCD, off = wgid / NXCD; wgid = (xcd < r ? xcd * (q + 1) : r * (q + 1) + (xcd - r) * q) + off; }
        const int nig = WGM * nN, gid = wgid / nig, fm = gid * WGM, gsz = (nM - fm) < WGM ? (nM - fm) : WGM;
        u.pm = fm + ((wgid % nig) % gsz); u.pn = (wgid % nig) / gsz; u.z = 0; return true;
    }
};

template <class P, class Epi, class Sched, bool ALIGN_EPI, bool SP2>
__device__ __forceinline__ void gemm_phase(LAS unsigned char* lds, const P& p, const Sched& S, const Epi& E) {
    int tid_ = threadIdx.x; asm volatile("" : "+v"(tid_));
    const int tid = tid_, wid = __builtin_amdgcn_readfirstlane(tid >> 6), lane = tid & 63, wr = wid >> 2, wc = wid & 3, fr = lane & 15, fq = lane >> 4;
    int nt = p.nt; asm volatile("" : "+s"(nt));
    unsigned voffA[2], voffB[2];
#pragma unroll
    for (int i = 0; i < 2; ++i) { int R, C; stage_rc(tid * 16 + i * 8192, R, C); const int Rb = Epi::PERM ? ((R & ~31) + perm32(R & 31)) : R;
        voffA[i] = p.a_off(R, C); voffB[i] = p.b_off(Rb, C); }
    const size_t ahs = (size_t)HALF * p.lda2, bhs = (size_t)HALF * p.ldb2;
    const unsigned ldsw = (unsigned)wid * 1024u;
    const int aoff = lds_byte(wr * 64 + fr, fq * 8), boff = lds_byte(wc * 32 + fr, fq * 8);
#define PG8_SA(b, h) (((b) * 2 + (h)) * HTB)
#define PG8_SB(b, h) ((4 + (b) * 2 + (h)) * HTB)
#define PG8_STAGE(bufoff, gbase, voff) do { _Pragma("unroll") for (int _i = 0; _i < 2; ++_i) \
        __builtin_amdgcn_global_load_lds((const unsigned*)((const char*)(gbase) + (voff)[_i]), (LAS unsigned*)(lds + (bufoff) + ldsw + _i * 8192), 16, 0, 0); } while (0)
#define PG8_LDA(dst, b, h) do { _Pragma("unroll") for (int m = 0; m < 4; ++m) _Pragma("unroll") for (int k = 0; k < 2; ++k) dst[m][k] = *(const LAS f16x8*)(lds + PG8_SA(b, h) + aoff + m * 2048 + k * 1024); } while (0)
#define PG8_LDB(dst, b, h) do { _Pragma("unroll") for (int n = 0; n < 2; ++n) _Pragma("unroll") for (int k = 0; k < 2; ++k) dst[n][k] = *(const LAS f16x8*)(lds + PG8_SB(b, h) + boff + n * 2048 + k * 1024); } while (0)
#define PG8_MMA(ai, bj, At, Bt) do { __builtin_amdgcn_s_setprio(1); _Pragma("unroll") for (int m = 0; m < 4; ++m) _Pragma("unroll") for (int n = 0; n < 2; ++n) _Pragma("unroll") for (int k = 0; k < 2; ++k) \
        acc[ai][bj][m][n] = __builtin_amdgcn_mfma_f32_16x16x32_f16(Bt[n][k], At[m][k], acc[ai][bj][m][n], 0, 0, 0); __builtin_amdgcn_s_setprio(0); } while (0)
#define PG8_WAIT_V(n) asm volatile("s_waitcnt vmcnt(" #n ")" ::: "memory")
#define PG8_WAIT_L(n) asm volatile("s_waitcnt lgkmcnt(" #n ")" ::: "memory")
#define PG8_BAR __builtin_amdgcn_s_barrier()
#define PG8_SCHED __builtin_amdgcn_sched_barrier(0)
    Unit cur, nxt; int ui = 0;
    if (!S.next(0, cur)) return;
    f32x4 acc[2][2][4][2];
#pragma unroll
    for (int a = 0; a < 2; ++a)
#pragma unroll
        for (int b = 0; b < 2; ++b)
#pragma unroll
            for (int m = 0; m < 4; ++m)
#pragma unroll
                for (int n = 0; n < 2; ++n) acc[a][b][m][n] = (f32x4){0.f, 0.f, 0.f, 0.f};
    f16x8 At[4][2], B0[2][2], B1[2][2];
    {
        const char* cA0 = p.a_ptr(cur, 0); const char* cB0 = p.b_ptr(cur, 0); const char* cA1 = p.a_ptr(cur, 1); const char* cB1 = p.b_ptr(cur, 1);
        if constexpr (SP2) {
            PG8_STAGE(PG8_SB(0, 0), cB0, voffB); PG8_STAGE(PG8_SB(0, 1), cB0 + bhs, voffB); PG8_STAGE(PG8_SA(0, 0), cA0, voffA); PG8_STAGE(PG8_SA(0, 1), cA0 + ahs, voffA);
            if (wr == 1) PG8_BAR;
            PG8_WAIT_V(2); PG8_BAR;
            PG8_STAGE(PG8_SB(1, 0), cB1, voffB); PG8_STAGE(PG8_SA(1, 0), cA1, voffA); PG8_STAGE(PG8_SB(1, 1), cB1 + bhs, voffB);
            PG8_WAIT_V(6); PG8_BAR;
        } else {
            PG8_STAGE(PG8_SB(0, 0), cB0, voffB); PG8_STAGE(PG8_SA(0, 0), cA0, voffA); PG8_STAGE(PG8_SB(0, 1), cB0 + bhs, voffB); PG8_STAGE(PG8_SA(0, 1), cA0 + ahs, voffA);
            if (wr == 1) PG8_BAR;
            PG8_WAIT_V(4); PG8_BAR;
            PG8_STAGE(PG8_SB(1, 0), cB1, voffB); PG8_STAGE(PG8_SA(1, 0), cA1, voffA); PG8_STAGE(PG8_SB(1, 1), cB1 + bhs, voffB);
            PG8_WAIT_V(6); PG8_BAR;
        }
    }
    for (;;) {
        const bool has_next = S.next(ui + 1, nxt);
        const Unit nu = has_next ? nxt : cur;
#pragma nounroll
        for (int t = 0; t < nt; t += 2) {
            const bool last = (t == nt - 2);
            const char* a1 = p.a_ptr(cur, t + 1);
            const char* a2 = last ? p.a_ptr(nu, 0) : p.a_ptr(cur, t + 2); const char* b2 = last ? p.b_ptr(nu, 0) : p.b_ptr(cur, t + 2);
            const char* a3 = last ? p.a_ptr(nu, 1) : p.a_ptr(cur, t + 3); const char* b3 = last ? p.b_ptr(nu, 1) : p.b_ptr(cur, t + 3);
            if constexpr (SP2) {
            PG8_LDB(B0, 0, 0); PG8_LDB(B1, 0, 1); PG8_SCHED; PG8_LDA(At, 0, 0); PG8_STAGE(PG8_SA(1, 1), a1 + ahs, voffA);
            PG8_WAIT_V(8); PG8_WAIT_L(0); PG8_BAR; PG8_MMA(0, 0, At, B0); PG8_MMA(0, 1, At, B1); PG8_BAR; PG8_SCHED;
            PG8_LDA(At, 0, 1); PG8_STAGE(PG8_SB(0, 0), b2, voffB); PG8_STAGE(PG8_SB(0, 1), b2 + bhs, voffB); PG8_STAGE(PG8_SA(0, 0), a2, voffA);
            PG8_WAIT_V(8); PG8_WAIT_L(0); PG8_BAR; PG8_MMA(1, 0, At, B0); PG8_MMA(1, 1, At, B1); PG8_BAR; PG8_SCHED;
            PG8_LDB(B0, 1, 0); PG8_LDB(B1, 1, 1); PG8_SCHED; PG8_LDA(At, 1, 0); PG8_STAGE(PG8_SA(0, 1), a2 + ahs, voffA);
            PG8_WAIT_V(8); PG8_WAIT_L(0); PG8_BAR; PG8_MMA(0, 0, At, B0); PG8_MMA(0, 1, At, B1); PG8_BAR; PG8_SCHED;
            PG8_LDA(At, 1, 1); PG8_STAGE(PG8_SB(1, 0), b3, voffB); PG8_STAGE(PG8_SB(1, 1), b3 + bhs, voffB); PG8_STAGE(PG8_SA(1, 0), a3, voffA);
            PG8_WAIT_V(8); PG8_WAIT_L(0); PG8_BAR; PG8_MMA(1, 0, At, B0); PG8_MMA(1, 1, At, B1); PG8_BAR; PG8_SCHED;
            } else {
            PG8_LDB(B0, 0, 0); PG8_SCHED; PG8_LDA(At, 0, 0); PG8_STAGE(PG8_SA(1, 1), a1 + ahs, voffA);
            PG8_WAIT_L(8); PG8_BAR; PG8_WAIT_L(0); PG8_MMA(0, 0, At, B0); PG8_BAR; PG8_SCHED;
            PG8_LDB(B1, 0, 1); PG8_STAGE(PG8_SB(0, 0), b2, voffB);
            PG8_BAR; PG8_WAIT_L(0); PG8_MMA(0, 1, At, B1); PG8_BAR;
            PG8_LDA(At, 0, 1); PG8_STAGE(PG8_SA(0, 0), a2, voffA);
            PG8_BAR; PG8_WAIT_L(0); PG8_MMA(1, 0, At, B0); PG8_BAR; PG8_SCHED;
            PG8_STAGE(PG8_SB(0, 1), b2 + bhs, voffB);
            PG8_WAIT_V(6); PG8_BAR; PG8_MMA(1, 1, At, B1); PG8_BAR;
            PG8_LDB(B0, 1, 0); PG8_SCHED; PG8_LDA(At, 1, 0); PG8_STAGE(PG8_SA(0, 1), a2 + ahs, voffA);
            PG8_WAIT_L(8); PG8_BAR; PG8_WAIT_L(0); PG8_MMA(0, 0, At, B0); PG8_BAR; PG8_SCHED;
            PG8_LDB(B1, 1, 1); PG8_STAGE(PG8_SB(1, 0), b3, voffB);
            PG8_BAR; PG8_WAIT_L(0); PG8_MMA(0, 1, At, B1); PG8_BAR;
            PG8_LDA(At, 1, 1); PG8_STAGE(PG8_SA(1, 0), a3, voffA);
            PG8_BAR; PG8_WAIT_L(0); PG8_MMA(1, 0, At, B0); PG8_BAR; PG8_SCHED;
            PG8_STAGE(PG8_SB(1, 1), b3 + bhs, voffB);
            PG8_WAIT_V(6); PG8_BAR; PG8_MMA(1, 1, At, B1); PG8_BAR;
            }
        }
        if constexpr (ALIGN_EPI) { if (wr == 0) PG8_BAR; }
        E(acc, cur, wr, wc, fr, fq);
        if (!has_next) break;
#pragma unroll
        for (int a = 0; a < 2; ++a)
#pragma unroll
            for (int b = 0; b < 2; ++b)
#pragma unroll
                for (int m = 0; m < 4; ++m)
#pragma unroll
                    for (int n = 0; n < 2; ++n) acc[a][b][m][n] = (f32x4){0.f, 0.f, 0.f, 0.f};
        cur = nxt; ++ui;
        if constexpr (ALIGN_EPI) { if (wr == 1) PG8_BAR; }
    }
    PG8_WAIT_V(0);
    if constexpr (!ALIGN_EPI) { if (wr == 0) PG8_BAR; }
    PG8_BAR;
#undef PG8_SA
#undef PG8_SB
#undef PG8_STAGE
#undef PG8_LDA
#undef PG8_LDB
#undef PG8_MMA
#undef PG8_WAIT_V
#undef PG8_WAIT_L
#undef PG8_BAR
#undef PG8_SCHED
}
}
using pg8::Unit;

#define RLX_AGENT __ATOMIC_RELAXED, __HIP_MEMORY_SCOPE_AGENT
#define LDS_WAIT() asm volatile("s_waitcnt lgkmcnt(0)" ::: "memory")
#define VM_WAIT() asm volatile("s_waitcnt vmcnt(0)" ::: "memory")
__device__ __forceinline__ unsigned pk2h(float lo, float hi) { f32x2 v = {lo, hi}; f16x2 h = __builtin_convertvector(v, f16x2); return __builtin_bit_cast(unsigned, h); }
__device__ __forceinline__ float wave_sum(float v, int lane) {
#pragma unroll
    for (int o = 1; o < 64; o <<= 1) v += __builtin_bit_cast(float, __builtin_amdgcn_ds_bpermute((lane ^ o) << 2, __builtin_bit_cast(int, v)));
    return v;
}
__device__ __forceinline__ float sigmoid_f(float x) { return __builtin_amdgcn_rcpf(1.0f + __builtin_amdgcn_exp2f(-1.4426950408889634f * x)); }
__device__ __forceinline__ float gelu_tanh_f(float x) {
    const float u2 = 1.5957691216057308f * (x + 0.044715f * x * x * x);
    return x * sigmoid_f(u2);
}
__device__ __forceinline__ int cond_of_panel(int pm) { return pm < 32 ? 0 : (pm < 48 ? 1 : 2); }

#define XB_TMO      128
#define XB_XCNT(j)  (256  + 64 * (j))
#define XB_XSUB(j)  (1280 + 64 * (j))
#define XB_XGEN(j)  (2304 + 64 * (j))
#define XB_TOP      3328
#define XB_TOPGEN   3392
#define XCD_BAR_WORDS 3456
#define XB_SPIN_CAP (1u << 18)
__device__ __forceinline__ unsigned xb_ld(unsigned* p)              { return __hip_atomic_load(p, __ATOMIC_RELAXED, __HIP_MEMORY_SCOPE_AGENT); }
__device__ __forceinline__ unsigned xb_add(unsigned* p, unsigned v) { return __hip_atomic_fetch_add(p, v, __ATOMIC_RELAXED, __HIP_MEMORY_SCOPE_AGENT); }
__device__ __forceinline__ unsigned xb_xcc_id() { return (unsigned)__builtin_amdgcn_s_getreg((3 << 11) | 20) & 0xFu; }
#define XB_SPIN(cond, bar) do { unsigned _sp = 0; while (cond) { __builtin_amdgcn_s_sleep(1); \
    if ((++_sp & 255u) == 0u) { if (xb_ld(&(bar)[XB_TMO])) break; if (_sp > XB_SPIN_CAP) { atomicAdd(&(bar)[XB_TMO], 1u); break; } } } } while (0)
struct XcdBarrier { unsigned* bar; unsigned x; volatile LAS unsigned* st; };
__device__ __forceinline__ XcdBarrier xcd_barrier_post(unsigned* bar, volatile LAS unsigned* st) {
    XcdBarrier b; b.bar = bar; b.x = xb_xcc_id(); b.st = st;
    if (threadIdx.x == 0) (void)xb_add(&bar[XB_XCNT(b.x)], 1u);
    return b;
}
__device__ __forceinline__ void xcd_barrier_complete(unsigned* bar, unsigned x, unsigned& nloc, unsigned& nx) {
    const unsigned G = gridDim.x * gridDim.y * gridDim.z;
    unsigned sum, cnt, mine, sp = 0u;
    for (;;) {
        sum = 0u; cnt = 0u; mine = 0u;
#pragma unroll
        for (unsigned j = 0; j < 16; ++j) { const unsigned c = xb_ld(&bar[XB_XCNT(j)]); sum += c; cnt += (c > 0u) ? 1u : 0u; mine = (j == x) ? c : mine; }
        if (sum == G) break;
        __builtin_amdgcn_s_sleep(1);
        if ((++sp & 255u) == 0u) { if (xb_ld(&bar[XB_TMO])) break; if (sp > XB_SPIN_CAP) { atomicAdd(&bar[XB_TMO], 1u); break; } }
    }
    nloc = mine > 0u ? mine : 1u; nx = cnt > 0u ? cnt : 1u;
}
__device__ __forceinline__ void xcd_barrier(const XcdBarrier& b) {
    asm volatile("s_waitcnt vmcnt(0)" ::: "memory");
    __syncthreads();
    if (threadIdx.x == 0) {
        unsigned* bar = b.bar;
        __builtin_amdgcn_s_waitcnt(0);
        unsigned nloc = b.st[0], nx = b.st[1];
        if (nloc == 0u) { xcd_barrier_complete(bar, b.x, nloc, nx); b.st[0] = nloc; b.st[1] = nx; }
        const unsigned old = xb_add(&bar[XB_XSUB(b.x)], 1u);
        const unsigned gen = old / nloc;
        if (old + 1u == (gen + 1u) * nloc) {
            __builtin_amdgcn_fence(__ATOMIC_RELEASE, "agent");
            asm volatile("s_waitcnt vmcnt(0)" ::: "memory");
            const unsigned og = xb_add(&bar[XB_TOP], 1u);
            const unsigned tg = og / nx;
            if (og + 1u == (tg + 1u) * nx) xb_add(&bar[XB_TOPGEN], 1u);
            else XB_SPIN(xb_ld(&bar[XB_TOPGEN]) == tg, bar);
            __builtin_amdgcn_fence(__ATOMIC_ACQUIRE, "agent");
            xb_add(&bar[XB_XGEN(b.x)], 1u);
            asm volatile("s_waitcnt vmcnt(0)" ::: "memory");
        } else {
            XB_SPIN(xb_ld(&bar[XB_XGEN(b.x)]) == gen, bar);
            __builtin_amdgcn_fence(__ATOMIC_ACQUIRE, "agent");
            asm volatile("s_waitcnt vmcnt(0)" ::: "memory");
        }
    }
    __syncthreads();
}

struct Args {
    const float* x_prompt; const float* x_sample; const float* state_ssm; const float* c; const float* c_ctx;
    const float* w_ada; const float* b_ada; const float* norm_g; const float* ffn_w_in; const float* ffn_w_out;
    const float* fourier_w_o; const float* ssm_a_re; const float* ssm_a_im; const float* ssm_log_dt;
    const float* ssm_b; const float* ssm_c; const float* ssm_d; const float* ssm_w_glu; const float* final_g;
    float* out; unsigned char* ws; int ph_lo, ph_hi;
};
struct Frame {
    LAS unsigned char* lds; int tid, lane, wave, vcu, G, bx;
};

struct EpiSwiGLU {
    static constexpr bool PERM = true;
    f16* O;
    __device__ __forceinline__ void operator()(const f32x4 (&acc)[2][2][4][2], const Unit& u, int wr, int wc, int fr, int fq) const {
        const int row0 = u.pm * 256 + wr * 64 + fr, col0 = u.pn * 128 + wc * 32 + 8 * fq;
#pragma unroll
        for (int ai = 0; ai < 2; ++ai)
#pragma unroll
            for (int m = 0; m < 4; ++m) {
                const f32x4 g0 = acc[ai][0][m][0], g1 = acc[ai][0][m][1], u0 = acc[ai][1][m][0], u1 = acc[ai][1][m][1];
                float r[8];
#pragma unroll
                for (int j = 0; j < 4; ++j) { r[j] = g0[j] * sigmoid_f(g0[j]) * u0[j]; r[4 + j] = g1[j] * sigmoid_f(g1[j]) * u1[j]; }
                u32x4 w; w.x = pk2h(r[0], r[1]); w.y = pk2h(r[2], r[3]); w.z = pk2h(r[4], r[5]); w.w = pk2h(r[6], r[7]);
                *(u32x4*)(O + (size_t)(row0 + ai * 128 + m * 16) * DFF + col0) = w;
            }
    }
};
struct EpiResid {
    static constexpr bool PERM = false;
    float* X; const float* modv; float coef;
    __device__ __forceinline__ void operator()(const f32x4 (&acc)[2][2][4][2], const Unit& u, int wr, int wc, int fr, int fq) const {
        const int row0 = u.pm * 256 + wr * 64 + fr, col0 = u.pn * 256 + wc * 32 + 4 * fq;
        const float* mv = modv + (size_t)cond_of_panel(u.pm) * (NMOD * D) + col0;
        f32x4 gv[2][2];
#pragma unroll
        for (int bj = 0; bj < 2; ++bj)
#pragma unroll
            for (int n = 0; n < 2; ++n) gv[bj][n] = *(const f32x4*)(mv + bj * 128 + n * 16) * coef;
#pragma unroll
        for (int ai = 0; ai < 2; ++ai)
#pragma unroll
            for (int m = 0; m < 4; ++m) { float* rowp = X + (size_t)(row0 + ai * 128 + m * 16) * D + col0;
#pragma unroll
                for (int bj = 0; bj < 2; ++bj)
#pragma unroll
                    for (int n = 0; n < 2; ++n) { f32x4* q = (f32x4*)(rowp + bj * 128 + n * 16); *q = *q + gv[bj][n] * acc[ai][bj][m][n]; } }
    }
};
struct EpiGLUResid {
    static constexpr bool PERM = true;
    float* X; const float* modv; float coef;
    __device__ __forceinline__ void operator()(const f32x4 (&acc)[2][2][4][2], const Unit& u, int wr, int wc, int fr, int fq) const {
        const int row0 = u.pm * 256 + wr * 64 + fr, col0 = u.pn * 128 + wc * 32 + 8 * fq;
        const float* mv = modv + (size_t)cond_of_panel(u.pm) * (NMOD * D) + col0;
        const f32x4 m0 = *(const f32x4*)mv * coef, m1 = *(const f32x4*)(mv + 4) * coef;
#pragma unroll
        for (int ai = 0; ai < 2; ++ai)
#pragma unroll
            for (int m = 0; m < 4; ++m) { float* rowp = X + (size_t)(row0 + ai * 128 + m * 16) * D + col0;
                const f32x4 v0 = acc[ai][0][m][0], v1 = acc[ai][0][m][1], g0 = acc[ai][1][m][0], g1 = acc[ai][1][m][1];
                f32x4 o0, o1;
#pragma unroll
                for (int j = 0; j < 4; ++j) { o0[j] = v0[j] * sigmoid_f(g0[j]); o1[j] = v1[j] * sigmoid_f(g1[j]); }
                f32x4* q = (f32x4*)rowp; q[0] = q[0] + m0 * o0; q[1] = q[1] + m1 * o1; }
    }
};
struct EpiFA {
    static constexpr bool PERM = true;
    f16* HT;
    __device__ __forceinline__ void operator()(const f32x4 (&acc)[2][2][4][2], const Unit& u, int wr, int wc, int fr, int fq) const {
        const int P = u.pn; const int n = P < 32 ? SEQ_P : SEQ_S;
        const size_t hb = P < 32 ? (size_t)P * (D * 2 * SEQ_P) : (size_t)NB_P * (D * 2 * SEQ_P) + (size_t)((P - 32) >> 4) * ((size_t)D * 2 * SEQ_S);
        const int t0 = (P < 32 ? 0 : ((P - 32) & 15) * 256) + wc * 32 + 8 * fq;
        const int q0 = wr * 64 + fr;
#pragma unroll
        for (int ai = 0; ai < 2; ++ai)
#pragma unroll
            for (int m = 0; m < 4; ++m) { const int q = q0 + ai * 128 + m * 16;
                f16* rowp = HT + hb + ((size_t)(u.z * 256 + q) * 2 + u.pm) * n + t0;
#pragma unroll
                for (int bj = 0; bj < 2; ++bj) { const f32x4 v0 = acc[ai][bj][m][0], v1 = acc[ai][bj][m][1];
                    u32x4 w; w.x = pk2h(v0[0], v0[1]); w.y = pk2h(v0[2], v0[3]); w.z = pk2h(v1[0], v1[1]); w.w = pk2h(v1[2], v1[3]);
                    *(u32x4*)(rowp + bj * 128) = w; } }
    }
};
struct EpiFB {
    static constexpr bool PERM = true;
    f16* F; int row0, zrows; float scale;
    __device__ __forceinline__ void operator()(const f32x4 (&acc)[2][2][4][2], const Unit& u, int wr, int wc, int fr, int fq) const {
        const int r0 = row0 + u.z * zrows + u.pm * 256 + wr * 64 + fr, col0 = u.pn * 256 + wc * 32 + 8 * fq;
#pragma unroll
        for (int ai = 0; ai < 2; ++ai)
#pragma unroll
            for (int m = 0; m < 4; ++m) { f16* rowp = F + (size_t)(r0 + ai * 128 + m * 16) * D + col0;
#pragma unroll
                for (int bj = 0; bj < 2; ++bj) { const f32x4 v0 = acc[ai][bj][m][0] * scale, v1 = acc[ai][bj][m][1] * scale;
                    u32x4 w; w.x = pk2h(v0[0], v0[1]); w.y = pk2h(v0[2], v0[3]); w.z = pk2h(v1[0], v1[1]); w.w = pk2h(v1[2], v1[3]);
                    *(u32x4*)(rowp + bj * 128) = w; } }
    }
};
struct EpiS1 {
    static constexpr bool PERM = false;
    float* S;
    __device__ __forceinline__ void operator()(const f32x4 (&acc)[2][2][4][2], const Unit& u, int wr, int wc, int fr, int fq) const {
        const int r0 = u.pm * 256 + wr * 64 + fr, col0 = wc * 32 + 4 * fq;
#pragma unroll
        for (int ai = 0; ai < 2; ++ai)
#pragma unroll
            for (int m = 0; m < 4; ++m) { float* rowp = S + ((size_t)(r0 + ai * 128 + m * 16) * SSM_G + u.z) * 256 + col0;
#pragma unroll
                for (int bj = 0; bj < 2; ++bj)
#pragma unroll
                    for (int n = 0; n < 2; ++n) *(f32x4*)(rowp + bj * 128 + n * 16) = acc[ai][bj][m][n]; }
    }
};
struct EpiS3 {
    static constexpr bool PERM = true;
    f16* Gm;
    __device__ __forceinline__ void operator()(const f32x4 (&acc)[2][2][4][2], const Unit& u, int wr, int wc, int fr, int fq) const {
        const int r0 = u.pm * 256 + wr * 64 + fr;
#pragma unroll
        for (int ai = 0; ai < 2; ++ai)
#pragma unroll
            for (int m = 0; m < 4; ++m) { const int r = r0 + ai * 128 + m * 16;
#pragma unroll
                for (int bj = 0; bj < 2; ++bj) { const int np = bj * 128 + wc * 32 + 8 * fq; const int j = np >> 4, h0 = np & 15;
                    const f32x4 v0 = acc[ai][bj][m][0], v1 = acc[ai][bj][m][1];
                    float rr[8];
#pragma unroll
                    for (int k = 0; k < 4; ++k) { rr[k] = gelu_tanh_f(v0[k]); rr[4 + k] = gelu_tanh_f(v1[k]); }
                    u32x4 w; w.x = pk2h(rr[0], rr[1]); w.y = pk2h(rr[2], rr[3]); w.z = pk2h(rr[4], rr[5]); w.w = pk2h(rr[6], rr[7]);
                    *(u32x4*)(Gm + (size_t)(r * 16 + j) * D + u.z * 16 + h0) = w; } }
    }
};

struct SchedFA {
    int vcu;
    __device__ bool next(int i, Unit& u) const { const int idx = i * 256 + vcu; if (idx >= 1024) return false; u.pm = idx & 1; u.z = (idx >> 1) & 7; u.pn = idx >> 4; return true; }
};
struct SchedFBs {
    int vcu;
    __device__ bool next(int i, Unit& u) const { if (i > 0) return false; u.z = vcu >> 7; u.pm = (vcu >> 3) & 15; u.pn = vcu & 7; return true; }
};
struct SchedFBp {
    int vcu;
    __device__ bool next(int i, Unit& u) const { if (i > 0) return false; u.z = vcu >> 3; u.pm = 0; u.pn = vcu & 7; return true; }
};
struct SchedS {
    int vcu;
    __device__ bool next(int i, Unit& u) const { const int idx = i * 256 + vcu; if (idx >= 512) return false; u.pm = idx & 3; u.z = idx >> 2; u.pn = 0; return true; }
};

struct TItem { const float* src; f16* dst; int N, K; };
__device__ __forceinline__ TItem titem_make(const float* W, int K, int N, f16* WT, int half, int item) {
    const int nblk = N / 32, kb = item / nblk, nb = item % nblk, k0 = 64 * kb, n0 = 32 * nb;
    int d0 = n0;
    if (half > 0) { const int bj = n0 / half, rem = n0 % half; d0 = (rem / 128) * 256 + bj * 128 + (rem % 128); }
    TItem t; t.src = W + (size_t)k0 * N + n0; t.dst = WT + (size_t)d0 * K + k0; t.N = N; t.K = K; return t;
}
__device__ __forceinline__ TItem titem_decode(const Args& a, int it) {
    constexpr int I_IN = (D / 64) * (2 * DFF / 32), I_OUT = (DFF / 64) * (D / 32), I_O = (D / 64) * (D / 32), I_GLU = (D / 64) * (2 * D / 32);
    int r = it;
    if (r < 8 * I_IN) { const int mi = r / I_IN; return titem_make(a.ffn_w_in + (size_t)mi * D * 2 * DFF, D, 2 * DFF, (f16*)(a.ws + WS_WIN) + (size_t)mi * D * 2 * DFF, DFF, r % I_IN); } r -= 8 * I_IN;
    if (r < 8 * I_OUT) { const int mi = r / I_OUT; return titem_make(a.ffn_w_out + (size_t)mi * DFF * D, DFF, D, (f16*)(a.ws + WS_WOUT) + (size_t)mi * DFF * D, 0, r % I_OUT); } r -= 8 * I_OUT;
    if (r < 2 * I_O) { const int mi = r / I_O; return titem_make(a.fourier_w_o + (size_t)mi * D * D, D, D, (f16*)(a.ws + WS_WO) + (size_t)mi * D * D, 0, r % I_O); } r -= 2 * I_O;
    { const int mi = r / I_GLU; return titem_make(a.ssm_w_glu + (size_t)mi * D * 2 * D, D, 2 * D, (f16*)(a.ws + WS_WGLU) + (size_t)mi * D * 2 * D, D, r % I_GLU); }
}
__device__ __forceinline__ void titem_load(f32x4 (&v)[8], const TItem& t, int lane) {
    const float* p = t.src + (size_t)(lane >> 3) * t.N + (lane & 7) * 4;
#pragma unroll
    for (int i = 0; i < 8; ++i) v[i] = __builtin_nontemporal_load((const f32x4*)(p + (size_t)(8 * i) * t.N));
}
__device__ __forceinline__ void titem_store(const f32x4 (&v)[8], const TItem& t, LAS float* scr, int lane) {
#pragma unroll
    for (int i = 0; i < 8; ++i) { LAS float* s = scr + (8 * i + (lane >> 3)) * 33 + (lane & 7) * 4; s[0] = v[i][0]; s[1] = v[i][1]; s[2] = v[i][2]; s[3] = v[i][3]; }
    LDS_WAIT(); asm volatile("" ::: "memory");
    const int c = lane & 7;
#pragma unroll
    for (int j = 0; j < 4; ++j) { const int n = (lane >> 3) + 8 * j; const LAS float* s = scr + (8 * c) * 33 + n;
        u32x4 o; o.x = pk2h(s[0 * 33], s[1 * 33]); o.y = pk2h(s[2 * 33], s[3 * 33]); o.z = pk2h(s[4 * 33], s[5 * 33]); o.w = pk2h(s[6 * 33], s[7 * 33]);
        *(u32x4*)(t.dst + (size_t)n * t.K + 8 * c) = o; }
    LDS_WAIT(); asm volatile("" ::: "memory");
}

__device__ __forceinline__ void ssm_tables_item(const Args& a, int kk, int g, LAS unsigned char* sl, int tid) {
    LAS f32x2* apow = (LAS f32x2*)sl;
    LAS f32x2* bbar = (LAS f32x2*)(sl + 17408);
    LAS f32x2* cc   = (LAS f32x2*)(sl + 17408 + 16384);
    LAS float* klag = (LAS float*)(sl + 17408 + 32768);
    if (tid < 128) {
        const int d = tid >> 6, p = tid & 63;
        const size_t ia = ((size_t)(kk * 2 + d) * SSM_G + g) * SSM_P + p;
        const double are = (double)a.ssm_a_re[ia], aim = (double)a.ssm_a_im[ia];
        const double dt = exp((double)a.ssm_log_dt[(kk * 2 + d) * SSM_G + g]);
        const double mag = exp(are * dt), ang = aim * dt;
        const double abr = mag * cos(ang), abi = mag * sin(ang);
        double cr = 1.0, ci = 0.0;
        for (int m = 0; m <= 16; ++m) {
            apow[(d * 64 + p) * 17 + m] = (f32x2){(float)cr, (float)ci};
            if (m == 16) ((f32x2*)(a.ws + WS_AL))[((size_t)(kk * 2 + d) * SSM_G + g) * SSM_P + p] = (f32x2){(float)cr, (float)ci};
            const double nr = cr * abr - ci * abi, ni = cr * abi + ci * abr; cr = nr; ci = ni;
        }
        const double nr = abr - 1.0, ni = abi, den = are * are + aim * aim;
        const double qr = (nr * are + ni * aim) / den, qi = (ni * are - nr * aim) / den;
        const float* bp = a.ssm_b + (ia * SSM_H) * 2;
        for (int h = 0; h < 16; ++h) { const double br = (double)bp[2 * h], bi = (double)bp[2 * h + 1];
            bbar[(d * 64 + p) * 16 + h] = (f32x2){(float)(qr * br - qi * bi), (float)(qr * bi + qi * br)}; }
    }
    for (int i = tid; i < 2048; i += NTHR) {
        const int d = i >> 10, r = i & 1023;
        const float* cp = a.ssm_c + ((((size_t)(kk * 2 + d) * SSM_G + g) * SSM_H) * SSM_P + r) * 2;
        cc[i] = (f32x2){cp[0], cp[1]};
    }
    __syncthreads();
    {
        const int hc = tid & 3, hb = (tid >> 2) & 3, lag = (tid >> 4) & 15, d = tid >> 8;
        float acc[4][4];
#pragma unroll
        for (int i = 0; i < 4; ++i)
#pragma unroll
            for (int j = 0; j < 4; ++j) acc[i][j] = 0.f;
        for (int p = 0; p < 64; ++p) {
            const f32x2 ap = apow[(d * 64 + p) * 17 + lag];
            f32x2 ab[4], c[4];
#pragma unroll
            for (int j = 0; j < 4; ++j) { const f32x2 bb = bbar[(d * 64 + p) * 16 + 4 * hc + j]; ab[j] = (f32x2){ap.x * bb.x - ap.y * bb.y, ap.x * bb.y + ap.y * bb.x}; }
#pragma unroll
            for (int i = 0; i < 4; ++i) c[i] = cc[(d * 16 + 4 * hb + i) * 64 + p];
#pragma unroll
            for (int i = 0; i < 4; ++i)
#pragma unroll
                for (int j = 0; j < 4; ++j) acc[i][j] += c[i].x * ab[j].x - c[i].y * ab[j].y;
        }
#pragma unroll
        for (int i = 0; i < 4; ++i)
#pragma unroll
            for (int j = 0; j < 4; ++j) klag[((d * 16 + lag) * 16 + 4 * hb + i) * 16 + 4 * hc + j] = acc[i][j];
    }
    __syncthreads();
    f16* W1 = (f16*)(a.ws + WS_W1) + ((size_t)(kk * SSM_G + g) << 16);
    for (int e = tid; e < 65536; e += NTHR) {
        const int k = e & 255, np = e >> 8, h = k & 15, j = k >> 4, p = np & 63, ri = (np >> 6) & 1, d = np >> 7;
        const f32x2 ap = apow[(d * 64 + p) * 17 + (d == 0 ? 15 - j : j)], bb = bbar[(d * 64 + p) * 16 + h];
        const float zr = ap.x * bb.x - ap.y * bb.y, zi = ap.x * bb.y + ap.y * bb.x;
        W1[e] = (f16)(ri == 0 ? zr : zi);
    }
    f16* TW = (f16*)(a.ws + WS_TW) + ((size_t)(kk * SSM_G + g) << 17);
    const float* dw = a.ssm_d + kk * D + g * 16;
    for (int e = tid; e < 131072; e += NTHR) {
        const int k = e & 511, np = e >> 9, hp = np & 15, j = np >> 4;
        float v;
        if (k < 256) { const int h = k & 15, j2 = k >> 4;
            v = (j2 == j && h == hp) ? dw[h] : 0.f;
            if (j2 <= j) v += klag[((0 * 16 + (j - j2)) * 16 + hp) * 16 + h];
            if (j2 >= j) v += klag[((1 * 16 + (j2 - j)) * 16 + hp) * 16 + h];
        } else { const int k2 = k - 256, p = k2 & 63, ri = (k2 >> 6) & 1, d = k2 >> 7;
            const f32x2 c = cc[(d * 16 + hp) * 64 + p], ap = apow[(d * 64 + p) * 17 + (d == 0 ? j + 1 : 16 - j)];
            const float zr = c.x * ap.x - c.y * ap.y, zi = c.x * ap.y + c.y * ap.x;
            v = ri == 0 ? zr : -zi;
        }
        TW[e] = (f16)v;
    }
    __syncthreads();
}

__device__ __forceinline__ void p0a_phase(const Args& a, Frame& F) {
    __syncthreads();
    LAS float* sc = (LAS float*)F.lds;
    for (int i = F.tid; i < 3 * D; i += NTHR) { const int c = i >> 11, k = i & (D - 1); const float v = (c == 0) ? a.c_ctx[k] : a.c[(c - 1) * D + k]; sc[i] = v * sigmoid_f(v); }
    __syncthreads();
    for (int it = F.vcu; it < 2 * SSM_G; it += F.G) ssm_tables_item(a, it >> 7, it & 127, F.lds + 24576, F.tid);
    const int gw = F.vcu * NWAVES + F.wave, NGW = F.G * NWAVES;
    float* modp = (float*)(a.ws + WS_MODP);
    for (int it = gw; it < 4 * 16 * 72; it += NGW) {
        const int nc = it % 72, kc = (it / 72) & 15, l = it / 1152;
        const float* wp = a.w_ada + ((size_t)(l * D + kc * 128)) * (NMOD * D) + nc * 256 + F.lane * 4;
        f32x4 s0 = {0.f, 0.f, 0.f, 0.f}, s1 = s0, s2 = s0;
        for (int k8 = 0; k8 < 128; k8 += 8) {
            f32x4 w[8];
#pragma unroll
            for (int j = 0; j < 8; ++j) w[j] = __builtin_nontemporal_load((const f32x4*)(wp + (size_t)(k8 + j) * (NMOD * D)));
#pragma unroll
            for (int j = 0; j < 8; ++j) { const int k = kc * 128 + k8 + j; s0 += w[j] * sc[k]; s1 += w[j] * sc[D + k]; s2 += w[j] * sc[2 * D + k]; }
        }
        float* op = modp + ((size_t)(kc * 4 + l) * 3) * (NMOD * D) + nc * 256 + F.lane * 4;
        *(f32x4*)op = s0; *(f32x4*)(op + NMOD * D) = s1; *(f32x4*)(op + 2 * NMOD * D) = s2;
    }
    __syncthreads();
    {
        const int gt = F.vcu * NTHR + F.tid, NGT = F.G * NTHR;
        f16* cs4 = (f16*)(a.ws + WS_CS4096);
        for (int ch = gt; ch < 4096 * 1024; ch += NGT) {
            const int k = ch >> 10, col0 = (ch & 1023) * 8, cs = col0 >> 12, t0 = col0 & 4095; float v[8];
#pragma unroll
            for (int j = 0; j < 8; ++j) { const int mm = (k * (t0 + j)) & 4095; const float x = (float)mm * (1.0f / 2048.0f); v[j] = cs == 0 ? cospif(x) : -sinpif(x); }
            u32x4 o; o.x = pk2h(v[0], v[1]); o.y = pk2h(v[2], v[3]); o.z = pk2h(v[4], v[5]); o.w = pk2h(v[6], v[7]);
            *(u32x4*)(cs4 + (size_t)ch * 8) = o;
        }
        f16* cs2 = (f16*)(a.ws + WS_CS256);
        for (int ch = gt; ch < 256 * 64; ch += NGT) {
            const int k = ch >> 6, col0 = (ch & 63) * 8, cs = col0 >> 8, t0 = col0 & 255; float v[8];
#pragma unroll
            for (int j = 0; j < 8; ++j) { const int mm = (k * (t0 + j)) & 255; const float x = (float)mm * (1.0f / 128.0f); v[j] = cs == 0 ? cospif(x) : -sinpif(x); }
            u32x4 o; o.x = pk2h(v[0], v[1]); o.y = pk2h(v[2], v[3]); o.z = pk2h(v[4], v[5]); o.w = pk2h(v[6], v[7]);
            *(u32x4*)(cs2 + (size_t)ch * 8) = o;
        }
        f16* w2t = (f16*)(a.ws + WS_W2T);
        for (int ch = gt; ch < 512 * 32; ch += NGT) {
            const int row = ch >> 5, c0 = (ch & 31) * 8, cs = row >> 8, q = row & 255; float v[8];
#pragma unroll
            for (int j = 0; j < 8; ++j) { const int mm = (q * (c0 + j)) & 255; const float x = (float)mm * (1.0f / 128.0f); v[j] = cs == 0 ? cospif(x) : sinpif(x); }
            u32x4 o; o.x = pk2h(v[0], v[1]); o.y = pk2h(v[2], v[3]); o.z = pk2h(v[4], v[5]); o.w = pk2h(v[6], v[7]);
            *(u32x4*)(w2t + (size_t)ch * 8) = o;
        }
    }
    {
        LAS float* scr = (LAS float*)(F.lds + F.wave * 16384);
        constexpr int I_IN = (D / 64) * (2 * DFF / 32), I_OUT = (DFF / 64) * (D / 32), I_O = (D / 64) * (D / 32), I_GLU = (D / 64) * (2 * D / 32);
        constexpr int NITEMS = 8 * I_IN + 8 * I_OUT + 2 * I_O + 2 * I_GLU;
        int it = gw;
        if (it < NITEMS) {
            TItem cur = titem_decode(a, it); f32x4 v[8], w[8]; titem_load(v, cur, F.lane);
            for (;;) {
                const int nit = it + NGW; const bool has = nit < NITEMS; TItem nx = cur;
                if (has) { nx = titem_decode(a, nit); titem_load(w, nx, F.lane); }
                titem_store(v, cur, scr, F.lane);
                if (!has) break;
#pragma unroll
                for (int i = 0; i < 8; ++i) v[i] = w[i];
                cur = nx; it = nit;
            }
        }
    }
    {
        float* pe = (float*)(a.ws + WS_PE);
        for (int e = F.vcu * NTHR + F.tid; e < 64 * 512; e += F.G * NTHR) { const int pos = e >> 9, i = e & 511;
            const float fr = exp2f(-(float)i * (13.287712379549449f / 512.0f)); const float ar = (float)pos * fr;
            pe[e] = sinf(ar); pe[64 * 512 + e] = cosf(ar); }
    }
}

__device__ __forceinline__ void p0b_phase(const Args& a, Frame& F) {
    const float* modp = (const float*)(a.ws + WS_MODP); float* mod = (float*)(a.ws + WS_MOD);
    for (int i = F.vcu * NTHR + F.tid; i < 4 * 3 * NMOD * D; i += F.G * NTHR) {
        const int n = i % (NMOD * D), lc = i / (NMOD * D), l = lc / 3;
        float s = a.b_ada[l * (NMOD * D) + n];
#pragma unroll
        for (int kc = 0; kc < 16; ++kc) s += modp[((size_t)kc * 12 + lc) * (NMOD * D) + n];
        mod[i] = s;
    }
}

__device__ __forceinline__ void norm_phase(const Args& a, Frame& F, int l, int j, bool first) {
    const int gw = F.vcu * NWAVES + F.wave; const int row0 = gw * 8;
    const int cond = cond_of_panel(row0 >> 8);
    const float* gp = a.norm_g + (size_t)(l * 3 + j) * D;
    const float* sh = (const float*)(a.ws + WS_MOD) + ((size_t)(l * 3 + cond) * NMOD + 3 * j) * D;
    const float* scl = sh + D;
    f32x4 gs[4][2], sv[4][2];
#pragma unroll
    for (int q = 0; q < 4; ++q)
#pragma unroll
        for (int e = 0; e < 2; ++e) { const int c = q * 512 + F.lane * 8 + e * 4; gs[q][e] = *(const f32x4*)(gp + c) * (*(const f32x4*)(scl + c) + 1.0f); sv[q][e] = *(const f32x4*)(sh + c); }
    f16* H = (f16*)(a.ws + WS_H);
    for (int r = 0; r < 8; ++r) {
        const int m = row0 + r;
        float* xo = a.out + (size_t)m * D;
        f32x4 v[4][2]; float ss = 0.f;
        if (first) {
            const float* xi = m < NPROMPT ? a.x_prompt + (size_t)m * D : a.x_sample + (size_t)(m - NPROMPT) * D;
            const int t = (m - NPROMPT) & (SEQ_S - 1); const float* pe = (const float*)(a.ws + WS_PE);
#pragma unroll
            for (int q = 0; q < 4; ++q)
#pragma unroll
                for (int e = 0; e < 2; ++e) { const int c = q * 512 + F.lane * 8 + e * 4; f32x4 x = *(const f32x4*)(xi + c);
                    if (m >= NPROMPT) x += *(const f32x4*)(pe + ((q & 1) * 64 + (q < 2 ? (t >> 6) : (t & 63))) * 512 + (c & 511));
                    *(f32x4*)(xo + c) = x; v[q][e] = x; }
        } else {
#pragma unroll
            for (int q = 0; q < 4; ++q)
#pragma unroll
                for (int e = 0; e < 2; ++e) v[q][e] = *(const f32x4*)(xo + q * 512 + F.lane * 8 + e * 4);
        }
#pragma unroll
        for (int q = 0; q < 4; ++q)
#pragma unroll
            for (int e = 0; e < 2; ++e) { const f32x4 t = v[q][e] * v[q][e]; ss += (t[0] + t[1]) + (t[2] + t[3]); }
        const float rstd = 1.0f / sqrtf(wave_sum(ss, F.lane) * (1.0f / D) + RMS_EPS);
#pragma unroll
        for (int q = 0; q < 4; ++q) { const f32x4 o0 = v[q][0] * rstd * gs[q][0] + sv[q][0], o1 = v[q][1] * rstd * gs[q][1] + sv[q][1];
            u32x4 w; w.x = pk2h(o0[0], o0[1]); w.y = pk2h(o0[2], o0[3]); w.z = pk2h(o1[0], o1[1]); w.w = pk2h(o1[2], o1[3]);
            *(u32x4*)(H + (size_t)(row0 + r) * D + q * 512 + F.lane * 8) = w; }
    }
}

__device__ __forceinline__ void final_phase(const Args& a, Frame& F) {
    const int gw = F.vcu * NWAVES + F.wave; const int row0 = gw * 8;
    f32x4 gs[8];
#pragma unroll
    for (int q = 0; q < 8; ++q) gs[q] = *(const f32x4*)(a.final_g + q * 256 + F.lane * 4);
    for (int r = 0; r < 8; ++r) {
        float* xr = a.out + (size_t)(row0 + r) * D;
        f32x4 v[8]; float ss = 0.f;
#pragma unroll
        for (int q = 0; q < 8; ++q) { v[q] = *(const f32x4*)(xr + q * 256 + F.lane * 4); const f32x4 t = v[q] * v[q]; ss += (t[0] + t[1]) + (t[2] + t[3]); }
        const float rstd = 1.0f / sqrtf(wave_sum(ss, F.lane) * (1.0f / D) + RMS_EPS);
#pragma unroll
        for (int q = 0; q < 8; ++q) *(f32x4*)(xr + q * 256 + F.lane * 4) = v[q] * rstd * gs[q];
    }
}

__device__ __forceinline__ void scan_phase(const Args& a, Frame& F, int kk) {
    const int gw = F.vcu * NWAVES + F.wave, NGW = F.G * NWAVES;
    const float* S = (const float*)(a.ws + WS_S); f16* CC = (f16*)(a.ws + WS_CC);
    const f32x2* AL = (const f32x2*)(a.ws + WS_AL);
    float* ns = a.out + (size_t)MTOK * D;
    const int p = F.lane;
    for (int it = gw; it < 34 * SSM_G * 2; it += NGW) {
        int sq, g, d;
        if (it < 512) { sq = 32 + (it >> 8); g = (it >> 1) & 127; d = it & 1; }
        else { const int r = it - 512; sq = r >> 8; g = (r >> 1) & 127; d = r & 1; }
        const int c0 = sq < 32 ? sq * 16 : 512 + (sq - 32) * 256, cnt = sq < 32 ? 16 : 256;
        const f32x2 al = AL[((size_t)(kk * 2 + d) * SSM_G + g) * SSM_P + p];
        float cr = 0.f, ci = 0.f;
        if (sq >= 32) { const float* sp = a.state_ssm + (((((size_t)(sq - 32) * 2 + kk) * 2 + d) * SSM_G + g) * SSM_P + p) * 2; cr = sp[0]; ci = sp[1]; }
        const size_t sbase = (size_t)g * 256 + d * 128 + p;
        f16* ccb = CC + (size_t)(d * 8 + (p >> 4)) * D + g * 16 + (p & 15);
        for (int s8 = 0; s8 < cnt; s8 += 8) {
            float sr[8], si[8];
#pragma unroll
            for (int j = 0; j < 8; ++j) { const int c = d == 0 ? c0 + s8 + j : c0 + cnt - 1 - s8 - j; const float* q = S + (size_t)c * (SSM_G * 256) + sbase; sr[j] = q[0]; si[j] = q[64]; }
#pragma unroll
            for (int j = 0; j < 8; ++j) { const int c = d == 0 ? c0 + s8 + j : c0 + cnt - 1 - s8 - j;
                f16* o = ccb + (size_t)c * 16 * D; o[0] = (f16)cr; o[4 * D] = (f16)ci;
                const float nr = al.x * cr - al.y * ci + sr[j], ni = al.x * ci + al.y * cr + si[j]; cr = nr; ci = ni; }
        }
        if (sq < 32) { float* o = ns + (((((size_t)sq * 2 + kk) * 2 + d) * SSM_G + g) * SSM_P + p) * 2; *(f32x2*)o = (f32x2){cr, ci}; }
    }
}

constexpr int N_PHASES = 45;
#ifndef MK_PER_PHASE
#define MK_PER_PHASE 0
#endif

#ifndef EN_MASK
#define EN_MASK 0xFFFF
#endif
#define EN(bit) if constexpr (((EN_MASK) >> (bit)) & 1)
#ifndef G_SP2
#define G_SP2 true
#endif
#ifndef G_ALIGN
#define G_ALIGN true
#endif
#ifndef REP_MASK
#define REP_MASK 0
#endif
#define REPCNT(bit) ((((REP_MASK) >> (bit)) & 1) ? 2 : 1)
#define REP(bit) for (int rep_ = 0; rep_ < REPCNT(bit); ++rep_)
typedef pg8::Prob<false> ProbStd;
typedef pg8::Prob<true> ProbChunk;

__device__ __forceinline__ ProbStd make_std(const void* A, unsigned lda2, size_t a_t, size_t a_z, const void* B, unsigned ldb2, size_t b_t, size_t b_z, int nt) {
    ProbStd p; p.A = (const char*)A; p.A2 = (const char*)A; p.B = (const char*)B; p.nt = nt; p.ksplit = nt; p.lda2 = lda2; p.ldb2 = ldb2; p.a_t = a_t; p.a_z = a_z; p.b_t = b_t; p.b_z = b_z; p.a_k = 128u; p.b_k = 128u; return p;
}

struct ArgsK {
    const GAS float* x_prompt; const GAS float* x_sample; const GAS float* state_ssm; const GAS float* c; const GAS float* c_ctx;
    const GAS float* w_ada; const GAS float* b_ada; const GAS float* norm_g; const GAS float* ffn_w_in; const GAS float* ffn_w_out;
    const GAS float* fourier_w_o; const GAS float* ssm_a_re; const GAS float* ssm_a_im; const GAS float* ssm_log_dt;
    const GAS float* ssm_b; const GAS float* ssm_c; const GAS float* ssm_d; const GAS float* ssm_w_glu; const GAS float* final_g;
    GAS float* out; GAS unsigned char* ws; int ph_lo, ph_hi;
};
static_assert(sizeof(ArgsK) == sizeof(Args), "ArgsK mirrors Args");
__device__ __forceinline__ Args kargs() {
    const __attribute__((address_space(4))) ArgsK* p = (const __attribute__((address_space(4))) ArgsK*)__builtin_amdgcn_kernarg_segment_ptr(); asm volatile("" : "+s"(p));
    Args a;
    a.x_prompt = (const float*)p->x_prompt; a.x_sample = (const float*)p->x_sample; a.state_ssm = (const float*)p->state_ssm; a.c = (const float*)p->c; a.c_ctx = (const float*)p->c_ctx;
    a.w_ada = (const float*)p->w_ada; a.b_ada = (const float*)p->b_ada; a.norm_g = (const float*)p->norm_g; a.ffn_w_in = (const float*)p->ffn_w_in; a.ffn_w_out = (const float*)p->ffn_w_out;
    a.fourier_w_o = (const float*)p->fourier_w_o; a.ssm_a_re = (const float*)p->ssm_a_re; a.ssm_a_im = (const float*)p->ssm_a_im; a.ssm_log_dt = (const float*)p->ssm_log_dt;
    a.ssm_b = (const float*)p->ssm_b; a.ssm_c = (const float*)p->ssm_c; a.ssm_d = (const float*)p->ssm_d; a.ssm_w_glu = (const float*)p->ssm_w_glu; a.final_g = (const float*)p->final_g;
    a.out = (float*)p->out; a.ws = (unsigned char*)p->ws; a.ph_lo = p->ph_lo; a.ph_hi = p->ph_hi;
    return a;
}

__global__ void __launch_bounds__(NTHR, 2) fwd_kernel(ArgsK a_unused) {
    extern __shared__ __attribute__((aligned(16))) unsigned char lds_raw[];
    Frame F0;
    F0.lds = (LAS unsigned char*)lds_raw;
    F0.tid = threadIdx.x; F0.lane = F0.tid & 63; F0.wave = __builtin_amdgcn_readfirstlane(F0.tid >> 6);
    F0.G = gridDim.x; F0.bx = blockIdx.x; { const int bx = blockIdx.x; F0.vcu = (F0.G % 8 == 0) ? (bx % 8) * (F0.G / 8) + bx / 8 : bx; }
    volatile LAS unsigned* MISC = (volatile LAS unsigned*)(F0.lds + MISC_OFF);
    if (F0.tid < 64) MISC[F0.tid] = 0u;
    __syncthreads();
    unsigned bar_x; int lo, hi;
    { const Args a = kargs(); unsigned* ctl = (unsigned*)(a.ws + WS_CTL); const XcdBarrier b0 = xcd_barrier_post(ctl + CW_BAR, MISC + 8); bar_x = b0.x; lo = a.ph_lo; hi = a.ph_hi; }
#define GRID_BAR() do { const Args ab = kargs(); XcdBarrier bb; bb.bar = (unsigned*)(ab.ws + WS_CTL) + CW_BAR; unsigned bx_ = bar_x; asm volatile("" : "+s"(bx_)); bb.x = bx_; bb.st = MISC + 8; xcd_barrier(bb); } while (0)
    int ph = 0;
#define PH_BEGIN if (ph >= lo && ph < hi) { const Args a = kargs(); unsigned char* ws = a.ws; \
    Frame F = F0; asm volatile("" : "+s"(F.vcu), "+s"(F.wave), "+s"(F.G), "+s"(F.bx)); asm volatile("" : "+v"(F.tid)); F.lane = F.tid & 63;   \
    f16* H = (f16*)(ws + WS_H); f16* ACT = (f16*)(ws + WS_ACT); f16* HT = (f16*)(ws + WS_HT); f16* Fm = (f16*)(ws + WS_F); \
    float* Sm = (float*)(ws + WS_S); f16* CC = (f16*)(ws + WS_CC); f16* Gm = (f16*)(ws + WS_G); \
    const float* modl = (const float*)(ws + WS_MOD) + (size_t)l * 3 * NMOD * D; \
    (void)H; (void)ACT; (void)HT; (void)Fm; (void)Sm; (void)CC; (void)Gm; (void)modl;
#define PH_END   if (ph + 1 < hi) GRID_BAR(); } ++ph;

    { const int l = 0;
    PH_BEGIN EN(0) REP(0) p0a_phase(a, F); PH_END
    PH_BEGIN EN(1) REP(1) p0b_phase(a, F); PH_END
    }
    for (int l = 0; l < DEPTH; ++l) {
        for (int s = 0; s < 2; ++s) {
            PH_BEGIN EN(2) REP(2) norm_phase(a, F, l, 2 * s, l == 0 && s == 0); PH_END
            PH_BEGIN EN(3) REP(3) {
                const f16* Wt = (const f16*)(ws + WS_WIN) + (size_t)(l * 2 + s) * D * 2 * DFF;
                ProbStd p = make_std(H, D * 2, (size_t)256 * D * 2, 0, Wt, D * 2, (size_t)256 * D * 2, 0, D / 64);
                pg8::StaticOrder S; S.init(MTOK, 2 * DFF, F.G, F.bx);
                EpiSwiGLU E{ACT};
                pg8::gemm_phase<ProbStd, EpiSwiGLU, pg8::StaticOrder, G_ALIGN, G_SP2>(F.lds, p, S, E);
            } PH_END
            PH_BEGIN EN(4) REP(4) {
                const f16* Wt = (const f16*)(ws + WS_WOUT) + (size_t)(l * 2 + s) * DFF * D;
                ProbStd p = make_std(ACT, DFF * 2, (size_t)256 * DFF * 2, 0, Wt, DFF * 2, (size_t)256 * DFF * 2, 0, DFF / 64);
                pg8::StaticOrder S; S.init(MTOK, D, F.G, F.bx);
                EpiResid E{a.out, modl + (size_t)(2 + 6 * s) * D, 0.5f / REPCNT(4)};
                pg8::gemm_phase<ProbStd, EpiResid, pg8::StaticOrder, G_ALIGN, G_SP2>(F.lds, p, S, E);
            } PH_END
            if (s == 0) {
                PH_BEGIN EN(2) REP(2) norm_phase(a, F, l, 1, false); PH_END
                const int kk = l >> 1;
                if ((l & 1) == 0) {
                    PH_BEGIN EN(5) REP(5) {
                        ProbStd p = make_std(ws + WS_W2T, 512, (size_t)256 * 512, 0, H, D * 2, (size_t)256 * D * 2, 512, 4);
                        SchedFA S{F.vcu}; EpiFA E{HT};
                        pg8::gemm_phase<ProbStd, EpiFA, SchedFA, true, true>(F.lds, p, S, E);
                    } PH_END
                    PH_BEGIN EN(6) REP(6) {
                        {
                            ProbStd p = make_std(ws + WS_CS4096, 16384, (size_t)256 * 16384, 0, HT + (size_t)NB_P * D * 2 * SEQ_P, 16384, (size_t)256 * 16384, (size_t)D * 16384, 128);
                            SchedFBs S{F.vcu}; EpiFB E{Fm, NPROMPT, SEQ_S, 1.0f / 1024.0f};
                            pg8::gemm_phase<ProbStd, EpiFB, SchedFBs, false, true>(F.lds, p, S, E);
                        }
                        {
                            ProbStd p = make_std(ws + WS_CS256, 1024, (size_t)256 * 1024, 0, HT, 1024, (size_t)256 * 1024, (size_t)D * 1024, 8);
                            SchedFBp S{F.vcu}; EpiFB E{Fm, 0, SEQ_P, 1.0f / 256.0f};
                            pg8::gemm_phase<ProbStd, EpiFB, SchedFBp, false, true>(F.lds, p, S, E);
                        }
                    } PH_END
                    PH_BEGIN EN(7) REP(7) {
                        const f16* Wt = (const f16*)(ws + WS_WO) + (size_t)kk * D * D;
                        ProbStd p = make_std(Fm, D * 2, (size_t)256 * D * 2, 0, Wt, D * 2, (size_t)256 * D * 2, 0, D / 64);
                        pg8::StaticOrder S; S.init(MTOK, D, F.G, F.bx);
                        EpiResid E{a.out, modl + (size_t)5 * D, 1.0f / REPCNT(7)};
                        pg8::gemm_phase<ProbStd, EpiResid, pg8::StaticOrder, G_ALIGN, G_SP2>(F.lds, p, S, E);
                    } PH_END
                } else {
                    PH_BEGIN EN(8) REP(8) {
                        ProbChunk p; p.A = (const char*)H; p.A2 = (const char*)H; p.B = (const char*)(ws + WS_W1) + (size_t)kk * SSM_G * 256 * 512; p.nt = 4; p.ksplit = 4;
                        p.lda2 = 65536u; p.ldb2 = 512u; p.a_t = (size_t)256 * 65536; p.a_z = 32; p.b_t = 0; p.b_z = (size_t)256 * 512; p.a_k = 16384u; p.b_k = 128u;
                        SchedS S{F.vcu}; EpiS1 E{Sm};
                        pg8::gemm_phase<ProbChunk, EpiS1, SchedS, true, true>(F.lds, p, S, E);
                    } PH_END
                    PH_BEGIN EN(9) REP(9) scan_phase(a, F, kk); PH_END
                    PH_BEGIN EN(10) REP(10) {
                        ProbChunk p; p.A = (const char*)H; p.A2 = (const char*)CC; p.B = (const char*)(ws + WS_TW) + (size_t)kk * SSM_G * 256 * 1024; p.nt = 8; p.ksplit = 4;
                        p.lda2 = 65536u; p.ldb2 = 1024u; p.a_t = (size_t)256 * 65536; p.a_z = 32; p.b_t = 0; p.b_z = (size_t)256 * 1024; p.a_k = 16384u; p.b_k = 128u;
                        SchedS S{F.vcu}; EpiS3 E{Gm};
                        pg8::gemm_phase<ProbChunk, EpiS3, SchedS, true, true>(F.lds, p, S, E);
                    } PH_END
                    PH_BEGIN EN(11) REP(11) {
                        const f16* Wt = (const f16*)(ws + WS_WGLU) + (size_t)kk * D * 2 * D;
                        ProbStd p = make_std(Gm, D * 2, (size_t)256 * D * 2, 0, Wt, D * 2, (size_t)256 * D * 2, 0, D / 64);
                        pg8::StaticOrder S; S.init(MTOK, 2 * D, F.G, F.bx);
                        EpiGLUResid E{a.out, modl + (size_t)5 * D, 1.0f / REPCNT(11)};
                        pg8::gemm_phase<ProbStd, EpiGLUResid, pg8::StaticOrder, G_ALIGN, G_SP2>(F.lds, p, S, E);
                    } PH_END
                }
            }
        }
    }
    { const int l = 0;
    PH_BEGIN EN(12) REP(12) final_phase(a, F); PH_END
    }
#undef PH_BEGIN
#undef PH_END
}

extern "C" void kernel_launch(void* const* d_in, const int* in_sizes, int n_in, void* d_out, int out_size, void* d_ws, size_t ws_size, hipStream_t stream) {
    static int grid = 0;
    if (grid == 0) {
        if (n_in != 19 || ws_size < WS_END) { fprintf(stderr, "kernel_launch: unexpected n_in %d or ws_size %zu (need %zu)\n", n_in, ws_size, (size_t)WS_END); grid = -1; return; }
        int dev = 0, cus = 0, per_cu = 0;
        if (hipGetDevice(&dev) != hipSuccess || hipDeviceGetAttribute(&cus, hipDeviceAttributeMultiprocessorCount, dev) != hipSuccess) { grid = -1; return; }
        if (hipFuncSetAttribute((const void*)fwd_kernel, hipFuncAttributeMaxDynamicSharedMemorySize, LDS_BYTES) != hipSuccess) { fprintf(stderr, "kernel_launch: hipFuncSetAttribute failed\n"); grid = -1; return; }
        if (hipOccupancyMaxActiveBlocksPerMultiprocessor(&per_cu, (const void*)fwd_kernel, NTHR, LDS_BYTES) != hipSuccess || per_cu < 1) fprintf(stderr, "kernel_launch: occupancy query reports %d\n", per_cu);
        (void)hipGetLastError();
        grid = cus < 256 ? cus : 256;
    }
    if (grid < 0) return;
    (void)hipMemsetAsync((char*)d_ws + WS_CTL, 0, CTL_ZERO_BYTES, stream);
    ArgsK a{};
    a.x_prompt = (const GAS float*)d_in[0]; a.x_sample = (const GAS float*)d_in[1]; a.state_ssm = (const GAS float*)d_in[2]; a.c = (const GAS float*)d_in[3]; a.c_ctx = (const GAS float*)d_in[4];
    a.w_ada = (const GAS float*)d_in[5]; a.b_ada = (const GAS float*)d_in[6]; a.norm_g = (const GAS float*)d_in[7]; a.ffn_w_in = (const GAS float*)d_in[8]; a.ffn_w_out = (const GAS float*)d_in[9];
    a.fourier_w_o = (const GAS float*)d_in[10]; a.ssm_a_re = (const GAS float*)d_in[11]; a.ssm_a_im = (const GAS float*)d_in[12]; a.ssm_log_dt = (const GAS float*)d_in[13];
    a.ssm_b = (const GAS float*)d_in[14]; a.ssm_c = (const GAS float*)d_in[15]; a.ssm_d = (const GAS float*)d_in[16]; a.ssm_w_glu = (const GAS float*)d_in[17]; a.final_g = (const GAS float*)d_in[18];
    a.out = (GAS float*)d_out; a.ws = (GAS unsigned char*)d_ws;
#if MK_PER_PHASE
    for (int i = 0; i < N_PHASES; ++i) { a.ph_lo = i; a.ph_hi = i + 1; hipLaunchKernelGGL(fwd_kernel, dim3(grid), dim3(NTHR), LDS_BYTES, stream, a); }
#else
    a.ph_lo = 0; a.ph_hi = N_PHASES;
    hipLaunchKernelGGL(fwd_kernel, dim3(grid), dim3(NTHR), LDS_BYTES, stream, a);
#endif
    const hipError_t le = hipPeekAtLastError();
    if (le != hipSuccess) fprintf(stderr, "kernel_launch: launch failed: %s\n", hipGetErrorName(le));
}
```

```cpp
#include <hip/hip_runtime.h>
#include <cstdio>
#include <cstdint>

#define LAS __attribute__((address_space(3)))
#define GAS __attribute__((address_space(1)))
typedef _Float16 f16;
typedef _Float16 f16x8 __attribute__((ext_vector_type(8)));
typedef _Float16 f16x4 __attribute__((ext_vector_type(4)));
typedef _Float16 f16x2 __attribute__((ext_vector_type(2)));
typedef float f32x4 __attribute__((ext_vector_type(4)));
typedef float f32x2 __attribute__((ext_vector_type(2)));
typedef unsigned u32x4 __attribute__((ext_vector_type(4)));
typedef unsigned u32x2 __attribute__((ext_vector_type(2)));

constexpr int D = 2048, DFF = 5632, MTOK = 16384, NPROMPT = 8192, SEQ_P = 256, SEQ_S = 4096, NB_P = 32, NB_S = 2;
constexpr int DEPTH = 4, NMOD = 9, SSM_G = 128, SSM_P = 64, SSM_H = 16;
constexpr float RMS_EPS = 1e-6f;
constexpr int NWAVES = 8, NTHR = 512;

constexpr size_t MiB = 1u << 20;
constexpr size_t WS_CTL = 0, CTL_ZERO_BYTES = 1 * MiB;
constexpr size_t WS_MOD = 1 * MiB;
constexpr size_t WS_MODP = 2 * MiB;
constexpr size_t WS_AL = 18 * MiB;
constexpr size_t WS_W2T = 19 * MiB;
constexpr size_t WS_CS256 = 19 * MiB + 512 * 1024;
constexpr size_t WS_PE = 19 * MiB + 768 * 1024;
constexpr size_t WS_HCN = 18 * MiB + 512 * 1024;
constexpr size_t WS_CS4096 = 20 * MiB;
constexpr size_t WS_W1 = 84 * MiB;
constexpr size_t WS_TW = 116 * MiB;
constexpr size_t WS_WO = 180 * MiB;
constexpr size_t WS_WGLU = 196 * MiB;
constexpr size_t WS_WIN = 228 * MiB;
constexpr size_t WS_WOUT = 580 * MiB;
constexpr size_t WS_H = 756 * MiB;
constexpr size_t WS_ACT = 820 * MiB;
constexpr size_t WS_HT = 820 * MiB;
constexpr size_t WS_F = 948 * MiB;
constexpr size_t WS_S = 820 * MiB;
constexpr size_t WS_CC = 948 * MiB;
constexpr size_t WS_G = 1012 * MiB;
constexpr size_t WS_END = 1076 * MiB;
constexpr int CW_BAR = 4096;

constexpr int STAGE_BYTES = 131072;
constexpr int MISC_OFF = STAGE_BYTES;
constexpr int LDS_BYTES = 147456;

namespace pg8 {
constexpr int BM = 256, BK = 64, HALF = 128, HTB = HALF * BK * 2, NXCD = 8, WGM = 8;
__host__ __device__ __forceinline__ int lds_byte(int r, int c) { const int st = (r >> 4) * 2 + (c >> 5), rr = r & 15, cc = c & 31, ob = rr * 64 + cc * 2; return st * 1024 + (ob ^ (((ob >> 9) & 1) << 5)); }
__host__ __device__ __forceinline__ void stage_rc(int b, int& R, int& C) { const int st = b / 1024, sb = b % 1024, swz = sb ^ (((sb >> 9) & 1) << 5); R = (st >> 1) * 16 + swz / 64; C = (st & 1) * 32 + (swz % 64) / 2; }
__host__ __device__ __forceinline__ int perm32(int rho) { const int n = rho >> 4, i = rho & 15; return 8 * (i >> 2) + 4 * n + (i & 3); }

struct Unit { int pm, pn, z; };

template <bool CHUNK> struct Prob {
    const char* A; const char* A2; const char* B; int nt, ksplit; unsigned lda2, ldb2; size_t a_t, a_z, b_t, b_z; unsigned a_k, b_k;
    __device__ __forceinline__ const char* a_ptr(const Unit& u, int t) const { const char* p = (t < ksplit) ? A + (size_t)t * a_k : A2 + (size_t)(t - ksplit) * a_k; return p + (size_t)u.pm * a_t + (size_t)u.z * a_z; }
    __device__ __forceinline__ const char* b_ptr(const Unit& u, int t) const { return B + (size_t)t * b_k + (size_t)u.pn * b_t + (size_t)u.z * b_z; }
    __device__ __forceinline__ unsigned a_off(int R, int C) const { return CHUNK ? (unsigned)R * lda2 + (unsigned)(C >> 4) * 4096u + (unsigned)(C & 15) * 2u : (unsigned)R * lda2 + (unsigned)C * 2u; }
    __device__ __forceinline__ unsigned b_off(int R, int C) const { return (unsigned)R * ldb2 + (unsigned)C * 2u; }
};

struct ProbFA : Prob<false> {
    size_t b_m;
    __device__ __forceinline__ const char* b_ptr(const Unit& u, int t) const { return B + (size_t)t * b_k + (size_t)u.pn * b_t + (size_t)u.z * b_z + ((u.pn >= 32 && u.pm == 1) ? b_m : (size_t)0); }
};

struct StaticOrder {
    int nM, nN, nwg, G, c;
    __device__ void init(int M, int N, int G_, int c_) { nM = M / BM; nN = N / BM; nwg = nM * nN; G = G_; c = c_; }
    __device__ bool next(int i, Unit& u) const {
        const long L = (long)i * G + c; if (L >= nwg) return false;
        int wgid = (int)L; { const int q = nwg / NXCD, r = nwg % NXCD, xcd = wgid % NXCD, off = wgid / NXCD; wgid = (xcd < r ? xcd * (q + 1) : r * (q + 1) + (xcd - r) * q) + off; }
        const int nig = WGM * nN, gid = wgid / nig, fm = gid * WGM, gsz = (nM - fm) < WGM ? (nM - fm) : WGM;
        u.pm = fm + ((wgid % nig) % gsz); u.pn = (wgid % nig) / gsz; u.z = 0; return true;
    }
};

template <class P, class Epi, class Sched, bool ALIGN_EPI, bool SP2>
__device__ __forceinline__ void gemm_phase(LAS unsigned char* lds, const P& p, const Sched& S, const Epi& E) {
    int tid_ = threadIdx.x; asm volatile("" : "+v"(tid_));
    const int tid = tid_, wid = __builtin_amdgcn_readfirstlane(tid >> 6), lane = tid & 63, wr = wid >> 2, wc = wid & 3, fr = lane & 15, fq = lane >> 4;
    int nt = p.nt; asm volatile("" : "+s"(nt));
    unsigned voffA[2], voffB[2];
#pragma unroll
    for (int i = 0; i < 2; ++i) { int R, C; stage_rc(tid * 16 + i * 8192, R, C); const int Rb = Epi::PERM ? ((R & ~31) + perm32(R & 31)) : R;
        voffA[i] = p.a_off(R, C); voffB[i] = p.b_off(Rb, C); }
    const size_t ahs = (size_t)HALF * p.lda2, bhs = (size_t)HALF * p.ldb2;
    const unsigned ldsw = (unsigned)wid * 1024u;
    const int aoff = lds_byte(wr * 64 + fr, fq * 8), boff = lds_byte(wc * 32 + fr, fq * 8);
#define PG8_SA(b, h) (((b) * 2 + (h)) * HTB)
#define PG8_SB(b, h) ((4 + (b) * 2 + (h)) * HTB)
#define PG8_STAGE(bufoff, gbase, voff) do { _Pragma("unroll") for (int _i = 0; _i < 2; ++_i) \
        __builtin_amdgcn_global_load_lds((const unsigned*)((const char*)(gbase) + (voff)[_i]), (LAS unsigned*)(lds + (bufoff) + ldsw + _i * 8192), 16, 0, 0); } while (0)
#define PG8_LDA(dst, b, h) do { _Pragma("unroll") for (int m = 0; m < 4; ++m) _Pragma("unroll") for (int k = 0; k < 2; ++k) dst[m][k] = *(const LAS f16x8*)(lds + PG8_SA(b, h) + aoff + m * 2048 + k * 1024); } while (0)
#define PG8_LDB(dst, b, h) do { _Pragma("unroll") for (int n = 0; n < 2; ++n) _Pragma("unroll") for (int k = 0; k < 2; ++k) dst[n][k] = *(const LAS f16x8*)(lds + PG8_SB(b, h) + boff + n * 2048 + k * 1024); } while (0)
#define PG8_MMA(ai, bj, At, Bt) do { __builtin_amdgcn_s_setprio(1); _Pragma("unroll") for (int m = 0; m < 4; ++m) _Pragma("unroll") for (int n = 0; n < 2; ++n) _Pragma("unroll") for (int k = 0; k < 2; ++k) \
        acc[ai][bj][m][n] = __builtin_amdgcn_mfma_f32_16x16x32_f16(Bt[n][k], At[m][k], acc[ai][bj][m][n], 0, 0, 0); __builtin_amdgcn_s_setprio(0); } while (0)
#define PG8_WAIT_V(n) asm volatile("s_waitcnt vmcnt(" #n ")" ::: "memory")
#define PG8_WAIT_L(n) asm volatile("s_waitcnt lgkmcnt(" #n ")" ::: "memory")
#define PG8_BAR __builtin_amdgcn_s_barrier()
#define PG8_SCHED __builtin_amdgcn_sched_barrier(0)
    Unit cur, nxt; int ui = 0;
    if (!S.next(0, cur)) return;
    f32x4 acc[2][2][4][2];
#pragma unroll
    for (int a = 0; a < 2; ++a)
#pragma unroll
        for (int b = 0; b < 2; ++b)
#pragma unroll
            for (int m = 0; m < 4; ++m)
#pragma unroll
                for (int n = 0; n < 2; ++n) acc[a][b][m][n] = (f32x4){0.f, 0.f, 0.f, 0.f};
    f16x8 At[4][2], B0[2][2], B1[2][2];
    {
        const char* cA0 = p.a_ptr(cur, 0); const char* cB0 = p.b_ptr(cur, 0); const char* cA1 = p.a_ptr(cur, 1); const char* cB1 = p.b_ptr(cur, 1);
        if constexpr (SP2) {
            PG8_STAGE(PG8_SB(0, 0), cB0, voffB); PG8_STAGE(PG8_SB(0, 1), cB0 + bhs, voffB); PG8_STAGE(PG8_SA(0, 0), cA0, voffA); PG8_STAGE(PG8_SA(0, 1), cA0 + ahs, voffA);
            if (wr == 1) PG8_BAR;
            PG8_WAIT_V(2); PG8_BAR;
            PG8_STAGE(PG8_SB(1, 0), cB1, voffB); PG8_STAGE(PG8_SA(1, 0), cA1, voffA); PG8_STAGE(PG8_SB(1, 1), cB1 + bhs, voffB);
            PG8_WAIT_V(6); PG8_BAR;
        } else {
            PG8_STAGE(PG8_SB(0, 0), cB0, voffB); PG8_STAGE(PG8_SA(0, 0), cA0, voffA); PG8_STAGE(PG8_SB(0, 1), cB0 + bhs, voffB); PG8_STAGE(PG8_SA(0, 1), cA0 + ahs, voffA);
            if (wr == 1) PG8_BAR;
            PG8_WAIT_V(4); PG8_BAR;
            PG8_STAGE(PG8_SB(1, 0), cB1, voffB); PG8_STAGE(PG8_SA(1, 0), cA1, voffA); PG8_STAGE(PG8_SB(1, 1), cB1 + bhs, voffB);
            PG8_WAIT_V(6); PG8_BAR;
        }
    }
    for (;;) {
        const bool has_next = S.next(ui + 1, nxt);
        const Unit nu = has_next ? nxt : cur;
#pragma nounroll
        for (int t = 0; t < nt; t += 2) {
            const bool last = (t == nt - 2);
            const char* a1 = p.a_ptr(cur, t + 1);
            const char* a2 = last ? p.a_ptr(nu, 0) : p.a_ptr(cur, t + 2); const char* b2 = last ? p.b_ptr(nu, 0) : p.b_ptr(cur, t + 2);
            const char* a3 = last ? p.a_ptr(nu, 1) : p.a_ptr(cur, t + 3); const char* b3 = last ? p.b_ptr(nu, 1) : p.b_ptr(cur, t + 3);
            if constexpr (SP2) {
            PG8_LDB(B0, 0, 0); PG8_LDB(B1, 0, 1); PG8_SCHED; PG8_LDA(At, 0, 0); PG8_STAGE(PG8_SA(1, 1), a1 + ahs, voffA);
            PG8_WAIT_V(8); PG8_WAIT_L(0); PG8_BAR; PG8_MMA(0, 0, At, B0); PG8_MMA(0, 1, At, B1); PG8_BAR; PG8_SCHED;
            PG8_LDA(At, 0, 1); PG8_STAGE(PG8_SB(0, 0), b2, voffB); PG8_STAGE(PG8_SB(0, 1), b2 + bhs, voffB); PG8_STAGE(PG8_SA(0, 0), a2, voffA);
            PG8_WAIT_V(8); PG8_WAIT_L(0); PG8_BAR; PG8_MMA(1, 0, At, B0); PG8_MMA(1, 1, At, B1); PG8_BAR; PG8_SCHED;
            PG8_LDB(B0, 1, 0); PG8_LDB(B1, 1, 1); PG8_SCHED; PG8_LDA(At, 1, 0); PG8_STAGE(PG8_SA(0, 1), a2 + ahs, voffA);
            PG8_WAIT_V(8); PG8_WAIT_L(0); PG8_BAR; PG8_MMA(0, 0, At, B0); PG8_MMA(0, 1, At, B1); PG8_BAR; PG8_SCHED;
            PG8_LDA(At, 1, 1); PG8_STAGE(PG8_SB(1, 0), b3, voffB); PG8_STAGE(PG8_SB(1, 1), b3 + bhs, voffB); PG8_STAGE(PG8_SA(1, 0), a3, voffA);
            PG8_WAIT_V(8); PG8_WAIT_L(0); PG8_BAR; PG8_MMA(1, 0, At, B0); PG8_MMA(1, 1, At, B1); PG8_BAR; PG8_SCHED;
            } else {
            PG8_LDB(B0, 0, 0); PG8_SCHED; PG8_LDA(At, 0, 0); PG8_STAGE(PG8_SA(1, 1), a1 + ahs, voffA);
            PG8_WAIT_L(8); PG8_BAR; PG8_WAIT_L(0); PG8_MMA(0, 0, At, B0); PG8_BAR; PG8_SCHED;
            PG8_LDB(B1, 0, 1); PG8_STAGE(PG8_SB(0, 0), b2, voffB);
            PG8_BAR; PG8_WAIT_L(0); PG8_MMA(0, 1, At, B1); PG8_BAR;
            PG8_LDA(At, 0, 1); PG8_STAGE(PG8_SA(0, 0), a2, voffA);
            PG8_BAR; PG8_WAIT_L(0); PG8_MMA(1, 0, At, B0); PG8_BAR; PG8_SCHED;
            PG8_STAGE(PG8_SB(0, 1), b2 + bhs, voffB);
            PG8_WAIT_V(6); PG8_BAR; PG8_MMA(1, 1, At, B1); PG8_BAR;
            PG8_LDB(B0, 1, 0); PG8_SCHED; PG8_LDA(At, 1, 0); PG8_STAGE(PG8_SA(0, 1), a2 + ahs, voffA);
            PG8_WAIT_L(8); PG8_BAR; PG8_WAIT_L(0); PG8_MMA(0, 0, At, B0); PG8_BAR; PG8_SCHED;
            PG8_LDB(B1, 1, 1); PG8_STAGE(PG8_SB(1, 0), b3, voffB);
            PG8_BAR; PG8_WAIT_L(0); PG8_MMA(0, 1, At, B1); PG8_BAR;
            PG8_LDA(At, 1, 1); PG8_STAGE(PG8_SA(1, 0), a3, voffA);
            PG8_BAR; PG8_WAIT_L(0); PG8_MMA(1, 0, At, B0); PG8_BAR; PG8_SCHED;
            PG8_STAGE(PG8_SB(1, 1), b3 + bhs, voffB);
            PG8_WAIT_V(6); PG8_BAR; PG8_MMA(1, 1, At, B1); PG8_BAR;
            }
        }
        if constexpr (ALIGN_EPI) { if (wr == 0) PG8_BAR; }
        E(acc, cur, wr, wc, fr, fq);
        if (!has_next) break;
#pragma unroll
        for (int a = 0; a < 2; ++a)
#pragma unroll
            for (int b = 0; b < 2; ++b)
#pragma unroll
                for (int m = 0; m < 4; ++m)
#pragma unroll
                    for (int n = 0; n < 2; ++n) acc[a][b][m][n] = (f32x4){0.f, 0.f, 0.f, 0.f};
        cur = nxt; ++ui;
        if constexpr (ALIGN_EPI) { if (wr == 1) PG8_BAR; }
    }
    PG8_WAIT_V(0);
    if constexpr (!ALIGN_EPI) { if (wr == 0) PG8_BAR; }
    PG8_BAR;
#undef PG8_SA
#undef PG8_SB
#undef PG8_STAGE
#undef PG8_LDA
#undef PG8_LDB
#undef PG8_MMA
#undef PG8_WAIT_V
#undef PG8_WAIT_L
#undef PG8_BAR
#undef PG8_SCHED
}
}
using pg8::Unit;

#define RLX_AGENT __ATOMIC_RELAXED, __HIP_MEMORY_SCOPE_AGENT
#define LDS_WAIT() asm volatile("s_waitcnt lgkmcnt(0)" ::: "memory")
#define VM_WAIT() asm volatile("s_waitcnt vmcnt(0)" ::: "memory")
__device__ __forceinline__ unsigned pk2h(float lo, float hi) { f32x2 v = {lo, hi}; f16x2 h = __builtin_convertvector(v, f16x2); return __builtin_bit_cast(unsigned, h); }
__device__ __forceinline__ float wave_sum(float v, int lane) {
#pragma unroll
    for (int o = 1; o < 64; o <<= 1) v += __builtin_bit_cast(float, __builtin_amdgcn_ds_bpermute((lane ^ o) << 2, __builtin_bit_cast(int, v)));
    return v;
}
__device__ __forceinline__ float sigmoid_f(float x) { return __builtin_amdgcn_rcpf(1.0f + __builtin_amdgcn_exp2f(-1.4426950408889634f * x)); }
__device__ __forceinline__ float gelu_tanh_f(float x) {
    const float u2 = 1.5957691216057308f * (x + 0.044715f * x * x * x);
    return x * sigmoid_f(u2);
}
__device__ __forceinline__ int cond_of_panel(int pm) { return pm < 32 ? 0 : (pm < 48 ? 1 : 2); }

#define XB_TMO      128
#define XB_XCNT(j)  (256  + 64 * (j))
#define XB_XSUB(j)  (1280 + 64 * (j))
#define XB_XGEN(j)  (2304 + 64 * (j))
#define XB_TOP      3328
#define XB_TOPGEN   3392
#define XCD_BAR_WORDS 3456
#define XB_SPIN_CAP (1u << 18)
__device__ __forceinline__ unsigned xb_ld(unsigned* p)              { return __hip_atomic_load(p, __ATOMIC_RELAXED, __HIP_MEMORY_SCOPE_AGENT); }
__device__ __forceinline__ unsigned xb_add(unsigned* p, unsigned v) { return __hip_atomic_fetch_add(p, v, __ATOMIC_RELAXED, __HIP_MEMORY_SCOPE_AGENT); }
__device__ __forceinline__ unsigned xb_xcc_id() { return (unsigned)__builtin_amdgcn_s_getreg((3 << 11) | 20) & 0xFu; }
#define XB_SPIN(cond, bar) do { unsigned _sp = 0; while (cond) { __builtin_amdgcn_s_sleep(1); \
    if ((++_sp & 255u) == 0u) { if (xb_ld(&(bar)[XB_TMO])) break; if (_sp > XB_SPIN_CAP) { atomicAdd(&(bar)[XB_TMO], 1u); break; } } } } while (0)
struct XcdBarrier { unsigned* bar; unsigned x; volatile LAS unsigned* st; };
__device__ __forceinline__ XcdBarrier xcd_barrier_post(unsigned* bar, volatile LAS unsigned* st) {
    XcdBarrier b; b.bar = bar; b.x = xb_xcc_id(); b.st = st;
    if (threadIdx.x == 0) (void)xb_add(&bar[XB_XCNT(b.x)], 1u);
    return b;
}
__device__ __forceinline__ void xcd_barrier_complete(unsigned* bar, unsigned x, unsigned& nloc, unsigned& nx) {
    const unsigned G = gridDim.x * gridDim.y * gridDim.z;
    unsigned sum, cnt, mine, sp = 0u;
    for (;;) {
        sum = 0u; cnt = 0u; mine = 0u;
#pragma unroll
        for (unsigned j = 0; j < 16; ++j) { const unsigned c = xb_ld(&bar[XB_XCNT(j)]); sum += c; cnt += (c > 0u) ? 1u : 0u; mine = (j == x) ? c : mine; }
        if (sum == G) break;
        __builtin_amdgcn_s_sleep(1);
        if ((++sp & 255u) == 0u) { if (xb_ld(&bar[XB_TMO])) break; if (sp > XB_SPIN_CAP) { atomicAdd(&bar[XB_TMO], 1u); break; } }
    }
    nloc = mine > 0u ? mine : 1u; nx = cnt > 0u ? cnt : 1u;
}
__device__ __forceinline__ void xcd_barrier(const XcdBarrier& b) {
    asm volatile("s_waitcnt vmcnt(0)" ::: "memory");
    __syncthreads();
    if (threadIdx.x == 0) {
        unsigned* bar = b.bar;
        __builtin_amdgcn_s_waitcnt(0);
        unsigned nloc = b.st[0], nx = b.st[1];
        if (nloc == 0u) { xcd_barrier_complete(bar, b.x, nloc, nx); b.st[0] = nloc; b.st[1] = nx; }
        const unsigned old = xb_add(&bar[XB_XSUB(b.x)], 1u);
        const unsigned gen = old / nloc;
        if (old + 1u == (gen + 1u) * nloc) {
            __builtin_amdgcn_fence(__ATOMIC_RELEASE, "agent");
            asm volatile("s_waitcnt vmcnt(0)" ::: "memory");
            const unsigned og = xb_add(&bar[XB_TOP], 1u);
            const unsigned tg = og / nx;
            if (og + 1u == (tg + 1u) * nx) xb_add(&bar[XB_TOPGEN], 1u);
            else XB_SPIN(xb_ld(&bar[XB_TOPGEN]) == tg, bar);
            __builtin_amdgcn_fence(__ATOMIC_ACQUIRE, "agent");
            xb_add(&bar[XB_XGEN(b.x)], 1u);
            asm volatile("s_waitcnt vmcnt(0)" ::: "memory");
        } else {
            XB_SPIN(xb_ld(&bar[XB_XGEN(b.x)]) == gen, bar);
            __builtin_amdgcn_fence(__ATOMIC_ACQUIRE, "agent");
            asm volatile("s_waitcnt vmcnt(0)" ::: "memory");
        }
    }
    __syncthreads();
}

struct Args {
    const float* x_prompt; const float* x_sample; const float* state_ssm; const float* c; const float* c_ctx;
    const float* w_ada; const float* b_ada; const float* norm_g; const float* ffn_w_in; const float* ffn_w_out;
    const float* fourier_w_o; const float* ssm_a_re; const float* ssm_a_im; const float* ssm_log_dt;
    const float* ssm_b; const float* ssm_c; const float* ssm_d; const float* ssm_w_glu; const float* final_g;
    float* out; unsigned char* ws; int ph_lo, ph_hi;
};
struct Frame {
    LAS unsigned char* lds; int tid, lane, wave, vcu, G, bx;
};

struct EpiSwiGLU {
    static constexpr bool PERM = true;
    f16* O;
    __device__ __forceinline__ void operator()(const f32x4 (&acc)[2][2][4][2], const Unit& u, int wr, int wc, int fr, int fq) const {
        const int row0 = u.pm * 256 + wr * 64 + fr, col0 = u.pn * 128 + wc * 32 + 8 * fq;
#pragma unroll
        for (int ai = 0; ai < 2; ++ai)
#pragma unroll
            for (int m = 0; m < 4; ++m) {
                const f32x4 g0 = acc[ai][0][m][0], g1 = acc[ai][0][m][1], u0 = acc[ai][1][m][0], u1 = acc[ai][1][m][1];
                float r[8];
#pragma unroll
                for (int j = 0; j < 4; ++j) { r[j] = g0[j] * sigmoid_f(g0[j]) * u0[j]; r[4 + j] = g1[j] * sigmoid_f(g1[j]) * u1[j]; }
                u32x4 w; w.x = pk2h(r[0], r[1]); w.y = pk2h(r[2], r[3]); w.z = pk2h(r[4], r[5]); w.w = pk2h(r[6], r[7]);
                *(u32x4*)(O + (size_t)(row0 + ai * 128 + m * 16) * DFF + col0) = w;
            }
    }
};
struct EpiResid {
    static constexpr bool PERM = false;
    float* X; const float* modv; float coef;
    __device__ __forceinline__ void operator()(const f32x4 (&acc)[2][2][4][2], const Unit& u, int wr, int wc, int fr, int fq) const {
        const int row0 = u.pm * 256 + wr * 64 + fr, col0 = u.pn * 256 + wc * 32 + 4 * fq;
        const float* mv = modv + (size_t)cond_of_panel(u.pm) * (NMOD * D) + col0;
        f32x4 gv[2][2];
#pragma unroll
        for (int bj = 0; bj < 2; ++bj)
#pragma unroll
            for (int n = 0; n < 2; ++n) gv[bj][n] = *(const f32x4*)(mv + bj * 128 + n * 16) * coef;
#pragma unroll
        for (int ai = 0; ai < 2; ++ai)
#pragma unroll
            for (int m = 0; m < 4; ++m) { float* rowp = X + (size_t)(row0 + ai * 128 + m * 16) * D + col0;
#pragma unroll
                for (int bj = 0; bj < 2; ++bj)
#pragma unroll
                    for (int n = 0; n < 2; ++n) { f32x4* q = (f32x4*)(rowp + bj * 128 + n * 16); *q = *q + gv[bj][n] * acc[ai][bj][m][n]; } }
    }
};
struct EpiGLUResid {
    static constexpr bool PERM = true;
    float* X; const float* modv; float coef;
    __device__ __forceinline__ void operator()(const f32x4 (&acc)[2][2][4][2], const Unit& u, int wr, int wc, int fr, int fq) const {
        const int row0 = u.pm * 256 + wr * 64 + fr, col0 = u.pn * 128 + wc * 32 + 8 * fq;
        const float* mv = modv + (size_t)cond_of_panel(u.pm) * (NMOD * D) + col0;
        const f32x4 m0 = *(const f32x4*)mv * coef, m1 = *(const f32x4*)(mv + 4) * coef;
#pragma unroll
        for (int ai = 0; ai < 2; ++ai)
#pragma unroll
            for (int m = 0; m < 4; ++m) { float* rowp = X + (size_t)(row0 + ai * 128 + m * 16) * D + col0;
                const f32x4 v0 = acc[ai][0][m][0], v1 = acc[ai][0][m][1], g0 = acc[ai][1][m][0], g1 = acc[ai][1][m][1];
                f32x4 o0, o1;
#pragma unroll
                for (int j = 0; j < 4; ++j) { o0[j] = v0[j] * sigmoid_f(g0[j]); o1[j] = v1[j] * sigmoid_f(g1[j]); }
                f32x4* q = (f32x4*)rowp; q[0] = q[0] + m0 * o0; q[1] = q[1] + m1 * o1; }
    }
};
struct EpiFA {
    static constexpr bool PERM = true;
    f16* HT;
    __device__ __forceinline__ void operator()(const f32x4 (&acc)[2][2][4][2], const Unit& u, int wr, int wc, int fr, int fq) const {
        const int P = u.pn; const int n = P < 32 ? SEQ_P : SEQ_S / 2;
        const size_t hb = P < 32 ? (size_t)P * (D * 2 * SEQ_P) : (size_t)NB_P * (D * 2 * SEQ_P) + (size_t)((P - 32) >> 4) * ((size_t)D * SEQ_S);
        const int t0 = (P < 32 ? 0 : ((P - 32) & 15) * 256) + wc * 32 + 8 * fq;
        const int q0 = wr * 64 + fr;
#pragma unroll
        for (int ai = 0; ai < 2; ++ai)
#pragma unroll
            for (int m = 0; m < 4; ++m) { const int q = q0 + ai * 128 + m * 16;
                f16* rowp = HT + hb + ((size_t)(u.z * 256 + q) * 2 + u.pm) * n + t0;
#pragma unroll
                for (int bj = 0; bj < 2; ++bj) { const f32x4 v0 = acc[ai][bj][m][0], v1 = acc[ai][bj][m][1];
                    u32x4 w; w.x = pk2h(v0[0], v0[1]); w.y = pk2h(v0[2], v0[3]); w.z = pk2h(v1[0], v1[1]); w.w = pk2h(v1[2], v1[3]);
                    *(u32x4*)(rowp + bj * 128) = w; } }
    }
};
struct EpiFB {
    static constexpr bool PERM = true;
    f16* F; int row0, zrows; float scale; const float* hcn;
    __device__ __forceinline__ void operator()(const f32x4 (&acc)[2][2][4][2], const Unit& u, int wr, int wc, int fr, int fq) const {
        const int r0 = row0 + u.z * zrows + u.pm * 256 + wr * 64 + fr, col0 = u.pn * 256 + wc * 32 + 8 * fq;
        f32x4 nq[2][2];
#pragma unroll
        for (int bj = 0; bj < 2; ++bj)
#pragma unroll
            for (int n = 0; n < 2; ++n) { nq[bj][n] = (f32x4){0.f, 0.f, 0.f, 0.f};
                if (hcn) { const f32x4 h = *(const f32x4*)(hcn + (size_t)u.z * D + col0 + bj * 128 + n * 4); nq[bj][n] = (fr & 1) ? -h : h; } }
#pragma unroll
        for (int ai = 0; ai < 2; ++ai)
#pragma unroll
            for (int m = 0; m < 4; ++m) { f16* rowp = F + (size_t)(r0 + ai * 128 + m * 16) * D + col0;
#pragma unroll
                for (int bj = 0; bj < 2; ++bj) { const f32x4 v0 = (acc[ai][bj][m][0] + nq[bj][0]) * scale, v1 = (acc[ai][bj][m][1] + nq[bj][1]) * scale;
                    u32x4 w; w.x = pk2h(v0[0], v0[1]); w.y = pk2h(v0[2], v0[3]); w.z = pk2h(v1[0], v1[1]); w.w = pk2h(v1[2], v1[3]);
                    *(u32x4*)(rowp + bj * 128) = w; } }
    }
};
struct EpiS1 {
    static constexpr bool PERM = false;
    float* S;
    __device__ __forceinline__ void operator()(const f32x4 (&acc)[2][2][4][2], const Unit& u, int wr, int wc, int fr, int fq) const {
        const int r0 = u.pm * 256 + wr * 64 + fr, col0 = wc * 32 + 4 * fq;
#pragma unroll
        for (int ai = 0; ai < 2; ++ai)
#pragma unroll
            for (int m = 0; m < 4; ++m) { float* rowp = S + ((size_t)(r0 + ai * 128 + m * 16) * SSM_G + u.z) * 256 + col0;
#pragma unroll
                for (int bj = 0; bj < 2; ++bj)
#pragma unroll
                    for (int n = 0; n < 2; ++n) *(f32x4*)(rowp + bj * 128 + n * 16) = acc[ai][bj][m][n]; }
    }
};
struct EpiS3 {
    static constexpr bool PERM = true;
    f16* Gm;
    __device__ __forceinline__ void operator()(const f32x4 (&acc)[2][2][4][2], const Unit& u, int wr, int wc, int fr, int fq) const {
        const int r0 = u.pm * 256 + wr * 64 + fr;
#pragma unroll
        for (int ai = 0; ai < 2; ++ai)
#pragma unroll
            for (int m = 0; m < 4; ++m) { const int r = r0 + ai * 128 + m * 16;
#pragma unroll
                for (int bj = 0; bj < 2; ++bj) { const int np = bj * 128 + wc * 32 + 8 * fq; const int j = np >> 4, h0 = np & 15;
                    const f32x4 v0 = acc[ai][bj][m][0], v1 = acc[ai][bj][m][1];
                    float rr[8];
#pragma unroll
                    for (int k = 0; k < 4; ++k) { rr[k] = gelu_tanh_f(v0[k]); rr[4 + k] = gelu_tanh_f(v1[k]); }
                    u32x4 w; w.x = pk2h(rr[0], rr[1]); w.y = pk2h(rr[2], rr[3]); w.z = pk2h(rr[4], rr[5]); w.w = pk2h(rr[6], rr[7]);
                    *(u32x4*)(Gm + (size_t)(r * 16 + j) * D + u.z * 16 + h0) = w; } }
    }
};

struct SchedFA {
    int vcu;
    __device__ bool next(int i, Unit& u) const { const int idx = i * 256 + vcu; if (idx >= 768) return false; u.pm = idx & 1; u.z = (idx >> 1) & 7;
        if (idx < 512) u.pn = idx >> 4; else { const int j = idx - 512; u.pn = 32 + 16 * (j >> 7) + ((j >> 4) & 7); } return true; }
};
struct SchedFBs {
    int vcu;
    __device__ bool next(int i, Unit& u) const { if (i > 0) return false; u.z = vcu >> 7; u.pm = (vcu >> 3) & 15; u.pn = vcu & 7; return true; }
};
struct SchedFBp {
    int vcu;
    __device__ bool next(int i, Unit& u) const { if (i > 0) return false; u.z = vcu >> 3; u.pm = 0; u.pn = vcu & 7; return true; }
};
struct SchedS {
    int vcu;
    __device__ bool next(int i, Unit& u) const { const int idx = i * 256 + vcu; if (idx >= 512) return false; u.pm = idx & 3; u.z = idx >> 2; u.pn = 0; return true; }
};

struct TItem { const float* src; f16* dst; int N, K; };
__device__ __forceinline__ TItem titem_make(const float* W, int K, int N, f16* WT, int half, int item) {
    const int nblk = N / 32, kb = item / nblk, nb = item % nblk, k0 = 64 * kb, n0 = 32 * nb;
    int d0 = n0;
    if (half > 0) { const int bj = n0 / half, rem = n0 % half; d0 = (rem / 128) * 256 + bj * 128 + (rem % 128); }
    TItem t; t.src = W + (size_t)k0 * N + n0; t.dst = WT + (size_t)d0 * K + k0; t.N = N; t.K = K; return t;
}
__device__ __forceinline__ TItem titem_decode(const Args& a, int it) {
    constexpr int I_IN = (D / 64) * (2 * DFF / 32), I_OUT = (DFF / 64) * (D / 32), I_O = (D / 64) * (D / 32), I_GLU = (D / 64) * (2 * D / 32);
    int r = it;
    if (r < 8 * I_IN) { const int mi = r / I_IN; return titem_make(a.ffn_w_in + (size_t)mi * D * 2 * DFF, D, 2 * DFF, (f16*)(a.ws + WS_WIN) + (size_t)mi * D * 2 * DFF, DFF, r % I_IN); } r -= 8 * I_IN;
    if (r < 8 * I_OUT) { const int mi = r / I_OUT; return titem_make(a.ffn_w_out + (size_t)mi * DFF * D, DFF, D, (f16*)(a.ws + WS_WOUT) + (size_t)mi * DFF * D, 0, r % I_OUT); } r -= 8 * I_OUT;
    if (r < 2 * I_O) { const int mi = r / I_O; return titem_make(a.fourier_w_o + (size_t)mi * D * D, D, D, (f16*)(a.ws + WS_WO) + (size_t)mi * D * D, 0, r % I_O); } r -= 2 * I_O;
    { const int mi = r / I_GLU; return titem_make(a.ssm_w_glu + (size_t)mi * D * 2 * D, D, 2 * D, (f16*)(a.ws + WS_WGLU) + (size_t)mi * D * 2 * D, D, r % I_GLU); }
}
__device__ __forceinline__ void titem_load(f32x4 (&v)[8], const TItem& t, int lane) {
    const float* p = t.src + (size_t)(lane >> 3) * t.N + (lane & 7) * 4;
#pragma unroll
    for (int i = 0; i < 8; ++i) v[i] = __builtin_nontemporal_load((const f32x4*)(p + (size_t)(8 * i) * t.N));
}
__device__ __forceinline__ void titem_store(const f32x4 (&v)[8], const TItem& t, LAS float* scr, int lane) {
#pragma unroll
    for (int i = 0; i < 8; ++i) { LAS float* s = scr + (8 * i + (lane >> 3)) * 33 + (lane & 7) * 4; s[0] = v[i][0]; s[1] = v[i][1]; s[2] = v[i][2]; s[3] = v[i][3]; }
    LDS_WAIT(); asm volatile("" ::: "memory");
    const int c = lane & 7;
#pragma unroll
    for (int j = 0; j < 4; ++j) { const int n = (lane >> 3) + 8 * j; const LAS float* s = scr + (8 * c) * 33 + n;
        u32x4 o; o.x = pk2h(s[0 * 33], s[1 * 33]); o.y = pk2h(s[2 * 33], s[3 * 33]); o.z = pk2h(s[4 * 33], s[5 * 33]); o.w = pk2h(s[6 * 33], s[7 * 33]);
        *(u32x4*)(t.dst + (size_t)n * t.K + 8 * c) = o; }
    LDS_WAIT(); asm volatile("" ::: "memory");
}

__device__ __forceinline__ void ssm_tables_item(const Args& a, int kk, int g, LAS unsigned char* sl, int tid) {
    LAS f32x2* apow = (LAS f32x2*)sl;
    LAS f32x2* bbar = (LAS f32x2*)(sl + 17408);
    LAS f32x2* cc   = (LAS f32x2*)(sl + 17408 + 16384);
    LAS float* klag = (LAS float*)(sl + 17408 + 32768);
    if (tid < 128) {
        const int d = tid >> 6, p = tid & 63;
        const size_t ia = ((size_t)(kk * 2 + d) * SSM_G + g) * SSM_P + p;
        const double are = (double)a.ssm_a_re[ia], aim = (double)a.ssm_a_im[ia];
        const double dt = exp((double)a.ssm_log_dt[(kk * 2 + d) * SSM_G + g]);
        const double mag = exp(are * dt), ang = aim * dt;
        const double abr = mag * cos(ang), abi = mag * sin(ang);
        double cr = 1.0, ci = 0.0;
        for (int m = 0; m <= 16; ++m) {
            apow[(d * 64 + p) * 17 + m] = (f32x2){(float)cr, (float)ci};
            if (m == 16) ((f32x2*)(a.ws + WS_AL))[((size_t)(kk * 2 + d) * SSM_G + g) * SSM_P + p] = (f32x2){(float)cr, (float)ci};
            const double nr = cr * abr - ci * abi, ni = cr * abi + ci * abr; cr = nr; ci = ni;
        }
        const double nr = abr - 1.0, ni = abi, den = are * are + aim * aim;
        const double qr = (nr * are + ni * aim) / den, qi = (ni * are - nr * aim) / den;
        const float* bp = a.ssm_b + (ia * SSM_H) * 2;
        for (int h = 0; h < 16; ++h) { const double br = (double)bp[2 * h], bi = (double)bp[2 * h + 1];
            bbar[(d * 64 + p) * 16 + h] = (f32x2){(float)(qr * br - qi * bi), (float)(qr * bi + qi * br)}; }
    }
    for (int i = tid; i < 2048; i += NTHR) {
        const int d = i >> 10, r = i & 1023;
        const float* cp = a.ssm_c + ((((size_t)(kk * 2 + d) * SSM_G + g) * SSM_H) * SSM_P + r) * 2;
        cc[i] = (f32x2){cp[0], cp[1]};
    }
    __syncthreads();
    {
        const int hc = tid & 3, hb = (tid >> 2) & 3, lag = (tid >> 4) & 15, d = tid >> 8;
        float acc[4][4];
#pragma unroll
        for (int i = 0; i < 4; ++i)
#pragma unroll
            for (int j = 0; j < 4; ++j) acc[i][j] = 0.f;
        for (int p = 0; p < 64; ++p) {
            const f32x2 ap = apow[(d * 64 + p) * 17 + lag];
            f32x2 ab[4], c[4];
#pragma unroll
            for (int j = 0; j < 4; ++j) { const f32x2 bb = bbar[(d * 64 + p) * 16 + 4 * hc + j]; ab[j] = (f32x2){ap.x * bb.x - ap.y * bb.y, ap.x * bb.y + ap.y * bb.x}; }
#pragma unroll
            for (int i = 0; i < 4; ++i) c[i] = cc[(d * 16 + 4 * hb + i) * 64 + p];
#pragma unroll
            for (int i = 0; i < 4; ++i)
#pragma unroll
                for (int j = 0; j < 4; ++j) acc[i][j] += c[i].x * ab[j].x - c[i].y * ab[j].y;
        }
#pragma unroll
        for (int i = 0; i < 4; ++i)
#pragma unroll
            for (int j = 0; j < 4; ++j) klag[((d * 16 + lag) * 16 + 4 * hb + i) * 16 + 4 * hc + j] = acc[i][j];
    }
    __syncthreads();
    f16* W1 = (f16*)(a.ws + WS_W1) + ((size_t)(kk * SSM_G + g) << 16);
    for (int e = tid; e < 65536; e += NTHR) {
        const int k = e & 255, np = e >> 8, h = k & 15, j = k >> 4, p = np & 63, ri = (np >> 6) & 1, d = np >> 7;
        const f32x2 ap = apow[(d * 64 + p) * 17 + (d == 0 ? 15 - j : j)], bb = bbar[(d * 64 + p) * 16 + h];
        const float zr = ap.x * bb.x - ap.y * bb.y, zi = ap.x * bb.y + ap.y * bb.x;
        W1[e] = (f16)(ri == 0 ? zr : zi);
    }
    f16* TW = (f16*)(a.ws + WS_TW) + ((size_t)(kk * SSM_G + g) << 17);
    const float* dw = a.ssm_d + kk * D + g * 16;
    for (int e = tid; e < 131072; e += NTHR) {
        const int k = e & 511, np = e >> 9, hp = np & 15, j = np >> 4;
        float v;
        if (k < 256) { const int h = k & 15, j2 = k >> 4;
            v = (j2 == j && h == hp) ? dw[h] : 0.f;
            if (j2 <= j) v += klag[((0 * 16 + (j - j2)) * 16 + hp) * 16 + h];
            if (j2 >= j) v += klag[((1 * 16 + (j2 - j)) * 16 + hp) * 16 + h];
        } else { const int k2 = k - 256, p = k2 & 63, ri = (k2 >> 6) & 1, d = k2 >> 7;
            const f32x2 c = cc[(d * 16 + hp) * 64 + p], ap = apow[(d * 64 + p) * 17 + (d == 0 ? j + 1 : 16 - j)];
            const float zr = c.x * ap.x - c.y * ap.y, zi = c.x * ap.y + c.y * ap.x;
            v = ri == 0 ? zr : -zi;
        }
        TW[e] = (f16)v;
    }
    __syncthreads();
}

__device__ __forceinline__ void p0a_phase(const Args& a, Frame& F) {
    __syncthreads();
    LAS float* sc = (LAS float*)F.lds;
    for (int i = F.tid; i < 3 * D; i += NTHR) { const int c = i >> 11, k = i & (D - 1); const float v = (c == 0) ? a.c_ctx[k] : a.c[(c - 1) * D + k]; sc[i] = v * sigmoid_f(v); }
    __syncthreads();
    for (int it = F.vcu; it < 2 * SSM_G; it += F.G) ssm_tables_item(a, it >> 7, it & 127, F.lds + 24576, F.tid);
    const int gw = F.vcu * NWAVES + F.wave, NGW = F.G * NWAVES;
    float* modp = (float*)(a.ws + WS_MODP);
    for (int it = gw; it < 4 * 16 * 72; it += NGW) {
        const int nc = it % 72, kc = (it / 72) & 15, l = it / 1152;
        const float* wp = a.w_ada + ((size_t)(l * D + kc * 128)) * (NMOD * D) + nc * 256 + F.lane * 4;
        f32x4 s0 = {0.f, 0.f, 0.f, 0.f}, s1 = s0, s2 = s0;
        for (int k8 = 0; k8 < 128; k8 += 8) {
            f32x4 w[8];
#pragma unroll
            for (int j = 0; j < 8; ++j) w[j] = __builtin_nontemporal_load((const f32x4*)(wp + (size_t)(k8 + j) * (NMOD * D)));
#pragma unroll
            for (int j = 0; j < 8; ++j) { const int k = kc * 128 + k8 + j; s0 += w[j] * sc[k]; s1 += w[j] * sc[D + k]; s2 += w[j] * sc[2 * D + k]; }
        }
        float* op = modp + ((size_t)(kc * 4 + l) * 3) * (NMOD * D) + nc * 256 + F.lane * 4;
        *(f32x4*)op = s0; *(f32x4*)(op + NMOD * D) = s1; *(f32x4*)(op + 2 * NMOD * D) = s2;
    }
    __syncthreads();
    {
        const int gt = F.vcu * NTHR + F.tid, NGT = F.G * NTHR;
        f16* cs4 = (f16*)(a.ws + WS_CS4096);
        for (int ch = gt; ch < 4096 * 512; ch += NGT) {
            const int k = ch >> 9, col0 = (ch & 511) * 8, cs = col0 >> 11, t0 = col0 & 2047; float v[8];
#pragma unroll
            for (int j = 0; j < 8; ++j) { const int mm = (k * (t0 + j)) & 4095; const float x = (float)mm * (1.0f / 2048.0f); v[j] = cs == 0 ? cospif(x) : -sinpif(x); }
            u32x4 o; o.x = pk2h(v[0], v[1]); o.y = pk2h(v[2], v[3]); o.z = pk2h(v[4], v[5]); o.w = pk2h(v[6], v[7]);
            *(u32x4*)(cs4 + (size_t)ch * 8) = o;
        }
        f16* cs2 = (f16*)(a.ws + WS_CS256);
        for (int ch = gt; ch < 256 * 64; ch += NGT) {
            const int k = ch >> 6, col0 = (ch & 63) * 8, cs = col0 >> 8, t0 = col0 & 255; float v[8];
#pragma unroll
            for (int j = 0; j < 8; ++j) { const int mm = (k * (t0 + j)) & 255; const float x = (float)mm * (1.0f / 128.0f); v[j] = cs == 0 ? cospif(x) : -sinpif(x); }
            u32x4 o; o.x = pk2h(v[0], v[1]); o.y = pk2h(v[2], v[3]); o.z = pk2h(v[4], v[5]); o.w = pk2h(v[6], v[7]);
            *(u32x4*)(cs2 + (size_t)ch * 8) = o;
        }
        f16* w2t = (f16*)(a.ws + WS_W2T);
        for (int ch = gt; ch < 512 * 32; ch += NGT) {
            const int row = ch >> 5, c0 = (ch & 31) * 8, cs = row >> 8, q = row & 255; float v[8];
#pragma unroll
            for (int j = 0; j < 8; ++j) { const int mm = (q * (c0 + j)) & 255; const float x = (float)mm * (1.0f / 128.0f); v[j] = cs == 0 ? cospif(x) : sinpif(x); }
            u32x4 o; o.x = pk2h(v[0], v[1]); o.y = pk2h(v[2], v[3]); o.z = pk2h(v[4], v[5]); o.w = pk2h(v[6], v[7]);
            *(u32x4*)(w2t + (size_t)ch * 8) = o;
        }
    }
    {
        LAS float* scr = (LAS float*)(F.lds + F.wave * 16384);
        constexpr int I_IN = (D / 64) * (2 * DFF / 32), I_OUT = (DFF / 64) * (D / 32), I_O = (D / 64) * (D / 32), I_GLU = (D / 64) * (2 * D / 32);
        constexpr int NITEMS = 8 * I_IN + 8 * I_OUT + 2 * I_O + 2 * I_GLU;
        int it = gw;
        if (it < NITEMS) {
            TItem cur = titem_decode(a, it); f32x4 v[8], w[8]; titem_load(v, cur, F.lane);
            for (;;) {
                const int nit = it + NGW; const bool has = nit < NITEMS; TItem nx = cur;
                if (has) { nx = titem_decode(a, nit); titem_load(w, nx, F.lane); }
                titem_store(v, cur, scr, F.lane);
                if (!has) break;
#pragma unroll
                for (int i = 0; i < 8; ++i) v[i] = w[i];
                cur = nx; it = nit;
            }
        }
    }
    {
        float* pe = (float*)(a.ws + WS_PE);
        for (int e = F.vcu * NTHR + F.tid; e < 64 * 512; e += F.G * NTHR) { const int pos = e >> 9, i = e & 511;
            const float fr = exp2f(-(float)i * (13.287712379549449f / 512.0f)); const float ar = (float)pos * fr;
            pe[e] = sinf(ar); pe[64 * 512 + e] = cosf(ar); }
    }
}

__device__ __forceinline__ void p0b_phase(const Args& a, Frame& F) {
    const float* modp = (const float*)(a.ws + WS_MODP); float* mod = (float*)(a.ws + WS_MOD);
    for (int i = F.vcu * NTHR + F.tid; i < 4 * 3 * NMOD * D; i += F.G * NTHR) {
        const int n = i % (NMOD * D), lc = i / (NMOD * D), l = lc / 3;
        float s = a.b_ada[l * (NMOD * D) + n];
#pragma unroll
        for (int kc = 0; kc < 16; ++kc) s += modp[((size_t)kc * 12 + lc) * (NMOD * D) + n];
        mod[i] = s;
    }
}

__device__ __forceinline__ void norm_load_row(const Args& a, Frame& F, int m, bool first, f32x4 (&v)[4][2]) {
    float* xo = a.out + (size_t)m * D;
    if (first) {
        const float* xi = m < NPROMPT ? a.x_prompt + (size_t)m * D : a.x_sample + (size_t)(m - NPROMPT) * D;
        const int t = (m - NPROMPT) & (SEQ_S - 1); const float* pe = (const float*)(a.ws + WS_PE);
#pragma unroll
        for (int q = 0; q < 4; ++q)
#pragma unroll
            for (int e = 0; e < 2; ++e) { const int c = q * 512 + F.lane * 8 + e * 4; f32x4 x = *(const f32x4*)(xi + c);
                if (m >= NPROMPT) x += *(const f32x4*)(pe + ((q & 1) * 64 + (q < 2 ? (t >> 6) : (t & 63))) * 512 + (c & 511));
                *(f32x4*)(xo + c) = x; v[q][e] = x; }
    } else {
#pragma unroll
        for (int q = 0; q < 4; ++q)
#pragma unroll
            for (int e = 0; e < 2; ++e) v[q][e] = *(const f32x4*)(xo + q * 512 + F.lane * 8 + e * 4);
    }
}
__device__ __forceinline__ float norm_rstd(Frame& F, const f32x4 (&v)[4][2]) {
    float ss = 0.f;
#pragma unroll
    for (int q = 0; q < 4; ++q)
#pragma unroll
        for (int e = 0; e < 2; ++e) { const f32x4 t = v[q][e] * v[q][e]; ss += (t[0] + t[1]) + (t[2] + t[3]); }
    return 1.0f / sqrtf(wave_sum(ss, F.lane) * (1.0f / D) + RMS_EPS);
}
__device__ __forceinline__ void norm_store_row(f16* dst, Frame& F, const f32x4 (&o)[4][2]) {
#pragma unroll
    for (int q = 0; q < 4; ++q) { u32x4 w; w.x = pk2h(o[q][0][0], o[q][0][1]); w.y = pk2h(o[q][0][2], o[q][0][3]); w.z = pk2h(o[q][1][0], o[q][1][1]); w.w = pk2h(o[q][1][2], o[q][1][3]);
        *(u32x4*)(dst + q * 512 + F.lane * 8) = w; }
}
__device__ __forceinline__ void norm_phase(const Args& a, Frame& F, int l, int j, bool first, bool fold) {
    const int gw = F.vcu * NWAVES + F.wave; const int row0 = gw * 8;
    const int cond = cond_of_panel(row0 >> 8);
    const float* gp = a.norm_g + (size_t)(l * 3 + j) * D;
    const float* sh = (const float*)(a.ws + WS_MOD) + ((size_t)(l * 3 + cond) * NMOD + 3 * j) * D;
    const float* scl = sh + D;
    f32x4 gs[4][2], sv[4][2];
#pragma unroll
    for (int q = 0; q < 4; ++q)
#pragma unroll
        for (int e = 0; e < 2; ++e) { const int c = q * 512 + F.lane * 8 + e * 4; gs[q][e] = *(const f32x4*)(gp + c) * (*(const f32x4*)(scl + c) + 1.0f); sv[q][e] = *(const f32x4*)(sh + c); }
    f16* H = (f16*)(a.ws + WS_H);
    if (!(fold && row0 >= NPROMPT)) {
        for (int r = 0; r < 8; ++r) {
            const int m = row0 + r;
            f32x4 v[4][2]; norm_load_row(a, F, m, first, v);
            const float rstd = norm_rstd(F, v);
#pragma unroll
            for (int q = 0; q < 4; ++q)
#pragma unroll
                for (int e = 0; e < 2; ++e) v[q][e] = v[q][e] * rstd * gs[q][e] + sv[q][e];
            norm_store_row(H + (size_t)m * D, F, v);
        }
    } else {
        f16* G2 = (f16*)(a.ws + WS_G);
        const int i = gw - NPROMPT / 8, b = i >> 9, t0 = (i & 511) * 4, rb = NPROMPT + SEQ_S * b;
        for (int r = 0; r < 4; ++r) {
            const int t = t0 + r, ma = rb + t, mb = rb + (t == 0 ? SEQ_S / 2 : SEQ_S - t);
            f32x4 va[4][2], vb[4][2]; norm_load_row(a, F, ma, false, va); norm_load_row(a, F, mb, false, vb);
            const float ra = norm_rstd(F, va), rbv = norm_rstd(F, vb);
#pragma unroll
            for (int q = 0; q < 4; ++q)
#pragma unroll
                for (int e = 0; e < 2; ++e) { va[q][e] = va[q][e] * ra * gs[q][e] + sv[q][e]; vb[q][e] = vb[q][e] * rbv * gs[q][e] + sv[q][e]; }
            if (t == 0) {
                norm_store_row(H + (size_t)ma * D, F, va); norm_store_row(H + (size_t)mb * D, F, vb);
#pragma unroll
                for (int q = 0; q < 4; ++q)
#pragma unroll
                    for (int e = 0; e < 2; ++e) vb[q][e] = (f32x4){0.f, 0.f, 0.f, 0.f};
                norm_store_row(G2 + (size_t)ma * D, F, vb);
            } else {
                f32x4 se[4][2], so[4][2];
#pragma unroll
                for (int q = 0; q < 4; ++q)
#pragma unroll
                    for (int e = 0; e < 2; ++e) { se[q][e] = va[q][e] + vb[q][e]; so[q][e] = va[q][e] - vb[q][e]; }
                norm_store_row(H + (size_t)ma * D, F, se); norm_store_row(G2 + (size_t)ma * D, F, so);
            }
        }
    }
    if (fold && gw < 64) {
        const int b = gw >> 5, m = NPROMPT + SEQ_S * b + SEQ_S / 2;
        const float* sh2 = (const float*)(a.ws + WS_MOD) + ((size_t)(l * 3 + 1 + b) * NMOD + 3 * j) * D; const float* scl2 = sh2 + D;
        f32x4 v[4][2]; norm_load_row(a, F, m, false, v);
        const float rstd = norm_rstd(F, v);
        LAS float* hl = (LAS float*)(F.lds + F.wave * 16384);
#pragma unroll
        for (int q = 0; q < 4; ++q)
#pragma unroll
            for (int e = 0; e < 2; ++e) { const int c = q * 512 + F.lane * 8 + e * 4;
                const f32x4 o = v[q][e] * rstd * (*(const f32x4*)(gp + c) * (*(const f32x4*)(scl2 + c) + 1.0f)) + *(const f32x4*)(sh2 + c);
                *(LAS f32x4*)(hl + c) = o; }
        LDS_WAIT(); asm volatile("" ::: "memory");
        const int o = (gw & 31) * 64 + F.lane, g = o >> 8, q = o & 255;
        float s = 0.f;
        for (int c = 0; c < 256; ++c) s += hl[256 * g + c] * __builtin_amdgcn_cosf((float)((q * c) & 255) * (1.0f / 256.0f));
        ((float*)(a.ws + WS_HCN))[(size_t)b * D + o] = s;
        LDS_WAIT(); asm volatile("" ::: "memory");
    }
}

__device__ __forceinline__ void final_phase(const Args& a, Frame& F) {
    const int gw = F.vcu * NWAVES + F.wave; const int row0 = gw * 8;
    f32x4 gs[8];
#pragma unroll
    for (int q = 0; q < 8; ++q) gs[q] = *(const f32x4*)(a.final_g + q * 256 + F.lane * 4);
    for (int r = 0; r < 8; ++r) {
        float* xr = a.out + (size_t)(row0 + r) * D;
        f32x4 v[8]; float ss = 0.f;
#pragma unroll
        for (int q = 0; q < 8; ++q) { v[q] = *(const f32x4*)(xr + q * 256 + F.lane * 4); const f32x4 t = v[q] * v[q]; ss += (t[0] + t[1]) + (t[2] + t[3]); }
        const float rstd = 1.0f / sqrtf(wave_sum(ss, F.lane) * (1.0f / D) + RMS_EPS);
#pragma unroll
        for (int q = 0; q < 8; ++q) *(f32x4*)(xr + q * 256 + F.lane * 4) = v[q] * rstd * gs[q];
    }
}

__device__ __forceinline__ void scan_phase(const Args& a, Frame& F, int kk) {
    const int gw = F.vcu * NWAVES + F.wave, NGW = F.G * NWAVES;
    const float* S = (const float*)(a.ws + WS_S); f16* CC = (f16*)(a.ws + WS_CC);
    const f32x2* AL = (const f32x2*)(a.ws + WS_AL);
    float* ns = a.out + (size_t)MTOK * D;
    const int p = F.lane;
    for (int it = gw; it < 34 * SSM_G * 2; it += NGW) {
        int sq, g, d;
        if (it < 512) { sq = 32 + (it >> 8); g = (it >> 1) & 127; d = it & 1; }
        else { const int r = it - 512; sq = r >> 8; g = (r >> 1) & 127; d = r & 1; }
        const int c0 = sq < 32 ? sq * 16 : 512 + (sq - 32) * 256, cnt = sq < 32 ? 16 : 256;
        const f32x2 al = AL[((size_t)(kk * 2 + d) * SSM_G + g) * SSM_P + p];
        float cr = 0.f, ci = 0.f;
        if (sq >= 32) { const float* sp = a.state_ssm + (((((size_t)(sq - 32) * 2 + kk) * 2 + d) * SSM_G + g) * SSM_P + p) * 2; cr = sp[0]; ci = sp[1]; }
        const size_t sbase = (size_t)g * 256 + d * 128 + p;
        f16* ccb = CC + (size_t)(d * 8 + (p >> 4)) * D + g * 16 + (p & 15);
        for (int s8 = 0; s8 < cnt; s8 += 8) {
            float sr[8], si[8];
#pragma unroll
            for (int j = 0; j < 8; ++j) { const int c = d == 0 ? c0 + s8 + j : c0 + cnt - 1 - s8 - j; const float* q = S + (size_t)c * (SSM_G * 256) + sbase; sr[j] = q[0]; si[j] = q[64]; }
#pragma unroll
            for (int j = 0; j < 8; ++j) { const int c = d == 0 ? c0 + s8 + j : c0 + cnt - 1 - s8 - j;
                f16* o = ccb + (size_t)c * 16 * D; o[0] = (f16)cr; o[4 * D] = (f16)ci;
                const float nr = al.x * cr - al.y * ci + sr[j], ni = al.x * ci + al.y * cr + si[j]; cr = nr; ci = ni; }
        }
        if (sq < 32) { float* o = ns + (((((size_t)sq * 2 + kk) * 2 + d) * SSM_G + g) * SSM_P + p) * 2; *(f32x2*)o = (f32x2){cr, ci}; }
    }
}

constexpr int N_PHASES = 45;
#ifndef MK_PER_PHASE
#define MK_PER_PHASE 0
#endif

#ifndef EN_MASK
#define EN_MASK 0xFFFF
#endif
#define EN(bit) if constexpr (((EN_MASK) >> (bit)) & 1)
#ifndef G_SP2
#define G_SP2 true
#endif
#ifndef G_ALIGN
#define G_ALIGN true
#endif
#ifndef REP_MASK
#define REP_MASK 0
#endif
#define REPCNT(bit) ((((REP_MASK) >> (bit)) & 1) ? 2 : 1)
#define REP(bit) for (int rep_ = 0; rep_ < REPCNT(bit); ++rep_)
typedef pg8::Prob<false> ProbStd;
typedef pg8::Prob<true> ProbChunk;

__device__ __forceinline__ ProbStd make_std(const void* A, unsigned lda2, size_t a_t, size_t a_z, const void* B, unsigned ldb2, size_t b_t, size_t b_z, int nt) {
    ProbStd p; p.A = (const char*)A; p.A2 = (const char*)A; p.B = (const char*)B; p.nt = nt; p.ksplit = nt; p.lda2 = lda2; p.ldb2 = ldb2; p.a_t = a_t; p.a_z = a_z; p.b_t = b_t; p.b_z = b_z; p.a_k = 128u; p.b_k = 128u; return p;
}

struct ArgsK {
    const GAS float* x_prompt; const GAS float* x_sample; const GAS float* state_ssm; const GAS float* c; const GAS float* c_ctx;
    const GAS float* w_ada; const GAS float* b_ada; const GAS float* norm_g; const GAS float* ffn_w_in; const GAS float* ffn_w_out;
    const GAS float* fourier_w_o; const GAS float* ssm_a_re; const GAS float* ssm_a_im; const GAS float* ssm_log_dt;
    const GAS float* ssm_b; const GAS float* ssm_c; const GAS float* ssm_d; const GAS float* ssm_w_glu; const GAS float* final_g;
    GAS float* out; GAS unsigned char* ws; int ph_lo, ph_hi;
};
static_assert(sizeof(ArgsK) == sizeof(Args), "ArgsK mirrors Args");
__device__ __forceinline__ Args kargs() {
    const __attribute__((address_space(4))) ArgsK* p = (const __attribute__((address_space(4))) ArgsK*)__builtin_amdgcn_kernarg_segment_ptr(); asm volatile("" : "+s"(p));
    Args a;
    a.x_prompt = (const float*)p->x_prompt; a.x_sample = (const float*)p->x_sample; a.state_ssm = (const float*)p->state_ssm; a.c = (const float*)p->c; a.c_ctx = (const float*)p->c_ctx;
    a.w_ada = (const float*)p->w_ada; a.b_ada = (const float*)p->b_ada; a.norm_g = (const float*)p->norm_g; a.ffn_w_in = (const float*)p->ffn_w_in; a.ffn_w_out = (const float*)p->ffn_w_out;
    a.fourier_w_o = (const float*)p->fourier_w_o; a.ssm_a_re = (const float*)p->ssm_a_re; a.ssm_a_im = (const float*)p->ssm_a_im; a.ssm_log_dt = (const float*)p->ssm_log_dt;
    a.ssm_b = (const float*)p->ssm_b; a.ssm_c = (const float*)p->ssm_c; a.ssm_d = (const float*)p->ssm_d; a.ssm_w_glu = (const float*)p->ssm_w_glu; a.final_g = (const float*)p->final_g;
    a.out = (float*)p->out; a.ws = (unsigned char*)p->ws; a.ph_lo = p->ph_lo; a.ph_hi = p->ph_hi;
    return a;
}

__global__ void __launch_bounds__(NTHR, 2) fwd_kernel(ArgsK a_unused) {
    extern __shared__ __attribute__((aligned(16))) unsigned char lds_raw[];
    Frame F0;
    F0.lds = (LAS unsigned char*)lds_raw;
    F0.tid = threadIdx.x; F0.lane = F0.tid & 63; F0.wave = __builtin_amdgcn_readfirstlane(F0.tid >> 6);
    F0.G = gridDim.x; F0.bx = blockIdx.x; { const int bx = blockIdx.x; F0.vcu = (F0.G % 8 == 0) ? (bx % 8) * (F0.G / 8) + bx / 8 : bx; }
    volatile LAS unsigned* MISC = (volatile LAS unsigned*)(F0.lds + MISC_OFF);
    if (F0.tid < 64) MISC[F0.tid] = 0u;
    __syncthreads();
    unsigned bar_x; int lo, hi;
    { const Args a = kargs(); unsigned* ctl = (unsigned*)(a.ws + WS_CTL); const XcdBarrier b0 = xcd_barrier_post(ctl + CW_BAR, MISC + 8); bar_x = b0.x; lo = a.ph_lo; hi = a.ph_hi; }
#define GRID_BAR() do { const Args ab = kargs(); XcdBarrier bb; bb.bar = (unsigned*)(ab.ws + WS_CTL) + CW_BAR; unsigned bx_ = bar_x; asm volatile("" : "+s"(bx_)); bb.x = bx_; bb.st = MISC + 8; xcd_barrier(bb); } while (0)
    int ph = 0;
#define PH_BEGIN if (ph >= lo && ph < hi) { const Args a = kargs(); unsigned char* ws = a.ws; \
    Frame F = F0; asm volatile("" : "+s"(F.vcu), "+s"(F.wave), "+s"(F.G), "+s"(F.bx)); asm volatile("" : "+v"(F.tid)); F.lane = F.tid & 63;   \
    f16* H = (f16*)(ws + WS_H); f16* ACT = (f16*)(ws + WS_ACT); f16* HT = (f16*)(ws + WS_HT); f16* Fm = (f16*)(ws + WS_F); \
    float* Sm = (float*)(ws + WS_S); f16* CC = (f16*)(ws + WS_CC); f16* Gm = (f16*)(ws + WS_G); \
    const float* modl = (const float*)(ws + WS_MOD) + (size_t)l * 3 * NMOD * D; \
    (void)H; (void)ACT; (void)HT; (void)Fm; (void)Sm; (void)CC; (void)Gm; (void)modl;
#define PH_END   if (ph + 1 < hi) GRID_BAR(); } ++ph;

    { const int l = 0;
    PH_BEGIN EN(0) REP(0) p0a_phase(a, F); PH_END
    PH_BEGIN EN(1) REP(1) p0b_phase(a, F); PH_END
    }
    for (int l = 0; l < DEPTH; ++l) {
        for (int s = 0; s < 2; ++s) {
            PH_BEGIN EN(2) REP(2) norm_phase(a, F, l, 2 * s, l == 0 && s == 0, false); PH_END
            PH_BEGIN EN(3) REP(3) {
                const f16* Wt = (const f16*)(ws + WS_WIN) + (size_t)(l * 2 + s) * D * 2 * DFF;
                ProbStd p = make_std(H, D * 2, (size_t)256 * D * 2, 0, Wt, D * 2, (size_t)256 * D * 2, 0, D / 64);
                pg8::StaticOrder S; S.init(MTOK, 2 * DFF, F.G, F.bx);
                EpiSwiGLU E{ACT};
                pg8::gemm_phase<ProbStd, EpiSwiGLU, pg8::StaticOrder, G_ALIGN, G_SP2>(F.lds, p, S, E);
            } PH_END
            PH_BEGIN EN(4) REP(4) {
                const f16* Wt = (const f16*)(ws + WS_WOUT) + (size_t)(l * 2 + s) * DFF * D;
                ProbStd p = make_std(ACT, DFF * 2, (size_t)256 * DFF * 2, 0, Wt, DFF * 2, (size_t)256 * DFF * 2, 0, DFF / 64);
                pg8::StaticOrder S; S.init(MTOK, D, F.G, F.bx);
                EpiResid E{a.out, modl + (size_t)(2 + 6 * s) * D, 0.5f / REPCNT(4)};
                pg8::gemm_phase<ProbStd, EpiResid, pg8::StaticOrder, G_ALIGN, G_SP2>(F.lds, p, S, E);
            } PH_END
            if (s == 0) {
                PH_BEGIN EN(2) REP(2) norm_phase(a, F, l, 1, false, (l & 1) == 0); PH_END
                const int kk = l >> 1;
                if ((l & 1) == 0) {
                    PH_BEGIN EN(5) REP(5) {
                        pg8::ProbFA p; (ProbStd&)p = make_std(ws + WS_W2T, 512, (size_t)256 * 512, 0, H, D * 2, (size_t)256 * D * 2, 512, 4);
                        p.b_m = (size_t)((const char*)Gm - (const char*)H);
                        SchedFA S{F.vcu}; EpiFA E{HT};
                        pg8::gemm_phase<pg8::ProbFA, EpiFA, SchedFA, true, true>(F.lds, p, S, E);
                    } PH_END
                    PH_BEGIN EN(6) REP(6) {
                        {
                            ProbStd p = make_std(ws + WS_CS4096, 8192, (size_t)256 * 8192, 0, HT + (size_t)NB_P * D * 2 * SEQ_P, 8192, (size_t)256 * 8192, (size_t)D * 8192, 64);
                            SchedFBs S{F.vcu}; EpiFB E{Fm, NPROMPT, SEQ_S, 1.0f / 1024.0f, (const float*)(ws + WS_HCN)};
                            pg8::gemm_phase<ProbStd, EpiFB, SchedFBs, false, true>(F.lds, p, S, E);
                        }
                        {
                            ProbStd p = make_std(ws + WS_CS256, 1024, (size_t)256 * 1024, 0, HT, 1024, (size_t)256 * 1024, (size_t)D * 1024, 8);
                            SchedFBp S{F.vcu}; EpiFB E{Fm, 0, SEQ_P, 1.0f / 256.0f, nullptr};
                            pg8::gemm_phase<ProbStd, EpiFB, SchedFBp, false, true>(F.lds, p, S, E);
                        }
                    } PH_END
                    PH_BEGIN EN(7) REP(7) {
                        const f16* Wt = (const f16*)(ws + WS_WO) + (size_t)kk * D * D;
                        ProbStd p = make_std(Fm, D * 2, (size_t)256 * D * 2, 0, Wt, D * 2, (size_t)256 * D * 2, 0, D / 64);
                        pg8::StaticOrder S; S.init(MTOK, D, F.G, F.bx);
                        EpiResid E{a.out, modl + (size_t)5 * D, 1.0f / REPCNT(7)};
                        pg8::gemm_phase<ProbStd, EpiResid, pg8::StaticOrder, G_ALIGN, G_SP2>(F.lds, p, S, E);
                    } PH_END
                } else {
                    PH_BEGIN EN(8) REP(8) {
                        ProbChunk p; p.A = (const char*)H; p.A2 = (const char*)H; p.B = (const char*)(ws + WS_W1) + (size_t)kk * SSM_G * 256 * 512; p.nt = 4; p.ksplit = 4;
                        p.lda2 = 65536u; p.ldb2 = 512u; p.a_t = (size_t)256 * 65536; p.a_z = 32; p.b_t = 0; p.b_z = (size_t)256 * 512; p.a_k = 16384u; p.b_k = 128u;
                        SchedS S{F.vcu}; EpiS1 E{Sm};
                        pg8::gemm_phase<ProbChunk, EpiS1, SchedS, true, true>(F.lds, p, S, E);
                    } PH_END
                    PH_BEGIN EN(9) REP(9) scan_phase(a, F, kk); PH_END
                    PH_BEGIN EN(10) REP(10) {
                        ProbChunk p; p.A = (const char*)H; p.A2 = (const char*)CC; p.B = (const char*)(ws + WS_TW) + (size_t)kk * SSM_G * 256 * 1024; p.nt = 8; p.ksplit = 4;
                        p.lda2 = 65536u; p.ldb2 = 1024u; p.a_t = (size_t)256 * 65536; p.a_z = 32; p.b_t = 0; p.b_z = (size_t)256 * 1024; p.a_k = 16384u; p.b_k = 128u;
                        SchedS S{F.vcu}; EpiS3 E{Gm};
                        pg8::gemm_phase<ProbChunk, EpiS3, SchedS, true, true>(F.lds, p, S, E);
                    } PH_END
                    PH_BEGIN EN(11) REP(11) {
                        const f16* Wt = (const f16*)(ws + WS_WGLU) + (size_t)kk * D * 2 * D;
                        ProbStd p = make_std(Gm, D * 2, (size_t)256 * D * 2, 0, Wt, D * 2, (size_t)256 * D * 2, 0, D / 64);
                        pg8::StaticOrder S; S.init(MTOK, 2 * D, F.G, F.bx);
                        EpiGLUResid E{a.out, modl + (size_t)5 * D, 1.0f / REPCNT(11)};
                        pg8::gemm_phase<ProbStd, EpiGLUResid, pg8::StaticOrder, G_ALIGN, G_SP2>(F.lds, p, S, E);
                    } PH_END
                }
            }
        }
    }
    { const int l = 0;
    PH_BEGIN EN(12) REP(12) final_phase(a, F); PH_END
    }
#undef PH_BEGIN
#undef PH_END
}

extern "C" void kernel_launch(void* const* d_in, const int* in_sizes, int n_in, void* d_out, int out_size, void* d_ws, size_t ws_size, hipStream_t stream) {
    static int grid = 0;
    if (grid == 0) {
        if (n_in != 19 || ws_size < WS_END) { fprintf(stderr, "kernel_launch: unexpected n_in %d or ws_size %zu (need %zu)\n", n_in, ws_size, (size_t)WS_END); grid = -1; return; }
        int dev = 0, cus = 0, per_cu = 0;
        if (hipGetDevice(&dev) != hipSuccess || hipDeviceGetAttribute(&cus, hipDeviceAttributeMultiprocessorCount, dev) != hipSuccess) { grid = -1; return; }
        if (hipFuncSetAttribute((const void*)fwd_kernel, hipFuncAttributeMaxDynamicSharedMemorySize, LDS_BYTES) != hipSuccess) { fprintf(stderr, "kernel_launch: hipFuncSetAttribute failed\n"); grid = -1; return; }
        if (hipOccupancyMaxActiveBlocksPerMultiprocessor(&per_cu, (const void*)fwd_kernel, NTHR, LDS_BYTES) != hipSuccess || per_cu < 1) fprintf(stderr, "kernel_launch: occupancy query reports %d\n", per_cu);
        (void)hipGetLastError();
        grid = cus < 256 ? cus : 256;
    }
    if (grid < 0) return;
    (void)hipMemsetAsync((char*)d_ws + WS_CTL, 0, CTL_ZERO_BYTES, stream);
    ArgsK a{};
    a.x_prompt = (const GAS float*)d_in[0]; a.x_sample = (const GAS float*)d_in[1]; a.state_ssm = (const GAS float*)d_in[2]; a.c = (const GAS float*)d_in[3]; a.c_ctx = (const GAS float*)d_in[4];
    a.w_ada = (const GAS float*)d_in[5]; a.b_ada = (const GAS float*)d_in[6]; a.norm_g = (const GAS float*)d_in[7]; a.ffn_w_in = (const GAS float*)d_in[8]; a.ffn_w_out = (const GAS float*)d_in[9];
    a.fourier_w_o = (const GAS float*)d_in[10]; a.ssm_a_re = (const GAS float*)d_in[11]; a.ssm_a_im = (const GAS float*)d_in[12]; a.ssm_log_dt = (const GAS float*)d_in[13];
    a.ssm_b = (const GAS float*)d_in[14]; a.ssm_c = (const GAS float*)d_in[15]; a.ssm_d = (const GAS float*)d_in[16]; a.ssm_w_glu = (const GAS float*)d_in[17]; a.final_g = (const GAS float*)d_in[18];
    a.out = (GAS float*)d_out; a.ws = (GAS unsigned char*)d_ws;
#if MK_PER_PHASE
    for (int i = 0; i < N_PHASES; ++i) { a.ph_lo = i; a.ph_hi = i + 1; hipLaunchKernelGGL(fwd_kernel, dim3(grid), dim3(NTHR), LDS_BYTES, stream, a); }
#else
    a.ph_lo = 0; a.ph_hi = N_PHASES;
    hipLaunchKernelGGL(fwd_kernel, dim3(grid), dim3(NTHR), LDS_BYTES, stream, a);
#endif
    const hipError_t le = hipPeekAtLastError();
    if (le != hipSuccess) fprintf(stderr, "kernel_launch: launch failed: %s\n", hipGetErrorName(le));
}
```

```cpp
#include <hip/hip_runtime.h>
#include <cstdio>
#include <cstdint>

#define LAS __attribute__((address_space(3)))
#define GAS __attribute__((address_space(1)))
typedef _Float16 f16;
typedef _Float16 f16x8 __attribute__((ext_vector_type(8)));
typedef _Float16 f16x4 __attribute__((ext_vector_type(4)));
typedef _Float16 f16x2 __attribute__((ext_vector_type(2)));
typedef float f32x4 __attribute__((ext_vector_type(4)));
typedef float f32x2 __attribute__((ext_vector_type(2)));
typedef short s16x8 __attribute__((ext_vector_type(8)));
typedef __bf16 bf16x2_t __attribute__((ext_vector_type(2)));
typedef unsigned u32x4 __attribute__((ext_vector_type(4)));
typedef unsigned u32x2 __attribute__((ext_vector_type(2)));

constexpr int D = 2048, DFF = 5632, MTOK = 16384, NPROMPT = 8192, SEQ_P = 256, SEQ_S = 4096, NB_P = 32, NB_S = 2;
constexpr int DEPTH = 4, NMOD = 9, SSM_G = 128, SSM_P = 64, SSM_H = 16;
constexpr float RMS_EPS = 1e-6f;
constexpr int NWAVES = 8, NTHR = 512;

constexpr size_t MiB = 1u << 20;
constexpr size_t WS_CTL = 0, CTL_ZERO_BYTES = 1 * MiB;
constexpr size_t WS_MOD = 1 * MiB;
constexpr size_t WS_MODP = 2 * MiB;
constexpr size_t WS_AL = 18 * MiB;
constexpr size_t WS_W2T = 19 * MiB;
constexpr size_t WS_CS256 = 19 * MiB + 512 * 1024;
constexpr size_t WS_PE = 19 * MiB + 768 * 1024;
constexpr size_t WS_HCN = 18 * MiB + 512 * 1024;
constexpr size_t WS_CS4096 = 20 * MiB;
constexpr size_t WS_W1 = 84 * MiB;
constexpr size_t WS_TW = 116 * MiB;
constexpr size_t WS_WO = 180 * MiB;
constexpr size_t WS_WGLU = 196 * MiB;
constexpr size_t WS_WIN = 228 * MiB;
constexpr size_t WS_WOUT = 580 * MiB;
constexpr size_t WS_H = 756 * MiB;
constexpr size_t WS_ACT = 820 * MiB;
constexpr size_t WS_HT = 820 * MiB;
constexpr size_t WS_F = 948 * MiB;
constexpr size_t WS_S = 820 * MiB;
constexpr size_t WS_CC = 948 * MiB;
constexpr size_t WS_G = 1012 * MiB;
constexpr size_t WS_XH = 1076 * MiB;
constexpr size_t WS_SLOT = 1140 * MiB;
constexpr size_t WS_GS = 1147 * MiB;
constexpr size_t WS_END = 1148 * MiB;
constexpr int CW_PANEL = 196608;
constexpr int CW_BAR = 4096;

constexpr int STAGE_BYTES = 131072;
constexpr int MISC_OFF = STAGE_BYTES;
constexpr int LDS_BYTES = 147456;

namespace pg8 {
constexpr int BM = 256, BK = 64, HALF = 128, HTB = HALF * BK * 2, NXCD = 8, WGM = 4;
__host__ __device__ __forceinline__ int lds_byte(int r, int c) { const int st = (r >> 4) * 2 + (c >> 5), rr = r & 15, cc = c & 31, ob = rr * 64 + cc * 2; return st * 1024 + (ob ^ (((ob >> 9) & 1) << 5)); }
__host__ __device__ __forceinline__ void stage_rc(int b, int& R, int& C) { const int st = b / 1024, sb = b % 1024, swz = sb ^ (((sb >> 9) & 1) << 5); R = (st >> 1) * 16 + swz / 64; C = (st & 1) * 32 + (swz % 64) / 2; }
__host__ __device__ __forceinline__ int perm32(int rho) { const int n = rho >> 4, i = rho & 15; return 8 * (i >> 2) + 4 * n + (i & 3); }

struct Unit { int pm, pn, z; };

constexpr unsigned PLANE_B = 16384u * 32u;
template <bool GRP> struct Prob {
    const char* A; const char* A2; const char* B; int nt, ksplit; unsigned lda2, ldb2; size_t a_t, a_z, b_t, b_z; unsigned a_k, b_k;
    __device__ __forceinline__ const char* a_ptr(const Unit& u, int t) const { const char* p = (t < ksplit) ? A + (size_t)t * a_k : A2 + (size_t)(t - ksplit) * a_k; return p + (size_t)u.pm * a_t + (size_t)u.z * a_z; }
    __device__ __forceinline__ const char* b_ptr(const Unit& u, int t) const { return B + (size_t)t * b_k + (size_t)u.pn * b_t + (size_t)u.z * b_z; }
    __device__ __forceinline__ unsigned a_off(int R, int C) const { return GRP ? (unsigned)R * lda2 + (unsigned)(C >> 4) * PLANE_B + (unsigned)(C & 15) * 2u : (unsigned)R * lda2 + (unsigned)C * 2u; }
    __device__ __forceinline__ unsigned b_off(int R, int C) const { return (unsigned)R * ldb2 + (unsigned)C * 2u; }
};

struct ProbFA : Prob<false> {
    size_t b_m;
    __device__ __forceinline__ const char* b_ptr(const Unit& u, int t) const { return B + (size_t)t * b_k + (size_t)u.pn * b_t + (size_t)u.z * b_z + ((u.pn >= 32 && u.pm == 1) ? b_m : (size_t)0); }
};

struct StaticOrder {
    int nM, nN, nwg, G, c;
    __device__ void init(int M, int N, int G_, int c_) { nM = M / BM; nN = N / BM; nwg = nM * nN; G = G_; c = c_; }
    __device__ bool next(int i, Unit& u) const {
        const long L = (long)i * G + c; if (L >= nwg) return false;
        int wgid = (int)L; { const int q = nwg / NXCD, r = nwg % NXCD, xcd = wgid % NXCD, off = wgid / NXCD; wgid = (xcd < r ? xcd * (q + 1) : r * (q + 1) + (xcd - r) * q) + off; }
        const int nig = WGM * nN, gid = wgid / nig, fm = gid * WGM, gsz = (nM - fm) < WGM ? (nM - fm) : WGM;
        u.pm = fm + ((wgid % nig) % gsz); u.pn = (wgid % nig) / gsz; u.z = 0; return true;
    }
};

template <class P, class Epi, class Sched, bool ALIGN_EPI, bool SP2>
__device__ __forceinline__ void gemm_phase(LAS unsigned char* lds, const P& p, const Sched& S, const Epi& E) {
    int tid_ = threadIdx.x; asm volatile("" : "+v"(tid_));
    const int tid = tid_, wid = __builtin_amdgcn_readfirstlane(tid >> 6), lane = tid & 63, wr = wid >> 2, wc = wid & 3, fr = lane & 15, fq = lane >> 4;
    int nt = p.nt; asm volatile("" : "+s"(nt));
    unsigned voffA[2], voffB[2];
#pragma unroll
    for (int i = 0; i < 2; ++i) { int R, C; stage_rc(tid * 16 + i * 8192, R, C); const int Rb = Epi::PERM ? ((R & ~31) + perm32(R & 31)) : R;
        voffA[i] = p.a_off(R, C); voffB[i] = p.b_off(Rb, C); }
    const size_t ahs = (size_t)HALF * p.lda2, bhs = (size_t)HALF * p.ldb2;
    const unsigned ldsw = (unsigned)wid * 1024u;
    const int aoff = lds_byte(wr * 64 + fr, fq * 8), boff = lds_byte(wc * 32 + fr, fq * 8);
#define PG8_SA(b, h) (((b) * 2 + (h)) * HTB)
#define PG8_SB(b, h) ((4 + (b) * 2 + (h)) * HTB)
#define PG8_STAGE(bufoff, gbase, voff) do { _Pragma("unroll") for (int _i = 0; _i < 2; ++_i) \
        __builtin_amdgcn_global_load_lds((const unsigned*)((const char*)(gbase) + (voff)[_i]), (LAS unsigned*)(lds + (bufoff) + ldsw + _i * 8192), 16, 0, 0); } while (0)
#define PG8_LDA(dst, b, h) do { _Pragma("unroll") for (int m = 0; m < 4; ++m) _Pragma("unroll") for (int k = 0; k < 2; ++k) dst[m][k] = *(const LAS f16x8*)(lds + PG8_SA(b, h) + aoff + m * 2048 + k * 1024); } while (0)
#define PG8_LDB(dst, b, h) do { _Pragma("unroll") for (int n = 0; n < 2; ++n) _Pragma("unroll") for (int k = 0; k < 2; ++k) dst[n][k] = *(const LAS f16x8*)(lds + PG8_SB(b, h) + boff + n * 2048 + k * 1024); } while (0)
#define PG8_MMA(ai, bj, At, Bt) do { __builtin_amdgcn_s_setprio(1); _Pragma("unroll") for (int m = 0; m < 4; ++m) _Pragma("unroll") for (int n = 0; n < 2; ++n) _Pragma("unroll") for (int k = 0; k < 2; ++k) \
        { if constexpr (Epi::BF16) acc[ai][bj][m][n] = __builtin_amdgcn_mfma_f32_16x16x32_bf16(__builtin_bit_cast(s16x8, Bt[n][k]), __builtin_bit_cast(s16x8, At[m][k]), acc[ai][bj][m][n], 0, 0, 0); \
          else acc[ai][bj][m][n] = __builtin_amdgcn_mfma_f32_16x16x32_f16(Bt[n][k], At[m][k], acc[ai][bj][m][n], 0, 0, 0); } __builtin_amdgcn_s_setprio(0); } while (0)
#define PG8_WAIT_V(n) asm volatile("s_waitcnt vmcnt(" #n ")" ::: "memory")
#define PG8_WAIT_L(n) asm volatile("s_waitcnt lgkmcnt(" #n ")" ::: "memory")
#define PG8_BAR __builtin_amdgcn_s_barrier()
#define PG8_SCHED __builtin_amdgcn_sched_barrier(0)
    Unit cur, nxt; int ui = 0;
    if (!S.next(0, cur)) return;
    f32x4 acc[2][2][4][2];
#pragma unroll
    for (int a = 0; a < 2; ++a)
#pragma unroll
        for (int b = 0; b < 2; ++b)
#pragma unroll
            for (int m = 0; m < 4; ++m)
#pragma unroll
                for (int n = 0; n < 2; ++n) acc[a][b][m][n] = (f32x4){0.f, 0.f, 0.f, 0.f};
    f16x8 At[4][2], B0[2][2], B1[2][2];
    {
        const char* cA0 = p.a_ptr(cur, 0); const char* cB0 = p.b_ptr(cur, 0); const char* cA1 = p.a_ptr(cur, 1); const char* cB1 = p.b_ptr(cur, 1);
        if constexpr (SP2) {
            PG8_STAGE(PG8_SB(0, 0), cB0, voffB); PG8_STAGE(PG8_SB(0, 1), cB0 + bhs, voffB); PG8_STAGE(PG8_SA(0, 0), cA0, voffA); PG8_STAGE(PG8_SA(0, 1), cA0 + ahs, voffA);
            if (wr == 1) PG8_BAR;
            PG8_WAIT_V(2); PG8_BAR;
            PG8_STAGE(PG8_SB(1, 0), cB1, voffB); PG8_STAGE(PG8_SA(1, 0), cA1, voffA); PG8_STAGE(PG8_SB(1, 1), cB1 + bhs, voffB);
            PG8_WAIT_V(6); PG8_BAR;
        } else {
            PG8_STAGE(PG8_SB(0, 0), cB0, voffB); PG8_STAGE(PG8_SA(0, 0), cA0, voffA); PG8_STAGE(PG8_SB(0, 1), cB0 + bhs, voffB); PG8_STAGE(PG8_SA(0, 1), cA0 + ahs, voffA);
            if (wr == 1) PG8_BAR;
            PG8_WAIT_V(4); PG8_BAR;
            PG8_STAGE(PG8_SB(1, 0), cB1, voffB); PG8_STAGE(PG8_SA(1, 0), cA1, voffA); PG8_STAGE(PG8_SB(1, 1), cB1 + bhs, voffB);
            PG8_WAIT_V(6); PG8_BAR;
        }
    }
    for (;;) {
        const bool has_next = S.next(ui + 1, nxt);
        const Unit nu = has_next ? nxt : cur;
#pragma nounroll
        for (int t = 0; t < nt; t += 2) {
            const bool last = (t == nt - 2);
            const char* a1 = p.a_ptr(cur, t + 1);
            const char* a2 = last ? p.a_ptr(nu, 0) : p.a_ptr(cur, t + 2); const char* b2 = last ? p.b_ptr(nu, 0) : p.b_ptr(cur, t + 2);
            const char* a3 = last ? p.a_ptr(nu, 1) : p.a_ptr(cur, t + 3); const char* b3 = last ? p.b_ptr(nu, 1) : p.b_ptr(cur, t + 3);
            if constexpr (SP2) {
            PG8_LDB(B0, 0, 0); PG8_LDB(B1, 0, 1); PG8_SCHED; PG8_LDA(At, 0, 0); PG8_STAGE(PG8_SA(1, 1), a1 + ahs, voffA);
            PG8_WAIT_V(8); PG8_WAIT_L(0); PG8_BAR; PG8_MMA(0, 0, At, B0); PG8_MMA(0, 1, At, B1); PG8_BAR; PG8_SCHED;
            PG8_LDA(At, 0, 1); PG8_STAGE(PG8_SB(0, 0), b2, voffB); PG8_STAGE(PG8_SB(0, 1), b2 + bhs, voffB); PG8_STAGE(PG8_SA(0, 0), a2, voffA);
            PG8_WAIT_V(8); PG8_WAIT_L(0); PG8_BAR; PG8_MMA(1, 0, At, B0); PG8_MMA(1, 1, At, B1); PG8_BAR; PG8_SCHED;
            PG8_LDB(B0, 1, 0); PG8_LDB(B1, 1, 1); PG8_SCHED; PG8_LDA(At, 1, 0); PG8_STAGE(PG8_SA(0, 1), a2 + ahs, voffA);
            PG8_WAIT_V(8); PG8_WAIT_L(0); PG8_BAR; PG8_MMA(0, 0, At, B0); PG8_MMA(0, 1, At, B1); PG8_BAR; PG8_SCHED;
            PG8_LDA(At, 1, 1); PG8_STAGE(PG8_SB(1, 0), b3, voffB); PG8_STAGE(PG8_SB(1, 1), b3 + bhs, voffB); PG8_STAGE(PG8_SA(1, 0), a3, voffA);
            PG8_WAIT_V(8); PG8_WAIT_L(0); PG8_BAR; PG8_MMA(1, 0, At, B0); PG8_MMA(1, 1, At, B1); PG8_BAR; PG8_SCHED;
            } else {
            PG8_LDB(B0, 0, 0); PG8_SCHED; PG8_LDA(At, 0, 0); PG8_STAGE(PG8_SA(1, 1), a1 + ahs, voffA);
            PG8_WAIT_L(8); PG8_BAR; PG8_WAIT_L(0); PG8_MMA(0, 0, At, B0); PG8_BAR; PG8_SCHED;
            PG8_LDB(B1, 0, 1); PG8_STAGE(PG8_SB(0, 0), b2, voffB);
            PG8_BAR; PG8_WAIT_L(0); PG8_MMA(0, 1, At, B1); PG8_BAR;
            PG8_LDA(At, 0, 1); PG8_STAGE(PG8_SA(0, 0), a2, voffA);
            PG8_BAR; PG8_WAIT_L(0); PG8_MMA(1, 0, At, B0); PG8_BAR; PG8_SCHED;
            PG8_STAGE(PG8_SB(0, 1), b2 + bhs, voffB);
            PG8_WAIT_V(6); PG8_BAR; PG8_MMA(1, 1, At, B1); PG8_BAR;
            PG8_LDB(B0, 1, 0); PG8_SCHED; PG8_LDA(At, 1, 0); PG8_STAGE(PG8_SA(0, 1), a2 + ahs, voffA);
            PG8_WAIT_L(8); PG8_BAR; PG8_WAIT_L(0); PG8_MMA(0, 0, At, B0); PG8_BAR; PG8_SCHED;
            PG8_LDB(B1, 1, 1); PG8_STAGE(PG8_SB(1, 0), b3, voffB);
            PG8_BAR; PG8_WAIT_L(0); PG8_MMA(0, 1, At, B1); PG8_BAR;
            PG8_LDA(At, 1, 1); PG8_STAGE(PG8_SA(1, 0), a3, voffA);
            PG8_BAR; PG8_WAIT_L(0); PG8_MMA(1, 0, At, B0); PG8_BAR; PG8_SCHED;
            PG8_STAGE(PG8_SB(1, 1), b3 + bhs, voffB);
            PG8_WAIT_V(6); PG8_BAR; PG8_MMA(1, 1, At, B1); PG8_BAR;
            }
        }
        if constexpr (ALIGN_EPI) { if (wr == 0) PG8_BAR; }
        E(acc, cur, wr, wc, fr, fq);
        if (!has_next) break;
#pragma unroll
        for (int a = 0; a < 2; ++a)
#pragma unroll
            for (int b = 0; b < 2; ++b)
#pragma unroll
                for (int m = 0; m < 4; ++m)
#pragma unroll
                    for (int n = 0; n < 2; ++n) acc[a][b][m][n] = (f32x4){0.f, 0.f, 0.f, 0.f};
        cur = nxt; ++ui;
        if constexpr (ALIGN_EPI) { if (wr == 1) PG8_BAR; }
    }
    PG8_WAIT_V(0);
    if constexpr (!ALIGN_EPI) { if (wr == 0) PG8_BAR; }
    PG8_BAR;
#undef PG8_SA
#undef PG8_SB
#undef PG8_STAGE
#undef PG8_LDA
#undef PG8_LDB
#undef PG8_MMA
#undef PG8_WAIT_V
#undef PG8_WAIT_L
#undef PG8_BAR
#undef PG8_SCHED
}
}
using pg8::Unit;

#define RLX_AGENT __ATOMIC_RELAXED, __HIP_MEMORY_SCOPE_AGENT
#define LDS_WAIT() asm volatile("s_waitcnt lgkmcnt(0)" ::: "memory")
#define VM_WAIT() asm volatile("s_waitcnt vmcnt(0)" ::: "memory")
__device__ __forceinline__ unsigned pk2h_(float lo, float hi) { f32x2 v = {lo, hi}; f16x2 h = __builtin_convertvector(v, f16x2); return __builtin_bit_cast(unsigned, h); }
__device__ __forceinline__ unsigned pk2b(float lo, float hi) { f32x2 v = {lo, hi}; bf16x2_t b = __builtin_convertvector(v, bf16x2_t); return __builtin_bit_cast(unsigned, b); }
#ifndef FFN_BF16
#define FFN_BF16 1
#endif
__device__ __forceinline__ unsigned pk2x(float lo, float hi, bool bf) { return bf ? pk2b(lo, hi) : pk2h_(lo, hi); }
__device__ __forceinline__ unsigned pk2h(float lo, float hi) { f32x2 v = {lo, hi}; f16x2 h = __builtin_convertvector(v, f16x2); return __builtin_bit_cast(unsigned, h); }
__device__ __forceinline__ float wave_sum(float v, int lane) {
#pragma unroll
    for (int o = 1; o < 64; o <<= 1) v += __builtin_bit_cast(float, __builtin_amdgcn_ds_bpermute((lane ^ o) << 2, __builtin_bit_cast(int, v)));
    return v;
}
__device__ __forceinline__ float sigmoid_f(float x) { return __builtin_amdgcn_rcpf(1.0f + __builtin_amdgcn_exp2f(-1.4426950408889634f * x)); }
__device__ __forceinline__ float gelu_tanh_f(float x) {
    const float u2 = 1.5957691216057308f * (x + 0.044715f * x * x * x);
    return x * sigmoid_f(u2);
}
__device__ __forceinline__ int cond_of_panel(int pm) { return pm < 32 ? 0 : (pm < 48 ? 1 : 2); }

#define XB_TMO      128
#define XB_XCNT(j)  (256  + 64 * (j))
#define XB_XSUB(j)  (1280 + 64 * (j))
#define XB_XGEN(j)  (2304 + 64 * (j))
#define XB_TOP      3328
#define XB_TOPGEN   3392
#define XCD_BAR_WORDS 3456
#define XB_SPIN_CAP (1u << 18)
__device__ __forceinline__ unsigned xb_ld(unsigned* p)              { return __hip_atomic_load(p, __ATOMIC_RELAXED, __HIP_MEMORY_SCOPE_AGENT); }
__device__ __forceinline__ unsigned xb_add(unsigned* p, unsigned v) { return __hip_atomic_fetch_add(p, v, __ATOMIC_RELAXED, __HIP_MEMORY_SCOPE_AGENT); }
__device__ __forceinline__ unsigned xb_xcc_id() { return (unsigned)__builtin_amdgcn_s_getreg((3 << 11) | 20) & 0xFu; }
#define XB_SPIN(cond, bar) do { unsigned _sp = 0; while (cond) { __builtin_amdgcn_s_sleep(1); \
    if ((++_sp & 255u) == 0u) { if (xb_ld(&(bar)[XB_TMO])) break; if (_sp > XB_SPIN_CAP) { atomicAdd(&(bar)[XB_TMO], 1u); break; } } } } while (0)
struct XcdBarrier { unsigned* bar; unsigned x; volatile LAS unsigned* st; };
__device__ __forceinline__ XcdBarrier xcd_barrier_post(unsigned* bar, volatile LAS unsigned* st) {
    XcdBarrier b; b.bar = bar; b.x = xb_xcc_id(); b.st = st;
    if (threadIdx.x == 0) (void)xb_add(&bar[XB_XCNT(b.x)], 1u);
    return b;
}
__device__ __forceinline__ void xcd_barrier_complete(unsigned* bar, unsigned x, unsigned& nloc, unsigned& nx) {
    const unsigned G = gridDim.x * gridDim.y * gridDim.z;
    unsigned sum, cnt, mine, sp = 0u;
    for (;;) {
        sum = 0u; cnt = 0u; mine = 0u;
#pragma unroll
        for (unsigned j = 0; j < 16; ++j) { const unsigned c = xb_ld(&bar[XB_XCNT(j)]); sum += c; cnt += (c > 0u) ? 1u : 0u; mine = (j == x) ? c : mine; }
        if (sum == G) break;
        __builtin_amdgcn_s_sleep(1);
        if ((++sp & 255u) == 0u) { if (xb_ld(&bar[XB_TMO])) break; if (sp > XB_SPIN_CAP) { atomicAdd(&bar[XB_TMO], 1u); break; } }
    }
    nloc = mine > 0u ? mine : 1u; nx = cnt > 0u ? cnt : 1u;
}
__device__ __forceinline__ void xcd_barrier(const XcdBarrier& b) {
    asm volatile("s_waitcnt vmcnt(0)" ::: "memory");
    __syncthreads();
    if (threadIdx.x == 0) {
        unsigned* bar = b.bar;
        __builtin_amdgcn_s_waitcnt(0);
        unsigned nloc = b.st[0], nx = b.st[1];
        if (nloc == 0u) { xcd_barrier_complete(bar, b.x, nloc, nx); b.st[0] = nloc; b.st[1] = nx; }
        const unsigned old = xb_add(&bar[XB_XSUB(b.x)], 1u);
        const unsigned gen = old / nloc;
        if (old + 1u == (gen + 1u) * nloc) {
            __builtin_amdgcn_fence(__ATOMIC_RELEASE, "agent");
            asm volatile("s_waitcnt vmcnt(0)" ::: "memory");
            const unsigned og = xb_add(&bar[XB_TOP], 1u);
            const unsigned tg = og / nx;
            if (og + 1u == (tg + 1u) * nx) xb_add(&bar[XB_TOPGEN], 1u);
            else XB_SPIN(xb_ld(&bar[XB_TOPGEN]) == tg, bar);
            __builtin_amdgcn_fence(__ATOMIC_ACQUIRE, "agent");
            xb_add(&bar[XB_XGEN(b.x)], 1u);
            asm volatile("s_waitcnt vmcnt(0)" ::: "memory");
        } else {
            XB_SPIN(xb_ld(&bar[XB_XGEN(b.x)]) == gen, bar);
            __builtin_amdgcn_fence(__ATOMIC_ACQUIRE, "agent");
            asm volatile("s_waitcnt vmcnt(0)" ::: "memory");
        }
    }
    __syncthreads();
}

struct Args {
    const float* x_prompt; const float* x_sample; const float* state_ssm; const float* c; const float* c_ctx;
    const float* w_ada; const float* b_ada; const float* norm_g; const float* ffn_w_in; const float* ffn_w_out;
    const float* fourier_w_o; const float* ssm_a_re; const float* ssm_a_im; const float* ssm_log_dt;
    const float* ssm_b; const float* ssm_c; const float* ssm_d; const float* ssm_w_glu; const float* final_g;
    float* out; unsigned char* ws; int ph_lo, ph_hi;
};
struct Frame {
    LAS unsigned char* lds; int tid, lane, wave, vcu, G, bx;
};

#define GL4S(dst, voff, sbase, off) "global_load_dwordx4 %" #dst ", %" #voff ", %" #sbase " offset:" #off "\n\t"
__device__ __forceinline__ void load_resid_tile(u32x4 (&x)[8][2], f32x4 (&g)[4], const f16* xb, unsigned o0, unsigned o1, unsigned o2, unsigned o3, unsigned o4, unsigned o5, unsigned o6, unsigned o7, const float* mb, unsigned om) {
    asm volatile(GL4S(0, 20, 29, 0) GL4S(1, 20, 29, 256) GL4S(2, 21, 29, 0) GL4S(3, 21, 29, 256) GL4S(4, 22, 29, 0) GL4S(5, 22, 29, 256) GL4S(6, 23, 29, 0) GL4S(7, 23, 29, 256)
                 GL4S(8, 24, 29, 0) GL4S(9, 24, 29, 256) GL4S(10, 25, 29, 0) GL4S(11, 25, 29, 256) GL4S(12, 26, 29, 0) GL4S(13, 26, 29, 256) GL4S(14, 27, 29, 0) GL4S(15, 27, 29, 256)
                 GL4S(16, 28, 30, 0) GL4S(17, 28, 30, 16) GL4S(18, 28, 30, 512) GL4S(19, 28, 30, 528)
                 "s_waitcnt vmcnt(0)"
                 : "=&v"(x[0][0]), "=&v"(x[0][1]), "=&v"(x[1][0]), "=&v"(x[1][1]), "=&v"(x[2][0]), "=&v"(x[2][1]), "=&v"(x[3][0]), "=&v"(x[3][1]),
                   "=&v"(x[4][0]), "=&v"(x[4][1]), "=&v"(x[5][0]), "=&v"(x[5][1]), "=&v"(x[6][0]), "=&v"(x[6][1]), "=&v"(x[7][0]), "=&v"(x[7][1]),
                   "=&v"(g[0]), "=&v"(g[1]), "=&v"(g[2]), "=&v"(g[3])
                 : "v"(o0), "v"(o1), "v"(o2), "v"(o3), "v"(o4), "v"(o5), "v"(o6), "v"(o7), "v"(om), "s"(xb), "s"(mb) : "memory");
}
__device__ __forceinline__ void load_resid_tile1(u32x4 (&x)[8], f32x4 (&g)[2], const f16* xb, unsigned o0, unsigned o1, unsigned o2, unsigned o3, unsigned o4, unsigned o5, unsigned o6, unsigned o7, const float* mb, unsigned om) {
    asm volatile(GL4S(0, 10, 19, 0) GL4S(1, 11, 19, 0) GL4S(2, 12, 19, 0) GL4S(3, 13, 19, 0) GL4S(4, 14, 19, 0) GL4S(5, 15, 19, 0) GL4S(6, 16, 19, 0) GL4S(7, 17, 19, 0)
                 GL4S(8, 18, 20, 0) GL4S(9, 18, 20, 16)
                 "s_waitcnt vmcnt(0)"
                 : "=&v"(x[0]), "=&v"(x[1]), "=&v"(x[2]), "=&v"(x[3]), "=&v"(x[4]), "=&v"(x[5]), "=&v"(x[6]), "=&v"(x[7]), "=&v"(g[0]), "=&v"(g[1])
                 : "v"(o0), "v"(o1), "v"(o2), "v"(o3), "v"(o4), "v"(o5), "v"(o6), "v"(o7), "v"(om), "s"(xb), "s"(mb) : "memory");
}
__device__ __forceinline__ void load_vec8(f32x4 (&g)[4], f32x4 (&s)[4], const float* ga, const float* sa, unsigned om) {
    asm volatile(GL4S(0, 8, 9, 0) GL4S(1, 8, 9, 16) GL4S(2, 8, 9, 512) GL4S(3, 8, 9, 528)
                 GL4S(4, 8, 10, 0) GL4S(5, 8, 10, 16) GL4S(6, 8, 10, 512) GL4S(7, 8, 10, 528)
                 "s_waitcnt vmcnt(0)"
                 : "=&v"(g[0]), "=&v"(g[1]), "=&v"(g[2]), "=&v"(g[3]), "=&v"(s[0]), "=&v"(s[1]), "=&v"(s[2]), "=&v"(s[3])
                 : "v"(om), "s"(ga), "s"(sa) : "memory");
}
__device__ __forceinline__ f32x2 h2f(unsigned u) { const f16x2 h = __builtin_bit_cast(f16x2, u); return (f32x2){(float)h[0], (float)h[1]}; }

struct EpiSwiGLU {
    static constexpr bool PERM = true, BF16 = (FFN_BF16 != 0);
    f16* O;
    __device__ __forceinline__ void operator()(const f32x4 (&acc)[2][2][4][2], const Unit& u, int wr, int wc, int fr, int fq) const {
        const int rip = wr * 64 + fr, col0 = u.pn * 128 + wc * 32 + 8 * fq;
#pragma unroll
        for (int ai = 0; ai < 2; ++ai)
#pragma unroll
            for (int m = 0; m < 4; ++m) {
                const f32x4 g0 = acc[ai][0][m][0], g1 = acc[ai][0][m][1], u0 = acc[ai][1][m][0], u1 = acc[ai][1][m][1];
                float r[8];
#pragma unroll
                for (int j = 0; j < 4; ++j) { r[j] = g0[j] * sigmoid_f(g0[j]) * u0[j]; r[4 + j] = g1[j] * sigmoid_f(g1[j]) * u1[j]; }
                u32x4 w; w.x = pk2x(r[0], r[1], BF16); w.y = pk2x(r[2], r[3], BF16); w.z = pk2x(r[4], r[5], BF16); w.w = pk2x(r[6], r[7], BF16);
                *(u32x4*)(O + ((size_t)u.pm * (DFF / 64) + (col0 >> 6)) * 16384 + (size_t)(rip + ai * 128 + m * 16) * 64 + (col0 & 63)) = w;
            }
    }
};
template <bool BF> struct EpiResidT {
    static constexpr bool PERM = true, BF16 = BF;
    f16* X; const float* modv; float coef;
    __device__ __forceinline__ void operator()(const f32x4 (&acc)[2][2][4][2], const Unit& u, int wr, int wc, int fr, int fq) const {
        const int row0 = u.pm * 256 + wr * 64 + fr, col0 = u.pn * 256 + wc * 32 + 8 * fq;
        const float* mb = modv + (size_t)cond_of_panel(u.pm) * (NMOD * D);
        const unsigned e0 = (unsigned)row0 * D + col0;
#define EO(r) (e0 + (unsigned)((((r) >> 2) * 128 + ((r) & 3) * 16) * D))
        u32x4 x[8][2]; f32x4 gv[4];
        load_resid_tile(x, gv, X, EO(0) * 2u, EO(1) * 2u, EO(2) * 2u, EO(3) * 2u, EO(4) * 2u, EO(5) * 2u, EO(6) * 2u, EO(7) * 2u, mb, (unsigned)col0 * 4u);
#pragma unroll
        for (int i = 0; i < 4; ++i) gv[i] = gv[i] * coef;
#pragma unroll
        for (int ai = 0; ai < 2; ++ai)
#pragma unroll
            for (int m = 0; m < 4; ++m)
#pragma unroll
                for (int bj = 0; bj < 2; ++bj) { const u32x4 xv = x[ai * 4 + m][bj];
                    const f32x2 a0 = h2f(xv.x), a1 = h2f(xv.y), a2 = h2f(xv.z), a3 = h2f(xv.w);
                    const f32x4 v0 = (f32x4){a0.x, a0.y, a1.x, a1.y} + gv[2 * bj] * acc[ai][bj][m][0], v1 = (f32x4){a2.x, a2.y, a3.x, a3.y} + gv[2 * bj + 1] * acc[ai][bj][m][1];
                    u32x4 w; w.x = pk2h(v0[0], v0[1]); w.y = pk2h(v0[2], v0[3]); w.z = pk2h(v1[0], v1[1]); w.w = pk2h(v1[2], v1[3]);
                    *(u32x4*)(X + EO(ai * 4 + m) + bj * 128) = w; }
#undef EO
    }
};
template <bool BF, int MODE, int CNUM, int CDEN> struct EpiResidNormT {
    static constexpr bool PERM = true, BF16 = BF; static constexpr float coef = (float)CNUM / (float)CDEN;
    unsigned char* ws; float* out; const float* modv; const float* fg; int inst, tl, tj; LAS unsigned char* lt;
    __device__ __forceinline__ void operator()(f32x4 (&acc)[2][2][4][2], const Unit& u, int wr, int wc, int fr, int fq) const {
        f16* X = (f16*)(ws + WS_XH);
        const int cond = cond_of_panel(u.pm), rt = wr * 64 + fr, lane = fq * 16 + fr, wid = wr * 4 + wc;
        const int row0 = u.pm * 256 + rt, col0 = u.pn * 256 + wc * 32 + 8 * fq;
        const float* mb = modv + (size_t)cond * (NMOD * D);
        const unsigned e0 = (unsigned)row0 * D + col0;
#define EO(r) (e0 + (unsigned)((((r) >> 2) * 128 + ((r) & 3) * 16) * D))
        float ps[8];
        {
            u32x4 x[8][2]; f32x4 gv[4];
            load_resid_tile(x, gv, X, EO(0) * 2u, EO(1) * 2u, EO(2) * 2u, EO(3) * 2u, EO(4) * 2u, EO(5) * 2u, EO(6) * 2u, EO(7) * 2u, mb, (unsigned)col0 * 4u);
#pragma unroll
            for (int i = 0; i < 4; ++i) gv[i] = gv[i] * coef;
#pragma unroll
            for (int ai = 0; ai < 2; ++ai)
#pragma unroll
                for (int m = 0; m < 4; ++m) { float s = 0.f;
#pragma unroll
                    for (int bj = 0; bj < 2; ++bj) { const u32x4 xv = x[ai * 4 + m][bj];
                        const f32x2 a0 = h2f(xv.x), a1 = h2f(xv.y), a2 = h2f(xv.z), a3 = h2f(xv.w);
                        const f32x4 v0 = (f32x4){a0.x, a0.y, a1.x, a1.y} + gv[2 * bj] * acc[ai][bj][m][0], v1 = (f32x4){a2.x, a2.y, a3.x, a3.y} + gv[2 * bj + 1] * acc[ai][bj][m][1];
                        acc[ai][bj][m][0] = v0; acc[ai][bj][m][1] = v1;
                        const f32x4 q0 = v0 * v0, q1 = v1 * v1; s += ((q0[0] + q0[1]) + (q0[2] + q0[3])) + ((q1[0] + q1[1]) + (q1[2] + q1[3])); }
                    ps[ai * 4 + m] = s; }
        }
        LAS float* P = (LAS float*)lt; LAS float* S = (LAS float*)(lt + 4096);
#pragma unroll
        for (int r = 0; r < 8; ++r) { float s = ps[r];
            s += __builtin_bit_cast(float, __builtin_amdgcn_ds_bpermute((lane ^ 16) << 2, __builtin_bit_cast(int, s)));
            s += __builtin_bit_cast(float, __builtin_amdgcn_ds_bpermute((lane ^ 32) << 2, __builtin_bit_cast(int, s)));
            if (fq == 0) P[(rt + (r >> 2) * 128 + (r & 3) * 16) * 4 + wc] = s; }
        asm volatile("s_waitcnt lgkmcnt(0)" ::: "memory"); __builtin_amdgcn_s_barrier(); asm volatile("" ::: "memory");
        const int prow = wid * 32 + (lane & 31);
        unsigned long long* slots = (unsigned long long*)(ws + WS_SLOT) + (size_t)u.pm * 2048;
        const unsigned tag = (unsigned)inst + 1u;
        if (lane < 32) { const f32x4 p4 = *(const LAS f32x4*)(P + prow * 4);
            const float sm = (p4[0] + p4[1]) + (p4[2] + p4[3]);
            __hip_atomic_store(slots + u.pn * 256 + prow, ((unsigned long long)tag << 32) | (unsigned long long)__builtin_bit_cast(unsigned, sm), __ATOMIC_RELAXED, __HIP_MEMORY_SCOPE_AGENT); }
        { float t = 0.f; unsigned spins = 0;
            for (;;) { bool ok = true; t = 0.f;
#pragma unroll
                for (int k = 0; k < 8; ++k) { const unsigned long long g = __hip_atomic_load(slots + k * 256 + prow, __ATOMIC_RELAXED, __HIP_MEMORY_SCOPE_AGENT);
                    ok = ok && ((unsigned)(g >> 32) == tag); t += __builtin_bit_cast(float, (unsigned)g); }
                if (__builtin_amdgcn_ballot_w64(!ok) == 0ull) break;
                if (++spins > 20000u) break;
                __builtin_amdgcn_s_sleep(2); }
            if (lane < 32) S[prow] = 1.0f / sqrtf(t * (1.0f / D) + RMS_EPS); }
        asm volatile("s_waitcnt vmcnt(0) lgkmcnt(0)" ::: "memory"); __builtin_amdgcn_s_barrier(); asm volatile("" ::: "memory");
        const LAS float* V = (const LAS float*)(lt + 5120);
        const int cl = wc * 32 + 8 * fq;
#pragma unroll
        for (int bj = 0; bj < 2; ++bj) {
            const f32x4 g0 = *(const LAS f32x4*)(V + cl + bj * 128), g1 = *(const LAS f32x4*)(V + cl + bj * 128 + 4);
            const f32x4 s0 = *(const LAS f32x4*)(V + 256 + cl + bj * 128), s1 = *(const LAS f32x4*)(V + 256 + cl + bj * 128 + 4);
#pragma unroll
            for (int ai = 0; ai < 2; ++ai)
#pragma unroll
                for (int m = 0; m < 4; ++m) { const float rstd = S[rt + ai * 128 + m * 16];
                    if (MODE != 2) { const f32x4 v0 = acc[ai][bj][m][0], v1 = acc[ai][bj][m][1];
                        u32x4 w; w.x = pk2h(v0[0], v0[1]); w.y = pk2h(v0[2], v0[3]); w.z = pk2h(v1[0], v1[1]); w.w = pk2h(v1[2], v1[3]); *(u32x4*)(X + EO(ai * 4 + m) + bj * 128) = w; }
                    f32x4 h0 = acc[ai][bj][m][0] * rstd * g0, h1 = acc[ai][bj][m][1] * rstd * g1;
                    if (MODE != 2) { h0 = h0 + s0; h1 = h1 + s1; }
                    if (MODE == 0) { constexpr bool OB = (FFN_BF16 != 0);
                        u32x4 w; w.x = pk2x(h0[0], h0[1], OB); w.y = pk2x(h0[2], h0[3], OB); w.z = pk2x(h1[0], h1[1], OB); w.w = pk2x(h1[2], h1[3], OB);
                        *(u32x4*)((f16*)(ws + WS_H) + EO(ai * 4 + m) + bj * 128) = w; }
                    else if (MODE == 1) { const int c = col0 + bj * 128, tok = u.pm * 256 + rt + ai * 128 + m * 16;
                        u32x4 w; w.x = pk2h(h0[0], h0[1]); w.y = pk2h(h0[2], h0[3]); w.z = pk2h(h1[0], h1[1]); w.w = pk2h(h1[2], h1[3]);
                        *(u32x4*)((f16*)(ws + WS_H) + (size_t)(c >> 4) * (MTOK * 16) + (size_t)tok * 16 + ((c >> 3) & 1) * 8) = w; }
                    else { float* o = out + EO(ai * 4 + m) + bj * 128; *(f32x4*)o = h0; *(f32x4*)(o + 4) = h1; } }
        }
#undef EO
    }
};
__device__ __forceinline__ void fused_norm_vectors(unsigned char* ws, const float* fg, LAS unsigned char* lt, const pg8::StaticOrder& S, int tl, int tj, bool mode2, int tid) {
    Unit u0; if (!S.next(0, u0)) return;
    const int cond = cond_of_panel(u0.pm);
    LAS float* V = (LAS float*)(lt + 5120);
    if (tid < 256) { const int col = u0.pn * 256 + tid;
        V[tid] = mode2 ? fg[col] : ((const float*)(ws + WS_GS))[((size_t)(tl * 3 + tj) * 3 + cond) * D + col];
        V[256 + tid] = mode2 ? 0.f : ((const float*)(ws + WS_MOD))[((size_t)(tl * 3 + cond) * NMOD + 3 * tj) * D + col]; }
    __syncthreads();
}
struct EpiGLUResid {
    static constexpr bool PERM = true, BF16 = (FFN_BF16 != 0);
    f16* X; const float* modv; float coef;
    __device__ __forceinline__ void operator()(const f32x4 (&acc)[2][2][4][2], const Unit& u, int wr, int wc, int fr, int fq) const {
        const int row0 = u.pm * 256 + wr * 64 + fr, col0 = u.pn * 128 + wc * 32 + 8 * fq;
        const float* mb = modv + (size_t)cond_of_panel(u.pm) * (NMOD * D);
        const unsigned e0 = (unsigned)row0 * D + col0;
#define EO(r) (e0 + (unsigned)((((r) >> 2) * 128 + ((r) & 3) * 16) * D))
        u32x4 x[8]; f32x4 mm[2];
        load_resid_tile1(x, mm, X, EO(0) * 2u, EO(1) * 2u, EO(2) * 2u, EO(3) * 2u, EO(4) * 2u, EO(5) * 2u, EO(6) * 2u, EO(7) * 2u, mb, (unsigned)col0 * 4u);
        const f32x4 m0 = mm[0] * coef, m1 = mm[1] * coef;
#pragma unroll
        for (int ai = 0; ai < 2; ++ai)
#pragma unroll
            for (int m = 0; m < 4; ++m) {
                const f32x4 v0 = acc[ai][0][m][0], v1 = acc[ai][0][m][1], g0 = acc[ai][1][m][0], g1 = acc[ai][1][m][1];
                f32x4 o0, o1;
#pragma unroll
                for (int j = 0; j < 4; ++j) { o0[j] = v0[j] * sigmoid_f(g0[j]); o1[j] = v1[j] * sigmoid_f(g1[j]); }
                const u32x4 xv = x[ai * 4 + m]; const f32x2 a0 = h2f(xv.x), a1 = h2f(xv.y), a2 = h2f(xv.z), a3 = h2f(xv.w);
                const f32x4 n0 = (f32x4){a0.x, a0.y, a1.x, a1.y} + m0 * o0, n1 = (f32x4){a2.x, a2.y, a3.x, a3.y} + m1 * o1;
                u32x4 w; w.x = pk2h(n0[0], n0[1]); w.y = pk2h(n0[2], n0[3]); w.z = pk2h(n1[0], n1[1]); w.w = pk2h(n1[2], n1[3]);
                *(u32x4*)(X + EO(ai * 4 + m)) = w; }
#undef EO
    }
};
struct EpiFA {
    static constexpr bool PERM = true, BF16 = false;
    f16* HT;
    __device__ __forceinline__ void operator()(const f32x4 (&acc)[2][2][4][2], const Unit& u, int wr, int wc, int fr, int fq) const {
        const int P = u.pn; const int n = P < 32 ? SEQ_P : SEQ_S / 2;
        const size_t hb = P < 32 ? (size_t)P * (D * 2 * SEQ_P) : (size_t)NB_P * (D * 2 * SEQ_P) + (size_t)((P - 32) >> 4) * ((size_t)D * SEQ_S);
        const int t0 = (P < 32 ? 0 : ((P - 32) & 15) * 256) + wc * 32 + 8 * fq;
        const int q0 = wr * 64 + fr;
#pragma unroll
        for (int ai = 0; ai < 2; ++ai)
#pragma unroll
            for (int m = 0; m < 4; ++m) { const int q = q0 + ai * 128 + m * 16;
                f16* rowp = HT + hb + ((size_t)(u.z * 256 + q) * 2 + u.pm) * n + t0;
#pragma unroll
                for (int bj = 0; bj < 2; ++bj) { const f32x4 v0 = acc[ai][bj][m][0], v1 = acc[ai][bj][m][1];
                    u32x4 w; w.x = pk2h(v0[0], v0[1]); w.y = pk2h(v0[2], v0[3]); w.z = pk2h(v1[0], v1[1]); w.w = pk2h(v1[2], v1[3]);
                    *(u32x4*)(rowp + bj * 128) = w; } }
    }
};
struct EpiFB {
    static constexpr bool PERM = true, BF16 = false;
    f16* F; int row0, zrows; float scale; const float* hcn;
    __device__ __forceinline__ void operator()(const f32x4 (&acc)[2][2][4][2], const Unit& u, int wr, int wc, int fr, int fq) const {
        const int r0 = row0 + u.z * zrows + u.pm * 256 + wr * 64 + fr, col0 = u.pn * 256 + wc * 32 + 8 * fq;
        f32x4 nq[2][2];
#pragma unroll
        for (int bj = 0; bj < 2; ++bj)
#pragma unroll
            for (int n = 0; n < 2; ++n) { nq[bj][n] = (f32x4){0.f, 0.f, 0.f, 0.f};
                if (hcn) { const f32x4 h = *(const f32x4*)(hcn + (size_t)u.z * D + col0 + bj * 128 + n * 4); nq[bj][n] = (fr & 1) ? -h : h; } }
#pragma unroll
        for (int ai = 0; ai < 2; ++ai)
#pragma unroll
            for (int m = 0; m < 4; ++m) { f16* rowp = F + (size_t)(r0 + ai * 128 + m * 16) * D + col0;
#pragma unroll
                for (int bj = 0; bj < 2; ++bj) { const f32x4 v0 = (acc[ai][bj][m][0] + nq[bj][0]) * scale, v1 = (acc[ai][bj][m][1] + nq[bj][1]) * scale;
                    constexpr bool OB = (FFN_BF16 != 0);
                    u32x4 w; w.x = pk2x(v0[0], v0[1], OB); w.y = pk2x(v0[2], v0[3], OB); w.z = pk2x(v1[0], v1[1], OB); w.w = pk2x(v1[2], v1[3], OB);
                    *(u32x4*)(rowp + bj * 128) = w; } }
    }
};
struct EpiS1 {
    static constexpr bool PERM = true, BF16 = false;
    f16* S;
    __device__ __forceinline__ void operator()(const f32x4 (&acc)[2][2][4][2], const Unit& u, int wr, int wc, int fr, int fq) const {
        const int r0 = u.pm * 256 + wr * 64 + fr, col0 = wc * 32 + 8 * fq;
#pragma unroll
        for (int ai = 0; ai < 2; ++ai)
#pragma unroll
            for (int m = 0; m < 4; ++m) { f16* rowp = S + ((size_t)u.z * 1024 + (r0 + ai * 128 + m * 16)) * 256 + col0;
#pragma unroll
                for (int bj = 0; bj < 2; ++bj) { const f32x4 v0 = acc[ai][bj][m][0], v1 = acc[ai][bj][m][1];
                    u32x4 w; w.x = pk2h(v0[0], v0[1]); w.y = pk2h(v0[2], v0[3]); w.z = pk2h(v1[0], v1[1]); w.w = pk2h(v1[2], v1[3]);
                    *(u32x4*)(rowp + bj * 128) = w; } }
    }
};
struct EpiS3 {
    static constexpr bool PERM = true, BF16 = false;
    f16* Gg;
    __device__ __forceinline__ void operator()(const f32x4 (&acc)[2][2][4][2], const Unit& u, int wr, int wc, int fr, int fq) const {
        const int r0 = u.pm * 256 + wr * 64 + fr, col0 = wc * 32 + 8 * fq;
#pragma unroll
        for (int ai = 0; ai < 2; ++ai)
#pragma unroll
            for (int m = 0; m < 4; ++m) { f16* rowp = Gg + ((size_t)u.z * 1024 + (r0 + ai * 128 + m * 16)) * 256 + col0;
#pragma unroll
                for (int bj = 0; bj < 2; ++bj) { const f32x4 v0 = acc[ai][bj][m][0], v1 = acc[ai][bj][m][1];
                    float rr[8];
#pragma unroll
                    for (int k = 0; k < 4; ++k) { rr[k] = gelu_tanh_f(v0[k]); rr[4 + k] = gelu_tanh_f(v1[k]); }
                    constexpr bool OB = (FFN_BF16 != 0);
                    u32x4 w; w.x = pk2x(rr[0], rr[1], OB); w.y = pk2x(rr[2], rr[3], OB); w.z = pk2x(rr[4], rr[5], OB); w.w = pk2x(rr[6], rr[7], OB);
                    *(u32x4*)(rowp + bj * 128) = w; } }
    }
};

struct SchedFA {
    int vcu;
    __device__ bool next(int i, Unit& u) const { const int idx = i * 256 + vcu; if (idx >= 768) return false; u.pm = idx & 1; u.z = (idx >> 1) & 7;
        if (idx < 512) u.pn = idx >> 4; else { const int j = idx - 512; u.pn = 32 + 16 * (j >> 7) + ((j >> 4) & 7); } return true; }
};
struct SchedFBs {
    int vcu;
    __device__ bool next(int i, Unit& u) const { if (i > 0) return false; u.z = vcu >> 7; u.pm = (vcu >> 3) & 15; u.pn = vcu & 7; return true; }
};
struct SchedFBp {
    int vcu;
    __device__ bool next(int i, Unit& u) const { if (i > 0) return false; u.z = vcu >> 3; u.pm = 0; u.pn = vcu & 7; return true; }
};
struct SchedS {
    int vcu;
    __device__ bool next(int i, Unit& u) const { const int idx = i * 256 + vcu; if (idx >= 512) return false; u.pm = idx & 3; u.z = idx >> 2; u.pn = 0; return true; }
};

struct TItem { const float* src; f16* dst; int N, K; bool bf; };
__device__ __forceinline__ TItem titem_make(const float* W, int K, int N, f16* WT, int half, int item) {
    const int nblk = N / 32, kb = item / nblk, nb = item % nblk, k0 = 64 * kb, n0 = 32 * nb;
    int d0 = n0;
    if (half > 0) { const int bj = n0 / half, rem = n0 % half; d0 = (rem / 128) * 256 + bj * 128 + (rem % 128); }
    TItem t; t.src = W + (size_t)k0 * N + n0; t.dst = WT + ((size_t)(d0 >> 8) * (K / 64) + (k0 >> 6)) * 16384 + (size_t)(d0 & 255) * 64; t.N = N; t.K = 64; t.bf = false; return t;
}
__device__ __forceinline__ TItem titem_decode(const Args& a, int it) {
    constexpr int I_IN = (D / 64) * (2 * DFF / 32), I_OUT = (DFF / 64) * (D / 32), I_O = (D / 64) * (D / 32), I_GLU = (D / 64) * (2 * D / 32);
    int r = it;
    if (r < 8 * I_IN) { const int mi = r / I_IN; TItem t = titem_make(a.ffn_w_in + (size_t)mi * D * 2 * DFF, D, 2 * DFF, (f16*)(a.ws + WS_WIN) + (size_t)mi * D * 2 * DFF, DFF, r % I_IN); t.bf = (FFN_BF16 != 0); return t; } r -= 8 * I_IN;
    if (r < 8 * I_OUT) { const int mi = r / I_OUT; TItem t = titem_make(a.ffn_w_out + (size_t)mi * DFF * D, DFF, D, (f16*)(a.ws + WS_WOUT) + (size_t)mi * DFF * D, 0, r % I_OUT); t.bf = (FFN_BF16 != 0); return t; } r -= 8 * I_OUT;
    if (r < 2 * I_O) { const int mi = r / I_O; TItem t = titem_make(a.fourier_w_o + (size_t)mi * D * D, D, D, (f16*)(a.ws + WS_WO) + (size_t)mi * D * D, 0, r % I_O); t.bf = (FFN_BF16 != 0); return t; } r -= 2 * I_O;
    { const int mi = r / I_GLU; TItem t = titem_make(a.ssm_w_glu + (size_t)mi * D * 2 * D, D, 2 * D, (f16*)(a.ws + WS_WGLU) + (size_t)mi * D * 2 * D, D, r % I_GLU); t.bf = (FFN_BF16 != 0); return t; }
}
__device__ __forceinline__ void titem_load(f32x4 (&v)[8], const TItem& t, int lane) {
    const float* p = t.src + (size_t)(lane >> 3) * t.N + (lane & 7) * 4;
#pragma unroll
    for (int i = 0; i < 8; ++i) v[i] = __builtin_nontemporal_load((const f32x4*)(p + (size_t)(8 * i) * t.N));
}
__device__ __forceinline__ void titem_store(const f32x4 (&v)[8], const TItem& t, LAS float* scr, int lane) {
#pragma unroll
    for (int i = 0; i < 8; ++i) { LAS float* s = scr + (8 * i + (lane >> 3)) * 33 + (lane & 7) * 4; s[0] = v[i][0]; s[1] = v[i][1]; s[2] = v[i][2]; s[3] = v[i][3]; }
    LDS_WAIT(); asm volatile("" ::: "memory");
    const int c = lane & 7;
#pragma unroll
    for (int j = 0; j < 4; ++j) { const int n = (lane >> 3) + 8 * j; const LAS float* s = scr + (8 * c) * 33 + n;
        u32x4 o; o.x = pk2x(s[0 * 33], s[1 * 33], t.bf); o.y = pk2x(s[2 * 33], s[3 * 33], t.bf); o.z = pk2x(s[4 * 33], s[5 * 33], t.bf); o.w = pk2x(s[6 * 33], s[7 * 33], t.bf);
        *(u32x4*)(t.dst + (size_t)n * t.K + 8 * c) = o; }
    LDS_WAIT(); asm volatile("" ::: "memory");
}

__device__ __forceinline__ void ssm_tables_item(const Args& a, int kk, int g, LAS unsigned char* sl, int tid) {
    LAS f32x2* apow = (LAS f32x2*)sl;
    LAS f32x2* bbar = (LAS f32x2*)(sl + 17408);
    LAS f32x2* cc   = (LAS f32x2*)(sl + 17408 + 16384);
    LAS float* klag = (LAS float*)(sl + 17408 + 32768);
    if (tid < 128) {
        const int d = tid >> 6, p = tid & 63;
        const size_t ia = ((size_t)(kk * 2 + d) * SSM_G + g) * SSM_P + p;
        const double are = (double)a.ssm_a_re[ia], aim = (double)a.ssm_a_im[ia];
        const double dt = exp((double)a.ssm_log_dt[(kk * 2 + d) * SSM_G + g]);
        const double mag = exp(are * dt), ang = aim * dt;
        const double abr = mag * cos(ang), abi = mag * sin(ang);
        double cr = 1.0, ci = 0.0;
        for (int m = 0; m <= 16; ++m) {
            apow[(d * 64 + p) * 17 + m] = (f32x2){(float)cr, (float)ci};
            if (m == 16) ((f32x2*)(a.ws + WS_AL))[((size_t)(kk * 2 + d) * SSM_G + g) * SSM_P + p] = (f32x2){(float)cr, (float)ci};
            const double nr = cr * abr - ci * abi, ni = cr * abi + ci * abr; cr = nr; ci = ni;
        }
        const double nr = abr - 1.0, ni = abi, den = are * are + aim * aim;
        const double qr = (nr * are + ni * aim) / den, qi = (ni * are - nr * aim) / den;
        const float* bp = a.ssm_b + (ia * SSM_H) * 2;
        for (int h = 0; h < 16; ++h) { const double br = (double)bp[2 * h], bi = (double)bp[2 * h + 1];
            bbar[(d * 64 + p) * 16 + h] = (f32x2){(float)(qr * br - qi * bi), (float)(qr * bi + qi * br)}; }
    }
    for (int i = tid; i < 2048; i += NTHR) {
        const int d = i >> 10, r = i & 1023;
        const float* cp = a.ssm_c + ((((size_t)(kk * 2 + d) * SSM_G + g) * SSM_H) * SSM_P + r) * 2;
        cc[i] = (f32x2){cp[0], cp[1]};
    }
    __syncthreads();
    {
        const int hc = tid & 3, hb = (tid >> 2) & 3, lag = (tid >> 4) & 15, d = tid >> 8;
        float acc[4][4];
#pragma unroll
        for (int i = 0; i < 4; ++i)
#pragma unroll
            for (int j = 0; j < 4; ++j) acc[i][j] = 0.f;
        for (int p = 0; p < 64; ++p) {
            const f32x2 ap = apow[(d * 64 + p) * 17 + lag];
            f32x2 ab[4], c[4];
#pragma unroll
            for (int j = 0; j < 4; ++j) { const f32x2 bb = bbar[(d * 64 + p) * 16 + 4 * hc + j]; ab[j] = (f32x2){ap.x * bb.x - ap.y * bb.y, ap.x * bb.y + ap.y * bb.x}; }
#pragma unroll
            for (int i = 0; i < 4; ++i) c[i] = cc[(d * 16 + 4 * hb + i) * 64 + p];
#pragma unroll
            for (int i = 0; i < 4; ++i)
#pragma unroll
                for (int j = 0; j < 4; ++j) acc[i][j] += c[i].x * ab[j].x - c[i].y * ab[j].y;
        }
#pragma unroll
        for (int i = 0; i < 4; ++i)
#pragma unroll
            for (int j = 0; j < 4; ++j) klag[((d * 16 + lag) * 16 + 4 * hb + i) * 16 + 4 * hc + j] = acc[i][j];
    }
    __syncthreads();
    f16* W1 = (f16*)(a.ws + WS_W1) + ((size_t)(kk * SSM_G + g) << 16);
    for (int e = tid; e < 65536; e += NTHR) {
        const int k = e & 255, np = e >> 8, h = k & 15, j = k >> 4, p = np & 63, ri = (np >> 6) & 1, d = np >> 7;
        const f32x2 ap = apow[(d * 64 + p) * 17 + (d == 0 ? 15 - j : j)], bb = bbar[(d * 64 + p) * 16 + h];
        const float zr = ap.x * bb.x - ap.y * bb.y, zi = ap.x * bb.y + ap.y * bb.x;
        W1[e] = (f16)(ri == 0 ? zr : zi);
    }
    f16* TW = (f16*)(a.ws + WS_TW) + ((size_t)(kk * SSM_G + g) << 17);
    const float* dw = a.ssm_d + kk * D + g * 16;
    for (int e = tid; e < 131072; e += NTHR) {
        const int k = e & 511, np = e >> 9, hp = np & 15, j = np >> 4;
        float v;
        if (k < 256) { const int h = k & 15, j2 = k >> 4;
            v = (j2 == j && h == hp) ? dw[h] : 0.f;
            if (j2 <= j) v += klag[((0 * 16 + (j - j2)) * 16 + hp) * 16 + h];
            if (j2 >= j) v += klag[((1 * 16 + (j2 - j)) * 16 + hp) * 16 + h];
        } else { const int k2 = k - 256, p = k2 & 63, ri = (k2 >> 6) & 1, d = k2 >> 7;
            const f32x2 c = cc[(d * 16 + hp) * 64 + p], ap = apow[(d * 64 + p) * 17 + (d == 0 ? j + 1 : 16 - j)];
            const float zr = c.x * ap.x - c.y * ap.y, zi = c.x * ap.y + c.y * ap.x;
            v = ri == 0 ? zr : -zi;
        }
        TW[e] = (f16)v;
    }
    __syncthreads();
}

__device__ __forceinline__ void p0a_phase(const Args& a, Frame& F) {
    __syncthreads();
    LAS float* sc = (LAS float*)F.lds;
    for (int i = F.tid; i < 3 * D; i += NTHR) { const int c = i >> 11, k = i & (D - 1); const float v = (c == 0) ? a.c_ctx[k] : a.c[(c - 1) * D + k]; sc[i] = v * sigmoid_f(v); }
    __syncthreads();
    for (int it = F.vcu; it < 2 * SSM_G; it += F.G) ssm_tables_item(a, it >> 7, it & 127, F.lds + 24576, F.tid);
    const int gw = F.vcu * NWAVES + F.wave, NGW = F.G * NWAVES;
    float* modp = (float*)(a.ws + WS_MODP);
    for (int it = gw; it < 4 * 16 * 72; it += NGW) {
        const int nc = it % 72, kc = (it / 72) & 15, l = it / 1152;
        const float* wp = a.w_ada + ((size_t)(l * D + kc * 128)) * (NMOD * D) + nc * 256 + F.lane * 4;
        f32x4 s0 = {0.f, 0.f, 0.f, 0.f}, s1 = s0, s2 = s0;
        for (int k8 = 0; k8 < 128; k8 += 8) {
            f32x4 w[8];
#pragma unroll
            for (int j = 0; j < 8; ++j) w[j] = __builtin_nontemporal_load((const f32x4*)(wp + (size_t)(k8 + j) * (NMOD * D)));
#pragma unroll
            for (int j = 0; j < 8; ++j) { const int k = kc * 128 + k8 + j; s0 += w[j] * sc[k]; s1 += w[j] * sc[D + k]; s2 += w[j] * sc[2 * D + k]; }
        }
        float* op = modp + ((size_t)(kc * 4 + l) * 3) * (NMOD * D) + nc * 256 + F.lane * 4;
        *(f32x4*)op = s0; *(f32x4*)(op + NMOD * D) = s1; *(f32x4*)(op + 2 * NMOD * D) = s2;
    }
    __syncthreads();
    {
        const int gt = F.vcu * NTHR + F.tid, NGT = F.G * NTHR;
        f16* cs4 = (f16*)(a.ws + WS_CS4096);
        for (int ch = gt; ch < 4096 * 512; ch += NGT) {
            const int k = ch >> 9, col0 = (ch & 511) * 8, cs = col0 >> 11, t0 = col0 & 2047; float v[8];
#pragma unroll
            for (int j = 0; j < 8; ++j) { const int mm = (k * (t0 + j)) & 4095; const float x = (float)mm * (1.0f / 2048.0f); v[j] = cs == 0 ? cospif(x) : -sinpif(x); }
            u32x4 o; o.x = pk2h(v[0], v[1]); o.y = pk2h(v[2], v[3]); o.z = pk2h(v[4], v[5]); o.w = pk2h(v[6], v[7]);
            *(u32x4*)(cs4 + (size_t)ch * 8) = o;
        }
        f16* cs2 = (f16*)(a.ws + WS_CS256);
        for (int ch = gt; ch < 256 * 64; ch += NGT) {
            const int k = ch >> 6, col0 = (ch & 63) * 8, cs = col0 >> 8, t0 = col0 & 255; float v[8];
#pragma unroll
            for (int j = 0; j < 8; ++j) { const int mm = (k * (t0 + j)) & 255; const float x = (float)mm * (1.0f / 128.0f); v[j] = cs == 0 ? cospif(x) : -sinpif(x); }
            u32x4 o; o.x = pk2h(v[0], v[1]); o.y = pk2h(v[2], v[3]); o.z = pk2h(v[4], v[5]); o.w = pk2h(v[6], v[7]);
            *(u32x4*)(cs2 + (size_t)ch * 8) = o;
        }
        f16* w2t = (f16*)(a.ws + WS_W2T);
        for (int ch = gt; ch < 512 * 32; ch += NGT) {
            const int row = ch >> 5, c0 = (ch & 31) * 8, cs = row >> 8, q = row & 255; float v[8];
#pragma unroll
            for (int j = 0; j < 8; ++j) { const int mm = (q * (c0 + j)) & 255; const float x = (float)mm * (1.0f / 128.0f); v[j] = cs == 0 ? cospif(x) : sinpif(x); }
            u32x4 o; o.x = pk2h(v[0], v[1]); o.y = pk2h(v[2], v[3]); o.z = pk2h(v[4], v[5]); o.w = pk2h(v[6], v[7]);
            *(u32x4*)(w2t + (size_t)ch * 8) = o;
        }
    }
    {
        LAS float* scr = (LAS float*)(F.lds + F.wave * 16384);
        constexpr int I_IN = (D / 64) * (2 * DFF / 32), I_OUT = (DFF / 64) * (D / 32), I_O = (D / 64) * (D / 32), I_GLU = (D / 64) * (2 * D / 32);
        constexpr int NITEMS = 8 * I_IN + 8 * I_OUT + 2 * I_O + 2 * I_GLU;
        int it = gw;
        if (it < NITEMS) {
            TItem cur = titem_decode(a, it); f32x4 v[8], w[8]; titem_load(v, cur, F.lane);
            for (;;) {
                const int nit = it + NGW; const bool has = nit < NITEMS; TItem nx = cur;
                if (has) { nx = titem_decode(a, nit); titem_load(w, nx, F.lane); }
                titem_store(v, cur, scr, F.lane);
                if (!has) break;
#pragma unroll
                for (int i = 0; i < 8; ++i) v[i] = w[i];
                cur = nx; it = nit;
            }
        }
    }
    {
        float* pe = (float*)(a.ws + WS_PE);
        for (int e = F.vcu * NTHR + F.tid; e < 64 * 512; e += F.G * NTHR) { const int pos = e >> 9, i = e & 511;
            const float fr = exp2f(-(float)i * (13.287712379549449f / 512.0f)); const float ar = (float)pos * fr;
            pe[e] = sinf(ar); pe[64 * 512 + e] = cosf(ar); }
    }
}

__device__ __forceinline__ void p0b_phase(const Args& a, Frame& F) {
    const float* modp = (const float*)(a.ws + WS_MODP); float* mod = (float*)(a.ws + WS_MOD);
    for (int i = F.vcu * NTHR + F.tid; i < 4 * 3 * NMOD * D; i += F.G * NTHR) {
        const int n = i % (NMOD * D), lc = i / (NMOD * D), l = lc / 3;
        float s = a.b_ada[l * (NMOD * D) + n];
#pragma unroll
        for (int kc = 0; kc < 16; ++kc) s += modp[((size_t)kc * 12 + lc) * (NMOD * D) + n];
        mod[i] = s;
        const int q = n / D;
        if (q % 3 == 1) { const int j = q / 3, col = n % D; ((float*)(a.ws + WS_GS))[((size_t)(l * 3 + j) * 3 + (lc % 3)) * D + col] = a.norm_g[(size_t)(l * 3 + j) * D + col] * (1.0f + s); }
    }
}

__device__ __forceinline__ void norm_load_row(const Args& a, Frame& F, int m, bool first, f32x4 (&v)[4][2]) {
    f16* xh = (f16*)(a.ws + WS_XH) + (size_t)m * D;
    if (first) {
        const float* xi = m < NPROMPT ? a.x_prompt + (size_t)m * D : a.x_sample + (size_t)(m - NPROMPT) * D;
        const int t = (m - NPROMPT) & (SEQ_S - 1); const float* pe = (const float*)(a.ws + WS_PE);
#pragma unroll
        for (int q = 0; q < 4; ++q) {
#pragma unroll
            for (int e = 0; e < 2; ++e) { const int c = q * 512 + F.lane * 8 + e * 4; f32x4 x = *(const f32x4*)(xi + c);
                if (m >= NPROMPT) x += *(const f32x4*)(pe + ((q & 1) * 64 + (q < 2 ? (t >> 6) : (t & 63))) * 512 + (c & 511));
                v[q][e] = x; }
            u32x4 w; w.x = pk2h(v[q][0][0], v[q][0][1]); w.y = pk2h(v[q][0][2], v[q][0][3]); w.z = pk2h(v[q][1][0], v[q][1][1]); w.w = pk2h(v[q][1][2], v[q][1][3]);
            *(u32x4*)(xh + q * 512 + F.lane * 8) = w; }
    } else {
#pragma unroll
        for (int q = 0; q < 4; ++q) { const f16x8 h = *(const f16x8*)(xh + q * 512 + F.lane * 8);
            v[q][0] = (f32x4){(float)h[0], (float)h[1], (float)h[2], (float)h[3]}; v[q][1] = (f32x4){(float)h[4], (float)h[5], (float)h[6], (float)h[7]}; }
    }
}
__device__ __forceinline__ float norm_rstd(Frame& F, const f32x4 (&v)[4][2]) {
    float ss = 0.f;
#pragma unroll
    for (int q = 0; q < 4; ++q)
#pragma unroll
        for (int e = 0; e < 2; ++e) { const f32x4 t = v[q][e] * v[q][e]; ss += (t[0] + t[1]) + (t[2] + t[3]); }
    return 1.0f / sqrtf(wave_sum(ss, F.lane) * (1.0f / D) + RMS_EPS);
}
__device__ __forceinline__ void norm_store_row(f16* dst, Frame& F, const f32x4 (&o)[4][2], bool bf = false) {
#pragma unroll
    for (int q = 0; q < 4; ++q) { u32x4 w; w.x = pk2x(o[q][0][0], o[q][0][1], bf); w.y = pk2x(o[q][0][2], o[q][0][3], bf); w.z = pk2x(o[q][1][0], o[q][1][1], bf); w.w = pk2x(o[q][1][2], o[q][1][3], bf);
        *(u32x4*)(dst + q * 512 + F.lane * 8) = w; }
}
__device__ __forceinline__ void norm_store_row_grp(f16* Hg, int m, Frame& F, const f32x4 (&o)[4][2]) {
#pragma unroll
    for (int q = 0; q < 4; ++q) { u32x4 w; w.x = pk2h(o[q][0][0], o[q][0][1]); w.y = pk2h(o[q][0][2], o[q][0][3]); w.z = pk2h(o[q][1][0], o[q][1][1]); w.w = pk2h(o[q][1][2], o[q][1][3]);
        *(u32x4*)(Hg + (size_t)(q * 32 + (F.lane >> 1)) * (MTOK * 16) + (size_t)m * 16 + (F.lane & 1) * 8) = w; }
}
__device__ __forceinline__ void norm_phase(const Args& a, Frame& F, int l, int j, bool first, bool fold, bool grp) {
    const int gw = F.vcu * NWAVES + F.wave; const int row0 = gw * 8;
    const int cond = cond_of_panel(row0 >> 8);
    const float* gp = a.norm_g + (size_t)(l * 3 + j) * D;
    const float* sh = (const float*)(a.ws + WS_MOD) + ((size_t)(l * 3 + cond) * NMOD + 3 * j) * D;
    const float* scl = sh + D;
    f32x4 gs[4][2], sv[4][2];
#pragma unroll
    for (int q = 0; q < 4; ++q)
#pragma unroll
        for (int e = 0; e < 2; ++e) { const int c = q * 512 + F.lane * 8 + e * 4; gs[q][e] = *(const f32x4*)(gp + c) * (*(const f32x4*)(scl + c) + 1.0f); sv[q][e] = *(const f32x4*)(sh + c); }
    f16* H = (f16*)(a.ws + WS_H);
    if (!(fold && row0 >= NPROMPT)) {
        const f16* xh0 = (const f16*)(a.ws + WS_XH) + (size_t)row0 * D + F.lane * 8;
        u32x4 nx[4];
        if (!first) {
#pragma unroll
            for (int q = 0; q < 4; ++q) nx[q] = *(const u32x4*)(xh0 + q * 512);
        }
        for (int r = 0; r < 8; ++r) {
            const int m = row0 + r;
            f32x4 v[4][2];
            if (first) norm_load_row(a, F, m, true, v);
            else {
#pragma unroll
                for (int q = 0; q < 4; ++q) { const f16x8 h = __builtin_bit_cast(f16x8, nx[q]);
                    v[q][0] = (f32x4){(float)h[0], (float)h[1], (float)h[2], (float)h[3]}; v[q][1] = (f32x4){(float)h[4], (float)h[5], (float)h[6], (float)h[7]}; }
                if (r < 7) {
#pragma unroll
                    for (int q = 0; q < 4; ++q) nx[q] = *(const u32x4*)(xh0 + (size_t)(r + 1) * D + q * 512);
                }
            }
            const float rstd = norm_rstd(F, v);
#pragma unroll
            for (int q = 0; q < 4; ++q)
#pragma unroll
                for (int e = 0; e < 2; ++e) v[q][e] = v[q][e] * rstd * gs[q][e] + sv[q][e];
            if (grp) norm_store_row_grp(H, m, F, v);
            else norm_store_row(H + (size_t)m * D, F, v, (FFN_BF16 != 0) && j != 1);
        }
    } else {
        f16* G2 = (f16*)(a.ws + WS_G);
        const int i = gw - NPROMPT / 8, b = i >> 9, t0 = (i & 511) * 4, rb = NPROMPT + SEQ_S * b;
        for (int r = 0; r < 4; ++r) {
            const int t = t0 + r, ma = rb + t, mb = rb + (t == 0 ? SEQ_S / 2 : SEQ_S - t);
            f32x4 va[4][2], vb[4][2]; norm_load_row(a, F, ma, false, va); norm_load_row(a, F, mb, false, vb);
            const float ra = norm_rstd(F, va), rbv = norm_rstd(F, vb);
#pragma unroll
            for (int q = 0; q < 4; ++q)
#pragma unroll
                for (int e = 0; e < 2; ++e) { va[q][e] = va[q][e] * ra * gs[q][e] + sv[q][e]; vb[q][e] = vb[q][e] * rbv * gs[q][e] + sv[q][e]; }
            if (t == 0) {
                norm_store_row(H + (size_t)ma * D, F, va); norm_store_row(H + (size_t)mb * D, F, vb);
#pragma unroll
                for (int q = 0; q < 4; ++q)
#pragma unroll
                    for (int e = 0; e < 2; ++e) vb[q][e] = (f32x4){0.f, 0.f, 0.f, 0.f};
                norm_store_row(G2 + (size_t)ma * D, F, vb);
            } else {
                f32x4 se[4][2], so[4][2];
#pragma unroll
                for (int q = 0; q < 4; ++q)
#pragma unroll
                    for (int e = 0; e < 2; ++e) { se[q][e] = va[q][e] + vb[q][e]; so[q][e] = va[q][e] - vb[q][e]; }
                norm_store_row(H + (size_t)ma * D, F, se); norm_store_row(G2 + (size_t)ma * D, F, so);
            }
        }
    }
    if (fold && gw < 64) {
        const int b = gw >> 5, m = NPROMPT + SEQ_S * b + SEQ_S / 2;
        const float* sh2 = (const float*)(a.ws + WS_MOD) + ((size_t)(l * 3 + 1 + b) * NMOD + 3 * j) * D; const float* scl2 = sh2 + D;
        f32x4 v[4][2]; norm_load_row(a, F, m, false, v);
        const float rstd = norm_rstd(F, v);
        LAS float* hl = (LAS float*)(F.lds + F.wave * 16384);
#pragma unroll
        for (int q = 0; q < 4; ++q)
#pragma unroll
            for (int e = 0; e < 2; ++e) { const int c = q * 512 + F.lane * 8 + e * 4;
                const f32x4 o = v[q][e] * rstd * (*(const f32x4*)(gp + c) * (*(const f32x4*)(scl2 + c) + 1.0f)) + *(const f32x4*)(sh2 + c);
                *(LAS f32x4*)(hl + c) = o; }
        LDS_WAIT(); asm volatile("" ::: "memory");
        const int o = (gw & 31) * 64 + F.lane, g = o >> 8, q = o & 255;
        float s = 0.f;
        for (int c = 0; c < 256; ++c) s += hl[256 * g + c] * __builtin_amdgcn_cosf((float)((q * c) & 255) * (1.0f / 256.0f));
        ((float*)(a.ws + WS_HCN))[(size_t)b * D + o] = s;
        LDS_WAIT(); asm volatile("" ::: "memory");
    }
}

__device__ __forceinline__ void final_phase(const Args& a, Frame& F) {
    const int gw = F.vcu * NWAVES + F.wave; const int row0 = gw * 8;
    f32x4 gs[4][2];
#pragma unroll
    for (int q = 0; q < 4; ++q)
#pragma unroll
        for (int e = 0; e < 2; ++e) gs[q][e] = *(const f32x4*)(a.final_g + q * 512 + F.lane * 8 + e * 4);
    for (int r = 0; r < 8; ++r) {
        const int m = row0 + r;
        f32x4 v[4][2]; norm_load_row(a, F, m, false, v);
        const float rstd = norm_rstd(F, v);
        float* xr = a.out + (size_t)m * D;
#pragma unroll
        for (int q = 0; q < 4; ++q)
#pragma unroll
            for (int e = 0; e < 2; ++e) *(f32x4*)(xr + q * 512 + F.lane * 8 + e * 4) = v[q][e] * rstd * gs[q][e];
    }
}

__device__ __forceinline__ void scan_phase(const Args& a, Frame& F, int kk) {
    const int gw = F.vcu * NWAVES + F.wave, NGW = F.G * NWAVES;
    const f16* S = (const f16*)(a.ws + WS_S); f16* CC = (f16*)(a.ws + WS_CC);
    const f32x2* AL = (const f32x2*)(a.ws + WS_AL);
    float* ns = a.out + (size_t)MTOK * D;
    const int p = F.lane, w = F.wave;
    LAS f32x2* Lx = (LAS f32x2*)F.lds;
    for (int item = F.vcu; item < 2 * SSM_G; item += F.G) {
        const int sq = item >> 7, g = item & 127, c0 = 512 + 256 * sq;
        const size_t gb = (size_t)g * 1024 * 256;
#pragma unroll
        for (int d = 0; d < 2; ++d) {
            const f32x2 al = AL[((size_t)(kk * 2 + d) * SSM_G + g) * SSM_P + p];
            float cr = 0.f, ci = 0.f;
            for (int s8 = 0; s8 < 32; s8 += 16) {
                f16 sr[16], si[16];
#pragma unroll
                for (int j = 0; j < 16; ++j) { const int i = 32 * w + s8 + j, c = d == 0 ? c0 + i : c0 + 255 - i; const f16* q = S + gb + (size_t)c * 256 + d * 128 + p; sr[j] = q[0]; si[j] = q[64]; }
#pragma unroll
                for (int j = 0; j < 16; ++j) { const float nr = al.x * cr - al.y * ci + (float)sr[j], ni = al.x * ci + al.y * cr + (float)si[j]; cr = nr; ci = ni; }
            }
            Lx[(d * 8 + w) * 64 + p] = (f32x2){cr, ci};
        }
        __syncthreads();
#pragma unroll
        for (int d = 0; d < 2; ++d) {
            const f32x2 al = AL[((size_t)(kk * 2 + d) * SSM_G + g) * SSM_P + p];
            f32x2 a32 = al;
#pragma unroll
            for (int k = 0; k < 5; ++k) a32 = (f32x2){a32.x * a32.x - a32.y * a32.y, 2.f * a32.x * a32.y};
            const float* sp = a.state_ssm + (((((size_t)sq * 2 + kk) * 2 + d) * SSM_G + g) * SSM_P + p) * 2;
            float cr = sp[0], ci = sp[1];
            for (int v = 0; v < w; ++v) { const f32x2 L = Lx[(d * 8 + v) * 64 + p]; const float nr = a32.x * cr - a32.y * ci + L.x, ni = a32.x * ci + a32.y * cr + L.y; cr = nr; ci = ni; }
            for (int s8 = 0; s8 < 32; s8 += 16) {
                f16 sr[16], si[16];
#pragma unroll
                for (int j = 0; j < 16; ++j) { const int i = 32 * w + s8 + j, c = d == 0 ? c0 + i : c0 + 255 - i; const f16* q = S + gb + (size_t)c * 256 + d * 128 + p; sr[j] = q[0]; si[j] = q[64]; }
#pragma unroll
                for (int j = 0; j < 16; ++j) { const int i = 32 * w + s8 + j, c = d == 0 ? c0 + i : c0 + 255 - i;
                    f16* o = CC + gb + (size_t)c * 256 + d * 128 + p; o[0] = (f16)cr; o[64] = (f16)ci;
                    const float nr = al.x * cr - al.y * ci + (float)sr[j], ni = al.x * ci + al.y * cr + (float)si[j]; cr = nr; ci = ni; }
            }
        }
        __syncthreads();
    }
    for (int it = gw; it < NB_P * SSM_G * 2; it += NGW) {
        const int sq = it >> 8, g = (it >> 1) & 127, d = it & 1, c0 = sq * 16;
        const size_t gb = (size_t)g * 1024 * 256;
        const f32x2 al = AL[((size_t)(kk * 2 + d) * SSM_G + g) * SSM_P + p];
        float cr = 0.f, ci = 0.f;
        f16 sr[16], si[16];
#pragma unroll
        for (int j = 0; j < 16; ++j) { const int c = d == 0 ? c0 + j : c0 + 15 - j; const f16* q = S + gb + (size_t)c * 256 + d * 128 + p; sr[j] = q[0]; si[j] = q[64]; }
#pragma unroll
        for (int j = 0; j < 16; ++j) { const int c = d == 0 ? c0 + j : c0 + 15 - j;
            f16* o = CC + gb + (size_t)c * 256 + d * 128 + p; o[0] = (f16)cr; o[64] = (f16)ci;
            const float nr = al.x * cr - al.y * ci + (float)sr[j], ni = al.x * ci + al.y * cr + (float)si[j]; cr = nr; ci = ni; }
        float* o = ns + (((((size_t)sq * 2 + kk) * 2 + d) * SSM_G + g) * SSM_P + p) * 2; *(f32x2*)o = (f32x2){cr, ci};
    }
}

constexpr int N_PHASES = 37;
#ifndef MK_PER_PHASE
#define MK_PER_PHASE 0
#endif

#ifndef EN_MASK
#define EN_MASK 0xFFFF
#endif
#ifndef PROBE
#define PROBE 0
#endif
#ifndef PROBE_SEL
#define PROBE_SEL 31
#endif
#if PROBE
#define EN(bit) pkind_ = (bit); if constexpr (((EN_MASK) >> (bit)) & 1)
#else
#define EN(bit) if constexpr (((EN_MASK) >> (bit)) & 1)
#endif
#ifndef G_SP2
#define G_SP2 true
#endif
#ifndef G_ALIGN
#define G_ALIGN true
#endif
#ifndef REP_MASK
#define REP_MASK 0
#endif
#define REPCNT(bit) ((((REP_MASK) >> (bit)) & 1) ? 2 : 1)
#define REP(bit) for (int rep_ = 0; rep_ < REPCNT(bit); ++rep_)
typedef pg8::Prob<false> ProbStd;
typedef pg8::Prob<true> ProbGrp;

__device__ __forceinline__ ProbStd make_std(const void* A, unsigned lda2, size_t a_t, size_t a_z, const void* B, unsigned ldb2, size_t b_t, size_t b_z, int nt) {
    ProbStd p; p.A = (const char*)A; p.A2 = (const char*)A; p.B = (const char*)B; p.nt = nt; p.ksplit = nt; p.lda2 = lda2; p.ldb2 = ldb2; p.a_t = a_t; p.a_z = a_z; p.b_t = b_t; p.b_z = b_z; p.a_k = 128u; p.b_k = 128u; return p;
}

struct ArgsK {
    const GAS float* x_prompt; const GAS float* x_sample; const GAS float* state_ssm; const GAS float* c; const GAS float* c_ctx;
    const GAS float* w_ada; const GAS float* b_ada; const GAS float* norm_g; const GAS float* ffn_w_in; const GAS float* ffn_w_out;
    const GAS float* fourier_w_o; const GAS float* ssm_a_re; const GAS float* ssm_a_im; const GAS float* ssm_log_dt;
    const GAS float* ssm_b; const GAS float* ssm_c; const GAS float* ssm_d; const GAS float* ssm_w_glu; const GAS float* final_g;
    GAS float* out; GAS unsigned char* ws; int ph_lo, ph_hi;
};
static_assert(sizeof(ArgsK) == sizeof(Args), "ArgsK mirrors Args");
__device__ __forceinline__ Args kargs() {
    const __attribute__((address_space(4))) ArgsK* p = (const __attribute__((address_space(4))) ArgsK*)__builtin_amdgcn_kernarg_segment_ptr(); asm volatile("" : "+s"(p));
    Args a;
    a.x_prompt = (const float*)p->x_prompt; a.x_sample = (const float*)p->x_sample; a.state_ssm = (const float*)p->state_ssm; a.c = (const float*)p->c; a.c_ctx = (const float*)p->c_ctx;
    a.w_ada = (const float*)p->w_ada; a.b_ada = (const float*)p->b_ada; a.norm_g = (const float*)p->norm_g; a.ffn_w_in = (const float*)p->ffn_w_in; a.ffn_w_out = (const float*)p->ffn_w_out;
    a.fourier_w_o = (const float*)p->fourier_w_o; a.ssm_a_re = (const float*)p->ssm_a_re; a.ssm_a_im = (const float*)p->ssm_a_im; a.ssm_log_dt = (const float*)p->ssm_log_dt;
    a.ssm_b = (const float*)p->ssm_b; a.ssm_c = (const float*)p->ssm_c; a.ssm_d = (const float*)p->ssm_d; a.ssm_w_glu = (const float*)p->ssm_w_glu; a.final_g = (const float*)p->final_g;
    a.out = (float*)p->out; a.ws = (unsigned char*)p->ws; a.ph_lo = p->ph_lo; a.ph_hi = p->ph_hi;
    return a;
}

__device__ __forceinline__ void set_b_tm(ProbStd& p, int nkt) { p.ldb2 = 128u; p.b_k = 32768u; p.b_t = (size_t)nkt * 32768; }
__device__ __forceinline__ void set_a_tm(ProbStd& p, int nkt) { p.lda2 = 128u; p.a_k = 32768u; p.a_t = (size_t)nkt * 32768; }

__global__ void __launch_bounds__(NTHR, 2) fwd_kernel(ArgsK a_unused) {
    extern __shared__ __attribute__((aligned(16))) unsigned char lds_raw[];
    Frame F0;
    F0.lds = (LAS unsigned char*)lds_raw;
    F0.tid = threadIdx.x; F0.lane = F0.tid & 63; F0.wave = __builtin_amdgcn_readfirstlane(F0.tid >> 6);
    F0.G = gridDim.x; F0.bx = blockIdx.x; { const int bx = blockIdx.x; F0.vcu = (F0.G % 8 == 0) ? (bx % 8) * (F0.G / 8) + bx / 8 : bx; }
    volatile LAS unsigned* MISC = (volatile LAS unsigned*)(F0.lds + MISC_OFF);
    if (F0.tid < 64) MISC[F0.tid] = 0u;
    __syncthreads();
    unsigned bar_x; int lo, hi;
    { const Args a = kargs(); unsigned* ctl = (unsigned*)(a.ws + WS_CTL); const XcdBarrier b0 = xcd_barrier_post(ctl + CW_BAR, MISC + 8); bar_x = b0.x; lo = a.ph_lo; hi = a.ph_hi; }
#define GRID_BAR() do { const Args ab = kargs(); XcdBarrier bb; bb.bar = (unsigned*)(ab.ws + WS_CTL) + CW_BAR; unsigned bx_ = bar_x; asm volatile("" : "+s"(bx_)); bb.x = bx_; bb.st = MISC + 8; xcd_barrier(bb); } while (0)
    int ph = 0;
#define PH_BEGIN if (ph >= lo && ph < hi) { const Args a = kargs(); unsigned char* ws = a.ws; \
    Frame F = F0; asm volatile("" : "+s"(F.vcu), "+s"(F.wave), "+s"(F.G), "+s"(F.bx)); asm volatile("" : "+v"(F.tid)); F.lane = F.tid & 63;   \
    f16* H = (f16*)(ws + WS_H); f16* ACT = (f16*)(ws + WS_ACT); f16* HT = (f16*)(ws + WS_HT); f16* Fm = (f16*)(ws + WS_F); \
    f16* Sm = (f16*)(ws + WS_S); f16* CC = (f16*)(ws + WS_CC); f16* Gm = (f16*)(ws + WS_G); \
    const float* modl = (const float*)(ws + WS_MOD) + (size_t)l * 3 * NMOD * D; \
    (void)H; (void)ACT; (void)HT; (void)Fm; (void)Sm; (void)CC; (void)Gm; (void)modl; PROBE_T0
#if PROBE
#define PROBE_T0 unsigned long long pt0_ = __builtin_amdgcn_s_memrealtime(); int pkind_ = 0; (void)pkind_;
#define PROBE_T1 { const unsigned long long pt1_ = __builtin_amdgcn_s_memrealtime(); if (threadIdx.x == 0) atomicAdd((unsigned long long*)(ws + WS_CTL + 262144) + pkind_, pt1_ - pt0_); pt0_ = pt1_; }
#define PROBE_T2 { const unsigned long long pt2_ = __builtin_amdgcn_s_memrealtime(); if (threadIdx.x == 0) { atomicAdd((unsigned long long*)(ws + WS_CTL + 262144) + 31, pt2_ - pt0_); atomicAdd((unsigned long long*)(ws + WS_CTL + 262144) + 16 + pkind_, pt2_ - pt0_); } }
#else
#define PROBE_T0
#define PROBE_T1
#define PROBE_T2
#endif
#define PH_END   PROBE_T1 if (ph + 1 < hi) { GRID_BAR(); PROBE_T2 } } ++ph;

    { const int l = 0;
    PH_BEGIN EN(0) REP(0) p0a_phase(a, F); PH_END
    PH_BEGIN EN(1) REP(1) p0b_phase(a, F); PH_END
    }
    for (int l = 0; l < DEPTH; ++l) {
        for (int s = 0; s < 2; ++s) {
            if ((s == 0 && l == 0) || (s == 1 && (l & 1) != 0)) {
            PH_BEGIN EN(2) REP(2) norm_phase(a, F, l, 2 * s, l == 0 && s == 0, false, false); PH_END
            }
            PH_BEGIN EN(3) REP(3) {
                const f16* Wt = (const f16*)(ws + WS_WIN) + (size_t)(l * 2 + s) * D * 2 * DFF;
                ProbStd p = make_std(H, D * 2, (size_t)256 * D * 2, 0, Wt, D * 2, (size_t)256 * D * 2, 0, D / 64); set_b_tm(p, D / 64);
                pg8::StaticOrder S; S.init(MTOK, 2 * DFF, F.G, F.bx);
                EpiSwiGLU E{ACT};
                pg8::gemm_phase<ProbStd, EpiSwiGLU, pg8::StaticOrder, G_ALIGN, G_SP2>(F.lds, p, S, E);
            } PH_END
            PH_BEGIN EN(4) REP(4) {
                const f16* Wt = (const f16*)(ws + WS_WOUT) + (size_t)(l * 2 + s) * DFF * D;
                ProbStd p = make_std(ACT, DFF * 2, (size_t)256 * DFF * 2, 0, Wt, DFF * 2, (size_t)256 * DFF * 2, 0, DFF / 64); set_a_tm(p, DFF / 64); set_b_tm(p, DFF / 64);
                pg8::StaticOrder S; S.init(MTOK, D, F.G, F.bx);
                constexpr bool BF = (FFN_BF16 != 0);
                LAS unsigned char* lt = F.lds + MISC_OFF + 1024;
                const float* gate = modl + (size_t)(2 + 6 * s) * D;
                if (s == 1 && l + 1 < DEPTH) { typedef EpiResidNormT<BF, 0, 1, 2> EN0;
                    fused_norm_vectors(ws, nullptr, lt, S, l + 1, 0, false, F.tid); EN0 E{ws, a.out, gate, nullptr, l * 3 + 2, l + 1, 0, lt}; pg8::gemm_phase<ProbStd, EN0, pg8::StaticOrder, true, G_SP2>(F.lds, p, S, E); }
                else if (s == 1) { typedef EpiResidNormT<BF, 2, 1, 2> EN2;
                    fused_norm_vectors(ws, a.final_g, lt, S, 0, 0, true, F.tid); EN2 E{ws, a.out, gate, a.final_g, l * 3 + 2, 0, 0, lt}; pg8::gemm_phase<ProbStd, EN2, pg8::StaticOrder, true, G_SP2>(F.lds, p, S, E); }
                else if (l & 1) { typedef EpiResidNormT<BF, 1, 1, 2> EN1;
                    fused_norm_vectors(ws, nullptr, lt, S, l, 1, false, F.tid); EN1 E{ws, a.out, gate, nullptr, l * 3 + 0, l, 1, lt}; pg8::gemm_phase<ProbStd, EN1, pg8::StaticOrder, true, G_SP2>(F.lds, p, S, E); }
                else { EpiResidT<BF> E{(f16*)(ws + WS_XH), gate, 0.5f};
                    pg8::gemm_phase<ProbStd, EpiResidT<BF>, pg8::StaticOrder, G_ALIGN, G_SP2>(F.lds, p, S, E); }
            } PH_END
            if (s == 0) {
                if ((l & 1) == 0) {
                PH_BEGIN EN(2) REP(2) norm_phase(a, F, l, 1, false, true, false); PH_END
                }
                const int kk = l >> 1;
                if ((l & 1) == 0) {
                    PH_BEGIN EN(5) REP(5) {
                        pg8::ProbFA p; (ProbStd&)p = make_std(ws + WS_W2T, 512, (size_t)256 * 512, 0, H, D * 2, (size_t)256 * D * 2, 512, 4);
                        p.b_m = (size_t)((const char*)Gm - (const char*)H);
                        SchedFA S{F.vcu}; EpiFA E{HT};
                        pg8::gemm_phase<pg8::ProbFA, EpiFA, SchedFA, true, true>(F.lds, p, S, E);
                    } PH_END
                    PH_BEGIN EN(6) REP(6) {
                        {
                            ProbStd p = make_std(ws + WS_CS4096, 8192, (size_t)256 * 8192, 0, HT + (size_t)NB_P * D * 2 * SEQ_P, 8192, (size_t)256 * 8192, (size_t)D * 8192, 64);
                            SchedFBs S{F.vcu}; EpiFB E{Fm, NPROMPT, SEQ_S, 1.0f / 1024.0f, (const float*)(ws + WS_HCN)};
                            pg8::gemm_phase<ProbStd, EpiFB, SchedFBs, false, true>(F.lds, p, S, E);
                        }
                        {
                            ProbStd p = make_std(ws + WS_CS256, 1024, (size_t)256 * 1024, 0, HT, 1024, (size_t)256 * 1024, (size_t)D * 1024, 8);
                            SchedFBp S{F.vcu}; EpiFB E{Fm, 0, SEQ_P, 1.0f / 256.0f, nullptr};
                            pg8::gemm_phase<ProbStd, EpiFB, SchedFBp, false, true>(F.lds, p, S, E);
                        }
                    } PH_END
                    PH_BEGIN EN(7) REP(7) {
                        const f16* Wt = (const f16*)(ws + WS_WO) + (size_t)kk * D * D;
                        ProbStd p = make_std(Fm, D * 2, (size_t)256 * D * 2, 0, Wt, D * 2, (size_t)256 * D * 2, 0, D / 64); set_b_tm(p, D / 64);
                        pg8::StaticOrder S; S.init(MTOK, D, F.G, F.bx);
                        typedef EpiResidNormT<(FFN_BF16 != 0), 0, 1, 1> ENC;
                        fused_norm_vectors(ws, nullptr, F.lds + MISC_OFF + 1024, S, l, 2, false, F.tid);
                        ENC E{ws, a.out, modl + (size_t)5 * D, nullptr, l * 3 + 1, l, 2, F.lds + MISC_OFF + 1024};
                        pg8::gemm_phase<ProbStd, ENC, pg8::StaticOrder, true, G_SP2>(F.lds, p, S, E);
                    } PH_END
                } else {
                    PH_BEGIN EN(8) REP(8) {
                        ProbStd p = make_std(H, 512, (size_t)256 * 512, pg8::PLANE_B, ws + WS_W1 + (size_t)kk * SSM_G * 256 * 512, 512, 0, (size_t)256 * 512, 4);
                        SchedS S{F.vcu}; EpiS1 E{Sm};
                        pg8::gemm_phase<ProbStd, EpiS1, SchedS, true, true>(F.lds, p, S, E);
                    } PH_END
                    PH_BEGIN EN(9) REP(9) scan_phase(a, F, kk); PH_END
                    PH_BEGIN EN(10) REP(10) {
                        ProbStd p = make_std(H, 512, (size_t)256 * 512, pg8::PLANE_B, ws + WS_TW + (size_t)kk * SSM_G * 256 * 1024, 1024, 0, (size_t)256 * 1024, 8);
                        p.A2 = (const char*)CC; p.ksplit = 4;
                        SchedS S{F.vcu}; EpiS3 E{Gm};
                        pg8::gemm_phase<ProbStd, EpiS3, SchedS, true, true>(F.lds, p, S, E);
                    } PH_END
                    PH_BEGIN EN(11) REP(11) {
                        const f16* Wt = (const f16*)(ws + WS_WGLU) + (size_t)kk * D * 2 * D;
                        ProbGrp p; { const ProbStd q = make_std(Gm, 32, (size_t)256 * 32, 0, Wt, D * 2, (size_t)256 * D * 2, 0, D / 64); p.A = q.A; p.A2 = q.A2; p.B = q.B; p.nt = q.nt; p.ksplit = q.ksplit; p.lda2 = q.lda2; p.a_t = q.a_t; p.a_z = 0; p.b_z = 0; }
                        p.a_k = 4u * pg8::PLANE_B; p.ldb2 = 128u; p.b_k = 32768u; p.b_t = (size_t)(D / 64) * 32768;
                        pg8::StaticOrder S; S.init(MTOK, 2 * D, F.G, F.bx);
                        EpiGLUResid E{(f16*)(ws + WS_XH), modl + (size_t)5 * D, 1.0f / REPCNT(11)};
                        pg8::gemm_phase<ProbGrp, EpiGLUResid, pg8::StaticOrder, G_ALIGN, G_SP2>(F.lds, p, S, E);
                    } PH_END
                }
            }
        }
    }
#if PROBE
    {
        GRID_BAR();
        if (blockIdx.x == 0) {
            if (threadIdx.x == 0) { const Args ap = kargs(); const unsigned long long v = __hip_atomic_load((unsigned long long*)(ap.ws + WS_CTL + 262144) + PROBE_SEL, __ATOMIC_RELAXED, __HIP_MEMORY_SCOPE_AGENT) / gridDim.x;
                const unsigned long long t0 = __builtin_amdgcn_s_memrealtime(); while (__builtin_amdgcn_s_memrealtime() - t0 < v) __builtin_amdgcn_s_sleep(8); }
            __syncthreads();
        }
    }
#endif
#undef PH_BEGIN
#undef PH_END
}

extern "C" void kernel_launch(void* const* d_in, const int* in_sizes, int n_in, void* d_out, int out_size, void* d_ws, size_t ws_size, hipStream_t stream) {
    static int grid = 0;
    if (grid == 0) {
        if (n_in != 19 || ws_size < WS_END) { fprintf(stderr, "kernel_launch: unexpected n_in %d or ws_size %zu (need %zu)\n", n_in, ws_size, (size_t)WS_END); grid = -1; return; }
        int dev = 0, cus = 0, per_cu = 0;
        if (hipGetDevice(&dev) != hipSuccess || hipDeviceGetAttribute(&cus, hipDeviceAttributeMultiprocessorCount, dev) != hipSuccess) { grid = -1; return; }
        if (hipFuncSetAttribute((const void*)fwd_kernel, hipFuncAttributeMaxDynamicSharedMemorySize, LDS_BYTES) != hipSuccess) { fprintf(stderr, "kernel_launch: hipFuncSetAttribute failed\n"); grid = -1; return; }
        if (hipOccupancyMaxActiveBlocksPerMultiprocessor(&per_cu, (const void*)fwd_kernel, NTHR, LDS_BYTES) != hipSuccess || per_cu < 1) fprintf(stderr, "kernel_launch: occupancy query reports %d\n", per_cu);
        (void)hipGetLastError();
        grid = cus < 256 ? cus : 256;
    }
    if (grid < 0) return;
    (void)hipMemsetAsync((char*)d_ws + WS_CTL, 0, CTL_ZERO_BYTES, stream);
    ArgsK a{};
    a.x_prompt = (const GAS float*)d_in[0]; a.x_sample = (const GAS float*)d_in[1]; a.state_ssm = (const GAS float*)d_in[2]; a.c = (const GAS float*)d_in[3]; a.c_ctx = (const GAS float*)d_in[4];
    a.w_ada = (const GAS float*)d_in[5]; a.b_ada = (const GAS float*)d_in[6]; a.norm_g = (const GAS float*)d_in[7]; a.ffn_w_in = (const GAS float*)d_in[8]; a.ffn_w_out = (const GAS float*)d_in[9];
    a.fourier_w_o = (const GAS float*)d_in[10]; a.ssm_a_re = (const GAS float*)d_in[11]; a.ssm_a_im = (const GAS float*)d_in[12]; a.ssm_log_dt = (const GAS float*)d_in[13];
    a.ssm_b = (const GAS float*)d_in[14]; a.ssm_c = (const GAS float*)d_in[15]; a.ssm_d = (const GAS float*)d_in[16]; a.ssm_w_glu = (const GAS float*)d_in[17]; a.final_g = (const GAS float*)d_in[18];
    a.out = (GAS float*)d_out; a.ws = (GAS unsigned char*)d_ws;
#if MK_PER_PHASE
    for (int i = 0; i < N_PHASES; ++i) { a.ph_lo = i; a.ph_hi = i + 1; hipLaunchKernelGGL(fwd_kernel, dim3(grid), dim3(NTHR), LDS_BYTES, stream, a); }
#else
    a.ph_lo = 0; a.ph_hi = N_PHASES;
    hipLaunchKernelGGL(fwd_kernel, dim3(grid), dim3(NTHR), LDS_BYTES, stream, a);
#endif
    const hipError_t le = hipPeekAtLastError();
    if (le != hipSuccess) fprintf(stderr, "kernel_launch: launch failed: %s\n", hipGetErrorName(le));
}
```

```cpp
#include <hip/hip_runtime.h>
#include <cstdio>
#include <cstdint>

#define LAS __attribute__((address_space(3)))
#define GAS __attribute__((address_space(1)))
typedef _Float16 f16;
typedef _Float16 f16x8 __attribute__((ext_vector_type(8)));
typedef _Float16 f16x4 __attribute__((ext_vector_type(4)));
typedef _Float16 f16x2 __attribute__((ext_vector_type(2)));
typedef float f32x4 __attribute__((ext_vector_type(4)));
typedef float f32x2 __attribute__((ext_vector_type(2)));
typedef short s16x8 __attribute__((ext_vector_type(8)));
typedef __bf16 bf16x2_t __attribute__((ext_vector_type(2)));
typedef unsigned u32x4 __attribute__((ext_vector_type(4)));
typedef unsigned u32x2 __attribute__((ext_vector_type(2)));

constexpr int D = 2048, DFF = 5632, MTOK = 16384, NPROMPT = 8192, SEQ_P = 256, SEQ_S = 4096, NB_P = 32, NB_S = 2;
constexpr int DEPTH = 4, NMOD = 9, SSM_G = 128, SSM_P = 64, SSM_H = 16;
constexpr float RMS_EPS = 1e-6f;
constexpr int NWAVES = 8, NTHR = 512;

constexpr size_t MiB = 1u << 20;
constexpr size_t WS_CTL = 0, CTL_ZERO_BYTES = 1 * MiB;
constexpr size_t WS_MOD = 1 * MiB;
constexpr size_t WS_MODP = 2 * MiB;
constexpr size_t WS_AL = 18 * MiB;
constexpr size_t WS_W2T = 19 * MiB;
constexpr size_t WS_CS256 = 19 * MiB + 512 * 1024;
constexpr size_t WS_PE = 19 * MiB + 768 * 1024;
constexpr size_t WS_HCN = 18 * MiB + 512 * 1024;
constexpr size_t WS_CS4096 = 20 * MiB;
constexpr size_t WS_W1 = 84 * MiB;
constexpr size_t WS_TW = 116 * MiB;
constexpr size_t WS_WO = 180 * MiB;
constexpr size_t WS_WGLU = 196 * MiB;
constexpr size_t WS_WIN = 228 * MiB;
constexpr size_t WS_WOUT = 580 * MiB;
constexpr size_t WS_H = 756 * MiB;
constexpr size_t WS_ACT = 820 * MiB;
constexpr size_t WS_HT = 820 * MiB;
constexpr size_t WS_F = 948 * MiB;
constexpr size_t WS_S = 820 * MiB;
constexpr size_t WS_CC = 948 * MiB;
constexpr size_t WS_G = 1012 * MiB;
constexpr size_t WS_XH = 1076 * MiB;
constexpr size_t WS_END = 1140 * MiB;
constexpr int CW_BAR = 4096;

constexpr int STAGE_BYTES = 131072;
constexpr int MISC_OFF = STAGE_BYTES;
constexpr int LDS_BYTES = 147456;

namespace pg8 {
constexpr int BM = 256, BK = 64, HALF = 128, HTB = HALF * BK * 2, NXCD = 8, WGM = 4;
__host__ __device__ __forceinline__ int lds_byte(int r, int c) { const int st = (r >> 4) * 2 + (c >> 5), rr = r & 15, cc = c & 31, ob = rr * 64 + cc * 2; return st * 1024 + (ob ^ (((ob >> 9) & 1) << 5)); }
__host__ __device__ __forceinline__ void stage_rc(int b, int& R, int& C) { const int st = b / 1024, sb = b % 1024, swz = sb ^ (((sb >> 9) & 1) << 5); R = (st >> 1) * 16 + swz / 64; C = (st & 1) * 32 + (swz % 64) / 2; }
__host__ __device__ __forceinline__ int perm32(int rho) { const int n = rho >> 4, i = rho & 15; return 8 * (i >> 2) + 4 * n + (i & 3); }

struct Unit { int pm, pn, z; };

constexpr unsigned PLANE_B = 16384u * 32u;
template <bool GRP> struct Prob {
    const char* A; const char* A2; const char* B; int nt, ksplit; unsigned lda2, ldb2; size_t a_t, a_z, b_t, b_z; unsigned a_k, b_k;
    __device__ __forceinline__ const char* a_ptr(const Unit& u, int t) const { const char* p = (t < ksplit) ? A + (size_t)t * a_k : A2 + (size_t)(t - ksplit) * a_k; return p + (size_t)u.pm * a_t + (size_t)u.z * a_z; }
    __device__ __forceinline__ const char* b_ptr(const Unit& u, int t) const { return B + (size_t)t * b_k + (size_t)u.pn * b_t + (size_t)u.z * b_z; }
    __device__ __forceinline__ unsigned a_off(int R, int C) const { return GRP ? (unsigned)R * lda2 + (unsigned)(C >> 4) * PLANE_B + (unsigned)(C & 15) * 2u : (unsigned)R * lda2 + (unsigned)C * 2u; }
    __device__ __forceinline__ unsigned b_off(int R, int C) const { return (unsigned)R * ldb2 + (unsigned)C * 2u; }
};

struct ProbFA : Prob<false> {
    size_t b_m;
    __device__ __forceinline__ const char* b_ptr(const Unit& u, int t) const { return B + (size_t)t * b_k + (size_t)u.pn * b_t + (size_t)u.z * b_z + ((u.pn >= 32 && u.pm == 1) ? b_m : (size_t)0); }
};

struct StaticOrder {
    int nM, nN, nwg, G, c;
    __device__ void init(int M, int N, int G_, int c_) { nM = M / BM; nN = N / BM; nwg = nM * nN; G = G_; c = c_; }
    __device__ bool next(int i, Unit& u) const {
        const long L = (long)i * G + c; if (L >= nwg) return false;
        int wgid = (int)L; { const int q = nwg / NXCD, r = nwg % NXCD, xcd = wgid % NXCD, off = wgid / NXCD; wgid = (xcd < r ? xcd * (q + 1) : r * (q + 1) + (xcd - r) * q) + off; }
        const int nig = WGM * nN, gid = wgid / nig, fm = gid * WGM, gsz = (nM - fm) < WGM ? (nM - fm) : WGM;
        u.pm = fm + ((wgid % nig) % gsz); u.pn = (wgid % nig) / gsz; u.z = 0; return true;
    }
};

template <class P, class Epi, class Sched, bool ALIGN_EPI, bool SP2>
__device__ __forceinline__ void gemm_phase(LAS unsigned char* lds, const P& p, const Sched& S, const Epi& E) {
    int tid_ = threadIdx.x; asm volatile("" : "+v"(tid_));
    const int tid = tid_, wid = __builtin_amdgcn_readfirstlane(tid >> 6), lane = tid & 63, wr = wid >> 2, wc = wid & 3, fr = lane & 15, fq = lane >> 4;
    int nt = p.nt; asm volatile("" : "+s"(nt));
    unsigned voffA[2], voffB[2];
#pragma unroll
    for (int i = 0; i < 2; ++i) { int R, C; stage_rc(tid * 16 + i * 8192, R, C); const int Rb = Epi::PERM ? ((R & ~31) + perm32(R & 31)) : R;
        voffA[i] = p.a_off(R, C); voffB[i] = p.b_off(Rb, C); }
    const size_t ahs = (size_t)HALF * p.lda2, bhs = (size_t)HALF * p.ldb2;
    const unsigned ldsw = (unsigned)wid * 1024u;
    const int aoff = lds_byte(wr * 64 + fr, fq * 8), boff = lds_byte(wc * 32 + fr, fq * 8);
#define PG8_SA(b, h) (((b) * 2 + (h)) * HTB)
#define PG8_SB(b, h) ((4 + (b) * 2 + (h)) * HTB)
    const unsigned ldsb = (unsigned)(size_t)lds + ldsw;
#define PG8_STAGE(bufoff, gbase, voff) do { _Pragma("unroll") for (int _i = 0; _i < 2; ++_i) { const unsigned m0v_ = ldsb + (unsigned)((bufoff) + _i * 8192); \
        asm volatile("s_mov_b32 m0, %0\n\ts_nop 0\n\tglobal_load_lds_dwordx4 %1, %2" :: "s"(m0v_), "v"((voff)[_i]), "s"((const char*)(gbase)) : "memory", "m0"); } } while (0)
#define PG8_LDA(dst, b, h) do { _Pragma("unroll") for (int m = 0; m < 4; ++m) _Pragma("unroll") for (int k = 0; k < 2; ++k) dst[m][k] = *(const LAS f16x8*)(lds + PG8_SA(b, h) + aoff + m * 2048 + k * 1024); } while (0)
#define PG8_LDB(dst, b, h) do { _Pragma("unroll") for (int n = 0; n < 2; ++n) _Pragma("unroll") for (int k = 0; k < 2; ++k) dst[n][k] = *(const LAS f16x8*)(lds + PG8_SB(b, h) + boff + n * 2048 + k * 1024); } while (0)
#define PG8_MMA(ai, bj, At, Bt) do { __builtin_amdgcn_s_setprio(1); _Pragma("unroll") for (int m = 0; m < 4; ++m) _Pragma("unroll") for (int n = 0; n < 2; ++n) _Pragma("unroll") for (int k = 0; k < 2; ++k) \
        { if constexpr (Epi::BF16) acc[ai][bj][m][n] = __builtin_amdgcn_mfma_f32_16x16x32_bf16(__builtin_bit_cast(s16x8, Bt[n][k]), __builtin_bit_cast(s16x8, At[m][k]), acc[ai][bj][m][n], 0, 0, 0); \
          else acc[ai][bj][m][n] = __builtin_amdgcn_mfma_f32_16x16x32_f16(Bt[n][k], At[m][k], acc[ai][bj][m][n], 0, 0, 0); } __builtin_amdgcn_s_setprio(0); } while (0)
#define PG8_WAIT_V(n) asm volatile("s_waitcnt vmcnt(" #n ")" ::: "memory")
#define PG8_WAIT_L(n) asm volatile("s_waitcnt lgkmcnt(" #n ")" ::: "memory")
#define PG8_BAR __builtin_amdgcn_s_barrier()
#define PG8_SCHED __builtin_amdgcn_sched_barrier(0)
    Unit cur, nxt; int ui = 0;
    if (!S.next(0, cur)) return;
    f32x4 acc[2][2][4][2];
#pragma unroll
    for (int a = 0; a < 2; ++a)
#pragma unroll
        for (int b = 0; b < 2; ++b)
#pragma unroll
            for (int m = 0; m < 4; ++m)
#pragma unroll
                for (int n = 0; n < 2; ++n) acc[a][b][m][n] = (f32x4){0.f, 0.f, 0.f, 0.f};
    f16x8 At[4][2], B0[2][2], B1[2][2];
    {
        const char* cA0 = p.a_ptr(cur, 0); const char* cB0 = p.b_ptr(cur, 0); const char* cA1 = p.a_ptr(cur, 1); const char* cB1 = p.b_ptr(cur, 1);
        if constexpr (SP2) {
            PG8_STAGE(PG8_SB(0, 0), cB0, voffB); PG8_STAGE(PG8_SB(0, 1), cB0 + bhs, voffB); PG8_STAGE(PG8_SA(0, 0), cA0, voffA); PG8_STAGE(PG8_SA(0, 1), cA0 + ahs, voffA);
            if (wr == 1) PG8_BAR;
            PG8_WAIT_V(2); PG8_BAR;
            PG8_STAGE(PG8_SB(1, 0), cB1, voffB); PG8_STAGE(PG8_SA(1, 0), cA1, voffA); PG8_STAGE(PG8_SB(1, 1), cB1 + bhs, voffB);
            PG8_WAIT_V(6); PG8_BAR;
        } else {
            PG8_STAGE(PG8_SB(0, 0), cB0, voffB); PG8_STAGE(PG8_SA(0, 0), cA0, voffA); PG8_STAGE(PG8_SB(0, 1), cB0 + bhs, voffB); PG8_STAGE(PG8_SA(0, 1), cA0 + ahs, voffA);
            if (wr == 1) PG8_BAR;
            PG8_WAIT_V(4); PG8_BAR;
            PG8_STAGE(PG8_SB(1, 0), cB1, voffB); PG8_STAGE(PG8_SA(1, 0), cA1, voffA); PG8_STAGE(PG8_SB(1, 1), cB1 + bhs, voffB);
            PG8_WAIT_V(6); PG8_BAR;
        }
    }
    for (;;) {
        const bool has_next = S.next(ui + 1, nxt);
        const Unit nu = has_next ? nxt : cur;
#pragma nounroll
        for (int t = 0; t < nt; t += 2) {
            const bool last = (t == nt - 2);
            const char* a1 = p.a_ptr(cur, t + 1);
            const char* a2 = last ? p.a_ptr(nu, 0) : p.a_ptr(cur, t + 2); const char* b2 = last ? p.b_ptr(nu, 0) : p.b_ptr(cur, t + 2);
            const char* a3 = last ? p.a_ptr(nu, 1) : p.a_ptr(cur, t + 3); const char* b3 = last ? p.b_ptr(nu, 1) : p.b_ptr(cur, t + 3);
            if constexpr (SP2) {
            PG8_LDB(B0, 0, 0); PG8_LDB(B1, 0, 1); PG8_SCHED; PG8_LDA(At, 0, 0); PG8_STAGE(PG8_SA(1, 1), a1 + ahs, voffA);
            PG8_WAIT_V(8); PG8_WAIT_L(0); PG8_BAR; PG8_MMA(0, 0, At, B0); PG8_MMA(0, 1, At, B1); PG8_BAR; PG8_SCHED;
            PG8_LDA(At, 0, 1); PG8_STAGE(PG8_SB(0, 0), b2, voffB); PG8_STAGE(PG8_SB(0, 1), b2 + bhs, voffB); PG8_STAGE(PG8_SA(0, 0), a2, voffA);
            PG8_WAIT_V(8); PG8_WAIT_L(0); PG8_BAR; PG8_MMA(1, 0, At, B0); PG8_MMA(1, 1, At, B1); PG8_BAR; PG8_SCHED;
            PG8_LDB(B0, 1, 0); PG8_LDB(B1, 1, 1); PG8_SCHED; PG8_LDA(At, 1, 0); PG8_STAGE(PG8_SA(0, 1), a2 + ahs, voffA);
            PG8_WAIT_V(8); PG8_WAIT_L(0); PG8_BAR; PG8_MMA(0, 0, At, B0); PG8_MMA(0, 1, At, B1); PG8_BAR; PG8_SCHED;
            PG8_LDA(At, 1, 1); PG8_STAGE(PG8_SB(1, 0), b3, voffB); PG8_STAGE(PG8_SB(1, 1), b3 + bhs, voffB); PG8_STAGE(PG8_SA(1, 0), a3, voffA);
            PG8_WAIT_V(8); PG8_WAIT_L(0); PG8_BAR; PG8_MMA(1, 0, At, B0); PG8_MMA(1, 1, At, B1); PG8_BAR; PG8_SCHED;
            } else {
            PG8_LDB(B0, 0, 0); PG8_SCHED; PG8_LDA(At, 0, 0); PG8_STAGE(PG8_SA(1, 1), a1 + ahs, voffA);
            PG8_WAIT_L(8); PG8_BAR; PG8_WAIT_L(0); PG8_MMA(0, 0, At, B0); PG8_BAR; PG8_SCHED;
            PG8_LDB(B1, 0, 1); PG8_STAGE(PG8_SB(0, 0), b2, voffB);
            PG8_BAR; PG8_WAIT_L(0); PG8_MMA(0, 1, At, B1); PG8_BAR;
            PG8_LDA(At, 0, 1); PG8_STAGE(PG8_SA(0, 0), a2, voffA);
            PG8_BAR; PG8_WAIT_L(0); PG8_MMA(1, 0, At, B0); PG8_BAR; PG8_SCHED;
            PG8_STAGE(PG8_SB(0, 1), b2 + bhs, voffB);
            PG8_WAIT_V(6); PG8_BAR; PG8_MMA(1, 1, At, B1); PG8_BAR;
            PG8_LDB(B0, 1, 0); PG8_SCHED; PG8_LDA(At, 1, 0); PG8_STAGE(PG8_SA(0, 1), a2 + ahs, voffA);
            PG8_WAIT_L(8); PG8_BAR; PG8_WAIT_L(0); PG8_MMA(0, 0, At, B0); PG8_BAR; PG8_SCHED;
            PG8_LDB(B1, 1, 1); PG8_STAGE(PG8_SB(1, 0), b3, voffB);
            PG8_BAR; PG8_WAIT_L(0); PG8_MMA(0, 1, At, B1); PG8_BAR;
            PG8_LDA(At, 1, 1); PG8_STAGE(PG8_SA(1, 0), a3, voffA);
            PG8_BAR; PG8_WAIT_L(0); PG8_MMA(1, 0, At, B0); PG8_BAR; PG8_SCHED;
            PG8_STAGE(PG8_SB(1, 1), b3 + bhs, voffB);
            PG8_WAIT_V(6); PG8_BAR; PG8_MMA(1, 1, At, B1); PG8_BAR;
            }
        }
        if constexpr (ALIGN_EPI) { if (wr == 0) PG8_BAR; }
        E(acc, cur, wr, wc, fr, fq);
        if (!has_next) break;
#pragma unroll
        for (int a = 0; a < 2; ++a)
#pragma unroll
            for (int b = 0; b < 2; ++b)
#pragma unroll
                for (int m = 0; m < 4; ++m)
#pragma unroll
                    for (int n = 0; n < 2; ++n) acc[a][b][m][n] = (f32x4){0.f, 0.f, 0.f, 0.f};
        cur = nxt; ++ui;
        if constexpr (ALIGN_EPI) { if (wr == 1) PG8_BAR; }
    }
    PG8_WAIT_V(0);
    if constexpr (!ALIGN_EPI) { if (wr == 0) PG8_BAR; }
    PG8_BAR;
#undef PG8_SA
#undef PG8_SB
#undef PG8_STAGE
#undef PG8_LDA
#undef PG8_LDB
#undef PG8_MMA
#undef PG8_WAIT_V
#undef PG8_WAIT_L
#undef PG8_BAR
#undef PG8_SCHED
}
}
using pg8::Unit;

#define RLX_AGENT __ATOMIC_RELAXED, __HIP_MEMORY_SCOPE_AGENT
#define LDS_WAIT() asm volatile("s_waitcnt lgkmcnt(0)" ::: "memory")
#define VM_WAIT() asm volatile("s_waitcnt vmcnt(0)" ::: "memory")
__device__ __forceinline__ unsigned pk2h_(float lo, float hi) { f32x2 v = {lo, hi}; f16x2 h = __builtin_convertvector(v, f16x2); return __builtin_bit_cast(unsigned, h); }
__device__ __forceinline__ unsigned pk2b(float lo, float hi) { f32x2 v = {lo, hi}; bf16x2_t b = __builtin_convertvector(v, bf16x2_t); return __builtin_bit_cast(unsigned, b); }
#ifndef FFN_BF16
#define FFN_BF16 1
#endif
__device__ __forceinline__ unsigned pk2x(float lo, float hi, bool bf) { return bf ? pk2b(lo, hi) : pk2h_(lo, hi); }
__device__ __forceinline__ unsigned pk2h(float lo, float hi) { f32x2 v = {lo, hi}; f16x2 h = __builtin_convertvector(v, f16x2); return __builtin_bit_cast(unsigned, h); }
__device__ __forceinline__ float wave_sum(float v, int lane) {
#pragma unroll
    for (int o = 1; o < 64; o <<= 1) v += __builtin_bit_cast(float, __builtin_amdgcn_ds_bpermute((lane ^ o) << 2, __builtin_bit_cast(int, v)));
    return v;
}
__device__ __forceinline__ float sigmoid_f(float x) { return __builtin_amdgcn_rcpf(1.0f + __builtin_amdgcn_exp2f(-1.4426950408889634f * x)); }
__device__ __forceinline__ float gelu_tanh_f(float x) {
    const float u2 = 1.5957691216057308f * (x + 0.044715f * x * x * x);
    return x * sigmoid_f(u2);
}
__device__ __forceinline__ int cond_of_panel(int pm) { return pm < 32 ? 0 : (pm < 48 ? 1 : 2); }

#define XB_TMO      128
#define XB_XCNT(j)  (256  + 64 * (j))
#define XB_XSUB(j)  (1280 + 64 * (j))
#define XB_XGEN(j)  (2304 + 64 * (j))
#define XB_TOP      3328
#define XB_TOPGEN   3392
#define XCD_BAR_WORDS 3456
#define XB_SPIN_CAP (1u << 18)
__device__ __forceinline__ unsigned xb_ld(unsigned* p)              { return __hip_atomic_load(p, __ATOMIC_RELAXED, __HIP_MEMORY_SCOPE_AGENT); }
__device__ __forceinline__ unsigned xb_add(unsigned* p, unsigned v) { return __hip_atomic_fetch_add(p, v, __ATOMIC_RELAXED, __HIP_MEMORY_SCOPE_AGENT); }
__device__ __forceinline__ unsigned xb_xcc_id() { return (unsigned)__builtin_amdgcn_s_getreg((3 << 11) | 20) & 0xFu; }
#define XB_SPIN(cond, bar) do { unsigned _sp = 0; while (cond) { __builtin_amdgcn_s_sleep(1); \
    if ((++_sp & 255u) == 0u) { if (xb_ld(&(bar)[XB_TMO])) break; if (_sp > XB_SPIN_CAP) { atomicAdd(&(bar)[XB_TMO], 1u); break; } } } } while (0)
struct XcdBarrier { unsigned* bar; unsigned x; volatile LAS unsigned* st; };
__device__ __forceinline__ XcdBarrier xcd_barrier_post(unsigned* bar, volatile LAS unsigned* st) {
    XcdBarrier b; b.bar = bar; b.x = xb_xcc_id(); b.st = st;
    if (threadIdx.x == 0) (void)xb_add(&bar[XB_XCNT(b.x)], 1u);
    return b;
}
__device__ __forceinline__ void xcd_barrier_complete(unsigned* bar, unsigned x, unsigned& nloc, unsigned& nx) {
    const unsigned G = gridDim.x * gridDim.y * gridDim.z;
    unsigned sum, cnt, mine, sp = 0u;
    for (;;) {
        sum = 0u; cnt = 0u; mine = 0u;
#pragma unroll
        for (unsigned j = 0; j < 16; ++j) { const unsigned c = xb_ld(&bar[XB_XCNT(j)]); sum += c; cnt += (c > 0u) ? 1u : 0u; mine = (j == x) ? c : mine; }
        if (sum == G) break;
        __builtin_amdgcn_s_sleep(1);
        if ((++sp & 255u) == 0u) { if (xb_ld(&bar[XB_TMO])) break; if (sp > XB_SPIN_CAP) { atomicAdd(&bar[XB_TMO], 1u); break; } }
    }
    nloc = mine > 0u ? mine : 1u; nx = cnt > 0u ? cnt : 1u;
}
__device__ __forceinline__ void xcd_barrier(const XcdBarrier& b) {
    asm volatile("s_waitcnt vmcnt(0)" ::: "memory");
    __syncthreads();
    if (threadIdx.x == 0) {
        unsigned* bar = b.bar;
        __builtin_amdgcn_s_waitcnt(0);
        unsigned nloc = b.st[0], nx = b.st[1];
        if (nloc == 0u) { xcd_barrier_complete(bar, b.x, nloc, nx); b.st[0] = nloc; b.st[1] = nx; }
        const unsigned old = xb_add(&bar[XB_XSUB(b.x)], 1u);
        const unsigned gen = old / nloc;
        if (old + 1u == (gen + 1u) * nloc) {
            __builtin_amdgcn_fence(__ATOMIC_RELEASE, "agent");
            asm volatile("s_waitcnt vmcnt(0)" ::: "memory");
            const unsigned og = xb_add(&bar[XB_TOP], 1u);
            const unsigned tg = og / nx;
            if (og + 1u == (tg + 1u) * nx) xb_add(&bar[XB_TOPGEN], 1u);
            else XB_SPIN(xb_ld(&bar[XB_TOPGEN]) == tg, bar);
            __builtin_amdgcn_fence(__ATOMIC_ACQUIRE, "agent");
            xb_add(&bar[XB_XGEN(b.x)], 1u);
            asm volatile("s_waitcnt vmcnt(0)" ::: "memory");
        } else {
            XB_SPIN(xb_ld(&bar[XB_XGEN(b.x)]) == gen, bar);
            __builtin_amdgcn_fence(__ATOMIC_ACQUIRE, "agent");
            asm volatile("s_waitcnt vmcnt(0)" ::: "memory");
        }
    }
    __syncthreads();
}

struct Args {
    const float* x_prompt; const float* x_sample; const float* state_ssm; const float* c; const float* c_ctx;
    const float* w_ada; const float* b_ada; const float* norm_g; const float* ffn_w_in; const float* ffn_w_out;
    const float* fourier_w_o; const float* ssm_a_re; const float* ssm_a_im; const float* ssm_log_dt;
    const float* ssm_b; const float* ssm_c; const float* ssm_d; const float* ssm_w_glu; const float* final_g;
    float* out; unsigned char* ws; int ph_lo, ph_hi;
};
struct Frame {
    LAS unsigned char* lds; int tid, lane, wave, vcu, G, bx;
};

#define GL4S(dst, voff, sbase, off) "global_load_dwordx4 %" #dst ", %" #voff ", %" #sbase " offset:" #off "\n\t"
__device__ __forceinline__ void load_resid_tile(u32x4 (&x)[8][2], f32x4 (&g)[4], const f16* xb, unsigned o0, unsigned o1, unsigned o2, unsigned o3, unsigned o4, unsigned o5, unsigned o6, unsigned o7, const float* mb, unsigned om) {
    asm volatile(GL4S(0, 20, 29, 0) GL4S(1, 20, 29, 256) GL4S(2, 21, 29, 0) GL4S(3, 21, 29, 256) GL4S(4, 22, 29, 0) GL4S(5, 22, 29, 256) GL4S(6, 23, 29, 0) GL4S(7, 23, 29, 256)
                 GL4S(8, 24, 29, 0) GL4S(9, 24, 29, 256) GL4S(10, 25, 29, 0) GL4S(11, 25, 29, 256) GL4S(12, 26, 29, 0) GL4S(13, 26, 29, 256) GL4S(14, 27, 29, 0) GL4S(15, 27, 29, 256)
                 GL4S(16, 28, 30, 0) GL4S(17, 28, 30, 16) GL4S(18, 28, 30, 512) GL4S(19, 28, 30, 528)
                 "s_waitcnt vmcnt(0)"
                 : "=&v"(x[0][0]), "=&v"(x[0][1]), "=&v"(x[1][0]), "=&v"(x[1][1]), "=&v"(x[2][0]), "=&v"(x[2][1]), "=&v"(x[3][0]), "=&v"(x[3][1]),
                   "=&v"(x[4][0]), "=&v"(x[4][1]), "=&v"(x[5][0]), "=&v"(x[5][1]), "=&v"(x[6][0]), "=&v"(x[6][1]), "=&v"(x[7][0]), "=&v"(x[7][1]),
                   "=&v"(g[0]), "=&v"(g[1]), "=&v"(g[2]), "=&v"(g[3])
                 : "v"(o0), "v"(o1), "v"(o2), "v"(o3), "v"(o4), "v"(o5), "v"(o6), "v"(o7), "v"(om), "s"(xb), "s"(mb) : "memory");
}
__device__ __forceinline__ void load_resid_tile1(u32x4 (&x)[8], f32x4 (&g)[2], const f16* xb, unsigned o0, unsigned o1, unsigned o2, unsigned o3, unsigned o4, unsigned o5, unsigned o6, unsigned o7, const float* mb, unsigned om) {
    asm volatile(GL4S(0, 10, 19, 0) GL4S(1, 11, 19, 0) GL4S(2, 12, 19, 0) GL4S(3, 13, 19, 0) GL4S(4, 14, 19, 0) GL4S(5, 15, 19, 0) GL4S(6, 16, 19, 0) GL4S(7, 17, 19, 0)
                 GL4S(8, 18, 20, 0) GL4S(9, 18, 20, 16)
                 "s_waitcnt vmcnt(0)"
                 : "=&v"(x[0]), "=&v"(x[1]), "=&v"(x[2]), "=&v"(x[3]), "=&v"(x[4]), "=&v"(x[5]), "=&v"(x[6]), "=&v"(x[7]), "=&v"(g[0]), "=&v"(g[1])
                 : "v"(o0), "v"(o1), "v"(o2), "v"(o3), "v"(o4), "v"(o5), "v"(o6), "v"(o7), "v"(om), "s"(xb), "s"(mb) : "memory");
}
__device__ __forceinline__ f32x2 h2f(unsigned u) { const f16x2 h = __builtin_bit_cast(f16x2, u); return (f32x2){(float)h[0], (float)h[1]}; }

struct EpiSwiGLU {
    static constexpr bool PERM = true, BF16 = (FFN_BF16 != 0);
    f16* O;
    __device__ __forceinline__ void operator()(const f32x4 (&acc)[2][2][4][2], const Unit& u, int wr, int wc, int fr, int fq) const {
        const int rip = wr * 64 + fr, col0 = u.pn * 128 + wc * 32 + 8 * fq;
#pragma unroll
        for (int ai = 0; ai < 2; ++ai)
#pragma unroll
            for (int m = 0; m < 4; ++m) {
                const f32x4 g0 = acc[ai][0][m][0], g1 = acc[ai][0][m][1], u0 = acc[ai][1][m][0], u1 = acc[ai][1][m][1];
                float r[8];
#pragma unroll
                for (int j = 0; j < 4; ++j) { r[j] = g0[j] * sigmoid_f(g0[j]) * u0[j]; r[4 + j] = g1[j] * sigmoid_f(g1[j]) * u1[j]; }
                u32x4 w; w.x = pk2x(r[0], r[1], BF16); w.y = pk2x(r[2], r[3], BF16); w.z = pk2x(r[4], r[5], BF16); w.w = pk2x(r[6], r[7], BF16);
                *(u32x4*)(O + ((size_t)u.pm * (DFF / 64) + (col0 >> 6)) * 16384 + (size_t)(rip + ai * 128 + m * 16) * 64 + (col0 & 63)) = w;
            }
    }
};
template <bool BF> struct EpiResidT {
    static constexpr bool PERM = true, BF16 = BF;
    f16* X; const float* modv; float coef;
    __device__ __forceinline__ void operator()(const f32x4 (&acc)[2][2][4][2], const Unit& u, int wr, int wc, int fr, int fq) const {
        const int row0 = u.pm * 256 + wr * 64 + fr, col0 = u.pn * 256 + wc * 32 + 8 * fq;
        const float* mb = modv + (size_t)cond_of_panel(u.pm) * (NMOD * D);
        const unsigned e0 = (unsigned)row0 * D + col0;
#define EO(r) (e0 + (unsigned)((((r) >> 2) * 128 + ((r) & 3) * 16) * D))
        u32x4 x[8][2]; f32x4 gv[4];
        load_resid_tile(x, gv, X, EO(0) * 2u, EO(1) * 2u, EO(2) * 2u, EO(3) * 2u, EO(4) * 2u, EO(5) * 2u, EO(6) * 2u, EO(7) * 2u, mb, (unsigned)col0 * 4u);
#pragma unroll
        for (int i = 0; i < 4; ++i) gv[i] = gv[i] * coef;
#pragma unroll
        for (int ai = 0; ai < 2; ++ai)
#pragma unroll
            for (int m = 0; m < 4; ++m)
#pragma unroll
                for (int bj = 0; bj < 2; ++bj) { const u32x4 xv = x[ai * 4 + m][bj];
                    const f32x2 a0 = h2f(xv.x), a1 = h2f(xv.y), a2 = h2f(xv.z), a3 = h2f(xv.w);
                    const f32x4 v0 = (f32x4){a0.x, a0.y, a1.x, a1.y} + gv[2 * bj] * acc[ai][bj][m][0], v1 = (f32x4){a2.x, a2.y, a3.x, a3.y} + gv[2 * bj + 1] * acc[ai][bj][m][1];
                    u32x4 w; w.x = pk2h(v0[0], v0[1]); w.y = pk2h(v0[2], v0[3]); w.z = pk2h(v1[0], v1[1]); w.w = pk2h(v1[2], v1[3]);
                    *(u32x4*)(X + EO(ai * 4 + m) + bj * 128) = w; }
#undef EO
    }
};
struct EpiGLUResid {
    static constexpr bool PERM = true, BF16 = (FFN_BF16 != 0);
    f16* X; const float* modv; float coef;
    __device__ __forceinline__ void operator()(const f32x4 (&acc)[2][2][4][2], const Unit& u, int wr, int wc, int fr, int fq) const {
        const int row0 = u.pm * 256 + wr * 64 + fr, col0 = u.pn * 128 + wc * 32 + 8 * fq;
        const float* mb = modv + (size_t)cond_of_panel(u.pm) * (NMOD * D);
        const unsigned e0 = (unsigned)row0 * D + col0;
#define EO(r) (e0 + (unsigned)((((r) >> 2) * 128 + ((r) & 3) * 16) * D))
        u32x4 x[8]; f32x4 mm[2];
        load_resid_tile1(x, mm, X, EO(0) * 2u, EO(1) * 2u, EO(2) * 2u, EO(3) * 2u, EO(4) * 2u, EO(5) * 2u, EO(6) * 2u, EO(7) * 2u, mb, (unsigned)col0 * 4u);
        const f32x4 m0 = mm[0] * coef, m1 = mm[1] * coef;
#pragma unroll
        for (int ai = 0; ai < 2; ++ai)
#pragma unroll
            for (int m = 0; m < 4; ++m) {
                const f32x4 v0 = acc[ai][0][m][0], v1 = acc[ai][0][m][1], g0 = acc[ai][1][m][0], g1 = acc[ai][1][m][1];
                f32x4 o0, o1;
#pragma unroll
                for (int j = 0; j < 4; ++j) { o0[j] = v0[j] * sigmoid_f(g0[j]); o1[j] = v1[j] * sigmoid_f(g1[j]); }
                const u32x4 xv = x[ai * 4 + m]; const f32x2 a0 = h2f(xv.x), a1 = h2f(xv.y), a2 = h2f(xv.z), a3 = h2f(xv.w);
                const f32x4 n0 = (f32x4){a0.x, a0.y, a1.x, a1.y} + m0 * o0, n1 = (f32x4){a2.x, a2.y, a3.x, a3.y} + m1 * o1;
                u32x4 w; w.x = pk2h(n0[0], n0[1]); w.y = pk2h(n0[2], n0[3]); w.z = pk2h(n1[0], n1[1]); w.w = pk2h(n1[2], n1[3]);
                *(u32x4*)(X + EO(ai * 4 + m)) = w; }
#undef EO
    }
};
struct EpiFA {
    static constexpr bool PERM = true, BF16 = false;
    f16* HT;
    __device__ __forceinline__ void operator()(const f32x4 (&acc)[2][2][4][2], const Unit& u, int wr, int wc, int fr, int fq) const {
        const int P = u.pn; const int n = P < 32 ? SEQ_P : SEQ_S / 2;
        const size_t hb = P < 32 ? (size_t)P * (D * 2 * SEQ_P) : (size_t)NB_P * (D * 2 * SEQ_P) + (size_t)((P - 32) >> 4) * ((size_t)D * SEQ_S);
        const int t0 = (P < 32 ? 0 : ((P - 32) & 15) * 256) + wc * 32 + 8 * fq;
        const int q0 = wr * 64 + fr;
#pragma unroll
        for (int ai = 0; ai < 2; ++ai)
#pragma unroll
            for (int m = 0; m < 4; ++m) { const int q = q0 + ai * 128 + m * 16;
                f16* rowp = HT + hb + ((size_t)(u.z * 256 + q) * 2 + u.pm) * n + t0;
#pragma unroll
                for (int bj = 0; bj < 2; ++bj) { const f32x4 v0 = acc[ai][bj][m][0], v1 = acc[ai][bj][m][1];
                    u32x4 w; w.x = pk2h(v0[0], v0[1]); w.y = pk2h(v0[2], v0[3]); w.z = pk2h(v1[0], v1[1]); w.w = pk2h(v1[2], v1[3]);
                    *(u32x4*)(rowp + bj * 128) = w; } }
    }
};
struct EpiFB {
    static constexpr bool PERM = true, BF16 = false;
    f16* F; int row0, zrows; float scale; const float* hcn;
    __device__ __forceinline__ void operator()(const f32x4 (&acc)[2][2][4][2], const Unit& u, int wr, int wc, int fr, int fq) const {
        const int r0 = row0 + u.z * zrows + u.pm * 256 + wr * 64 + fr, col0 = u.pn * 256 + wc * 32 + 8 * fq;
        f32x4 nq[2][2];
#pragma unroll
        for (int bj = 0; bj < 2; ++bj)
#pragma unroll
            for (int n = 0; n < 2; ++n) { nq[bj][n] = (f32x4){0.f, 0.f, 0.f, 0.f};
                if (hcn) { const f32x4 h = *(const f32x4*)(hcn + (size_t)u.z * D + col0 + bj * 128 + n * 4); nq[bj][n] = (fr & 1) ? -h : h; } }
#pragma unroll
        for (int ai = 0; ai < 2; ++ai)
#pragma unroll
            for (int m = 0; m < 4; ++m) { f16* rowp = F + (size_t)(r0 + ai * 128 + m * 16) * D + col0;
#pragma unroll
                for (int bj = 0; bj < 2; ++bj) { const f32x4 v0 = (acc[ai][bj][m][0] + nq[bj][0]) * scale, v1 = (acc[ai][bj][m][1] + nq[bj][1]) * scale;
                    constexpr bool OB = (FFN_BF16 != 0);
                    u32x4 w; w.x = pk2x(v0[0], v0[1], OB); w.y = pk2x(v0[2], v0[3], OB); w.z = pk2x(v1[0], v1[1], OB); w.w = pk2x(v1[2], v1[3], OB);
                    *(u32x4*)(rowp + bj * 128) = w; } }
    }
};
struct EpiS1 {
    static constexpr bool PERM = true, BF16 = false;
    f16* S;
    __device__ __forceinline__ void operator()(const f32x4 (&acc)[2][2][4][2], const Unit& u, int wr, int wc, int fr, int fq) const {
        const int r0 = u.pm * 256 + wr * 64 + fr, col0 = wc * 32 + 8 * fq;
#pragma unroll
        for (int ai = 0; ai < 2; ++ai)
#pragma unroll
            for (int m = 0; m < 4; ++m) { f16* rowp = S + ((size_t)u.z * 1024 + (r0 + ai * 128 + m * 16)) * 256 + col0;
#pragma unroll
                for (int bj = 0; bj < 2; ++bj) { const f32x4 v0 = acc[ai][bj][m][0], v1 = acc[ai][bj][m][1];
                    u32x4 w; w.x = pk2h(v0[0], v0[1]); w.y = pk2h(v0[2], v0[3]); w.z = pk2h(v1[0], v1[1]); w.w = pk2h(v1[2], v1[3]);
                    *(u32x4*)(rowp + bj * 128) = w; } }
    }
};
struct EpiS3 {
    static constexpr bool PERM = true, BF16 = false;
    f16* Gg;
    __device__ __forceinline__ void operator()(const f32x4 (&acc)[2][2][4][2], const Unit& u, int wr, int wc, int fr, int fq) const {
        const int r0 = u.pm * 256 + wr * 64 + fr, col0 = wc * 32 + 8 * fq;
#pragma unroll
        for (int ai = 0; ai < 2; ++ai)
#pragma unroll
            for (int m = 0; m < 4; ++m) { f16* rowp = Gg + ((size_t)u.z * 1024 + (r0 + ai * 128 + m * 16)) * 256 + col0;
#pragma unroll
                for (int bj = 0; bj < 2; ++bj) { const f32x4 v0 = acc[ai][bj][m][0], v1 = acc[ai][bj][m][1];
                    float rr[8];
#pragma unroll
                    for (int k = 0; k < 4; ++k) { rr[k] = gelu_tanh_f(v0[k]); rr[4 + k] = gelu_tanh_f(v1[k]); }
                    constexpr bool OB = (FFN_BF16 != 0);
                    u32x4 w; w.x = pk2x(rr[0], rr[1], OB); w.y = pk2x(rr[2], rr[3], OB); w.z = pk2x(rr[4], rr[5], OB); w.w = pk2x(rr[6], rr[7], OB);
                    *(u32x4*)(rowp + bj * 128) = w; } }
    }
};

struct SchedFA {
    int vcu;
    __device__ bool next(int i, Unit& u) const { const int idx = i * 256 + vcu; if (idx >= 768) return false; u.pm = idx & 1; u.z = (idx >> 1) & 7;
        if (idx < 512) u.pn = idx >> 4; else { const int j = idx - 512; u.pn = 32 + 16 * (j >> 7) + ((j >> 4) & 7); } return true; }
};
struct SchedFBs {
    int vcu;
    __device__ bool next(int i, Unit& u) const { if (i > 0) return false; u.z = vcu >> 7; u.pm = (vcu >> 3) & 15; u.pn = vcu & 7; return true; }
};
struct SchedFBp {
    int vcu;
    __device__ bool next(int i, Unit& u) const { if (i > 0) return false; u.z = vcu >> 3; u.pm = 0; u.pn = vcu & 7; return true; }
};
struct SchedS {
    int vcu;
    __device__ bool next(int i, Unit& u) const { const int idx = i * 256 + vcu; if (idx >= 512) return false; u.pm = idx & 3; u.z = idx >> 2; u.pn = 0; return true; }
};

struct TItem { const float* src; f16* dst; int N, K; bool bf; };
__device__ __forceinline__ TItem titem_make(const float* W, int K, int N, f16* WT, int half, int item) {
    const int nblk = N / 32, kb = item / nblk, nb = item % nblk, k0 = 64 * kb, n0 = 32 * nb;
    int d0 = n0;
    if (half > 0) { const int bj = n0 / half, rem = n0 % half; d0 = (rem / 128) * 256 + bj * 128 + (rem % 128); }
    TItem t; t.src = W + (size_t)k0 * N + n0; t.dst = WT + ((size_t)(d0 >> 8) * (K / 64) + (k0 >> 6)) * 16384 + (size_t)(d0 & 255) * 64; t.N = N; t.K = 64; t.bf = false; return t;
}
__device__ __forceinline__ TItem titem_decode(const Args& a, int it) {
    constexpr int I_IN = (D / 64) * (2 * DFF / 32), I_OUT = (DFF / 64) * (D / 32), I_O = (D / 64) * (D / 32), I_GLU = (D / 64) * (2 * D / 32);
    int r = it;
    if (r < 8 * I_IN) { const int mi = r / I_IN; TItem t = titem_make(a.ffn_w_in + (size_t)mi * D * 2 * DFF, D, 2 * DFF, (f16*)(a.ws + WS_WIN) + (size_t)mi * D * 2 * DFF, DFF, r % I_IN); t.bf = (FFN_BF16 != 0); return t; } r -= 8 * I_IN;
    if (r < 8 * I_OUT) { const int mi = r / I_OUT; TItem t = titem_make(a.ffn_w_out + (size_t)mi * DFF * D, DFF, D, (f16*)(a.ws + WS_WOUT) + (size_t)mi * DFF * D, 0, r % I_OUT); t.bf = (FFN_BF16 != 0); return t; } r -= 8 * I_OUT;
    if (r < 2 * I_O) { const int mi = r / I_O; TItem t = titem_make(a.fourier_w_o + (size_t)mi * D * D, D, D, (f16*)(a.ws + WS_WO) + (size_t)mi * D * D, 0, r % I_O); t.bf = (FFN_BF16 != 0); return t; } r -= 2 * I_O;
    { const int mi = r / I_GLU; TItem t = titem_make(a.ssm_w_glu + (size_t)mi * D * 2 * D, D, 2 * D, (f16*)(a.ws + WS_WGLU) + (size_t)mi * D * 2 * D, D, r % I_GLU); t.bf = (FFN_BF16 != 0); return t; }
}
__device__ __forceinline__ void titem_load(f32x4 (&v)[8], const TItem& t, int lane) {
    const float* p = t.src + (size_t)(lane >> 3) * t.N + (lane & 7) * 4;
#pragma unroll
    for (int i = 0; i < 8; ++i) v[i] = __builtin_nontemporal_load((const f32x4*)(p + (size_t)(8 * i) * t.N));
}
__device__ __forceinline__ void titem_store(const f32x4 (&v)[8], const TItem& t, LAS float* scr, int lane) {
#pragma unroll
    for (int i = 0; i < 8; ++i) { LAS float* s = scr + (8 * i + (lane >> 3)) * 33 + (lane & 7) * 4; s[0] = v[i][0]; s[1] = v[i][1]; s[2] = v[i][2]; s[3] = v[i][3]; }
    LDS_WAIT(); asm volatile("" ::: "memory");
    const int c = lane & 7;
#pragma unroll
    for (int j = 0; j < 4; ++j) { const int n = (lane >> 3) + 8 * j; const LAS float* s = scr + (8 * c) * 33 + n;
        u32x4 o; o.x = pk2x(s[0 * 33], s[1 * 33], t.bf); o.y = pk2x(s[2 * 33], s[3 * 33], t.bf); o.z = pk2x(s[4 * 33], s[5 * 33], t.bf); o.w = pk2x(s[6 * 33], s[7 * 33], t.bf);
        *(u32x4*)(t.dst + (size_t)n * t.K + 8 * c) = o; }
    LDS_WAIT(); asm volatile("" ::: "memory");
}

__device__ __forceinline__ void ssm_tables_item(const Args& a, int kk, int g, LAS unsigned char* sl, int tid) {
    LAS f32x2* apow = (LAS f32x2*)sl;
    LAS f32x2* bbar = (LAS f32x2*)(sl + 17408);
    LAS f32x2* cc   = (LAS f32x2*)(sl + 17408 + 16384);
    LAS float* klag = (LAS float*)(sl + 17408 + 32768);
    if (tid < 128) {
        const int d = tid >> 6, p = tid & 63;
        const size_t ia = ((size_t)(kk * 2 + d) * SSM_G + g) * SSM_P + p;
        const double are = (double)a.ssm_a_re[ia], aim = (double)a.ssm_a_im[ia];
        const double dt = exp((double)a.ssm_log_dt[(kk * 2 + d) * SSM_G + g]);
        const double mag = exp(are * dt), ang = aim * dt;
        const double abr = mag * cos(ang), abi = mag * sin(ang);
        double cr = 1.0, ci = 0.0;
        for (int m = 0; m <= 16; ++m) {
            apow[(d * 64 + p) * 17 + m] = (f32x2){(float)cr, (float)ci};
            if (m == 16) ((f32x2*)(a.ws + WS_AL))[((size_t)(kk * 2 + d) * SSM_G + g) * SSM_P + p] = (f32x2){(float)cr, (float)ci};
            const double nr = cr * abr - ci * abi, ni = cr * abi + ci * abr; cr = nr; ci = ni;
        }
        const double nr = abr - 1.0, ni = abi, den = are * are + aim * aim;
        const double qr = (nr * are + ni * aim) / den, qi = (ni * are - nr * aim) / den;
        const float* bp = a.ssm_b + (ia * SSM_H) * 2;
        for (int h = 0; h < 16; ++h) { const double br = (double)bp[2 * h], bi = (double)bp[2 * h + 1];
            bbar[(d * 64 + p) * 16 + h] = (f32x2){(float)(qr * br - qi * bi), (float)(qr * bi + qi * br)}; }
    }
    for (int i = tid; i < 2048; i += NTHR) {
        const int d = i >> 10, r = i & 1023;
        const float* cp = a.ssm_c + ((((size_t)(kk * 2 + d) * SSM_G + g) * SSM_H) * SSM_P + r) * 2;
        cc[i] = (f32x2){cp[0], cp[1]};
    }
    __syncthreads();
    {
        const int hc = tid & 3, hb = (tid >> 2) & 3, lag = (tid >> 4) & 15, d = tid >> 8;
        float acc[4][4];
#pragma unroll
        for (int i = 0; i < 4; ++i)
#pragma unroll
            for (int j = 0; j < 4; ++j) acc[i][j] = 0.f;
        for (int p = 0; p < 64; ++p) {
            const f32x2 ap = apow[(d * 64 + p) * 17 + lag];
            f32x2 ab[4], c[4];
#pragma unroll
            for (int j = 0; j < 4; ++j) { const f32x2 bb = bbar[(d * 64 + p) * 16 + 4 * hc + j]; ab[j] = (f32x2){ap.x * bb.x - ap.y * bb.y, ap.x * bb.y + ap.y * bb.x}; }
#pragma unroll
            for (int i = 0; i < 4; ++i) c[i] = cc[(d * 16 + 4 * hb + i) * 64 + p];
#pragma unroll
            for (int i = 0; i < 4; ++i)
#pragma unroll
                for (int j = 0; j < 4; ++j) acc[i][j] += c[i].x * ab[j].x - c[i].y * ab[j].y;
        }
#pragma unroll
        for (int i = 0; i < 4; ++i)
#pragma unroll
            for (int j = 0; j < 4; ++j) klag[((d * 16 + lag) * 16 + 4 * hb + i) * 16 + 4 * hc + j] = acc[i][j];
    }
    __syncthreads();
    f16* W1 = (f16*)(a.ws + WS_W1) + ((size_t)(kk * SSM_G + g) << 16);
    for (int e = tid; e < 65536; e += NTHR) {
        const int k = e & 255, np = e >> 8, h = k & 15, j = k >> 4, p = np & 63, ri = (np >> 6) & 1, d = np >> 7;
        const f32x2 ap = apow[(d * 64 + p) * 17 + (d == 0 ? 15 - j : j)], bb = bbar[(d * 64 + p) * 16 + h];
        const float zr = ap.x * bb.x - ap.y * bb.y, zi = ap.x * bb.y + ap.y * bb.x;
        W1[e] = (f16)(ri == 0 ? zr : zi);
    }
    f16* TW = (f16*)(a.ws + WS_TW) + ((size_t)(kk * SSM_G + g) << 17);
    const float* dw = a.ssm_d + kk * D + g * 16;
    for (int e = tid; e < 131072; e += NTHR) {
        const int k = e & 511, np = e >> 9, hp = np & 15, j = np >> 4;
        float v;
        if (k < 256) { const int h = k & 15, j2 = k >> 4;
            v = (j2 == j && h == hp) ? dw[h] : 0.f;
            if (j2 <= j) v += klag[((0 * 16 + (j - j2)) * 16 + hp) * 16 + h];
            if (j2 >= j) v += klag[((1 * 16 + (j2 - j)) * 16 + hp) * 16 + h];
        } else { const int k2 = k - 256, p = k2 & 63, ri = (k2 >> 6) & 1, d = k2 >> 7;
            const f32x2 c = cc[(d * 16 + hp) * 64 + p], ap = apow[(d * 64 + p) * 17 + (d == 0 ? j + 1 : 16 - j)];
            const float zr = c.x * ap.x - c.y * ap.y, zi = c.x * ap.y + c.y * ap.x;
            v = ri == 0 ? zr : -zi;
        }
        TW[e] = (f16)v;
    }
    __syncthreads();
}

__device__ __forceinline__ void p0a_phase(const Args& a, Frame& F) {
    __syncthreads();
    LAS float* sc = (LAS float*)F.lds;
    for (int i = F.tid; i < 3 * D; i += NTHR) { const int c = i >> 11, k = i & (D - 1); const float v = (c == 0) ? a.c_ctx[k] : a.c[(c - 1) * D + k]; sc[i] = v * sigmoid_f(v); }
    __syncthreads();
    for (int it = F.vcu; it < 2 * SSM_G; it += F.G) ssm_tables_item(a, it >> 7, it & 127, F.lds + 24576, F.tid);
    const int gw = F.vcu * NWAVES + F.wave, NGW = F.G * NWAVES;
    float* modp = (float*)(a.ws + WS_MODP);
    for (int it = gw; it < 4 * 16 * 72; it += NGW) {
        const int nc = it % 72, kc = (it / 72) & 15, l = it / 1152;
        const float* wp = a.w_ada + ((size_t)(l * D + kc * 128)) * (NMOD * D) + nc * 256 + F.lane * 4;
        f32x4 s0 = {0.f, 0.f, 0.f, 0.f}, s1 = s0, s2 = s0;
        for (int k8 = 0; k8 < 128; k8 += 8) {
            f32x4 w[8];
#pragma unroll
            for (int j = 0; j < 8; ++j) w[j] = __builtin_nontemporal_load((const f32x4*)(wp + (size_t)(k8 + j) * (NMOD * D)));
#pragma unroll
            for (int j = 0; j < 8; ++j) { const int k = kc * 128 + k8 + j; s0 += w[j] * sc[k]; s1 += w[j] * sc[D + k]; s2 += w[j] * sc[2 * D + k]; }
        }
        float* op = modp + ((size_t)(kc * 4 + l) * 3) * (NMOD * D) + nc * 256 + F.lane * 4;
        *(f32x4*)op = s0; *(f32x4*)(op + NMOD * D) = s1; *(f32x4*)(op + 2 * NMOD * D) = s2;
    }
    __syncthreads();
    {
        const int gt = F.vcu * NTHR + F.tid, NGT = F.G * NTHR;
        f16* cs4 = (f16*)(a.ws + WS_CS4096);
        for (int ch = gt; ch < 4096 * 512; ch += NGT) {
            const int k = ch >> 9, col0 = (ch & 511) * 8, cs = col0 >> 11, t0 = col0 & 2047; float v[8];
#pragma unroll
            for (int j = 0; j < 8; ++j) { const int mm = (k * (t0 + j)) & 4095; const float x = (float)mm * (1.0f / 2048.0f); v[j] = cs == 0 ? cospif(x) : -sinpif(x); }
            u32x4 o; o.x = pk2h(v[0], v[1]); o.y = pk2h(v[2], v[3]); o.z = pk2h(v[4], v[5]); o.w = pk2h(v[6], v[7]);
            *(u32x4*)(cs4 + (size_t)ch * 8) = o;
        }
        f16* cs2 = (f16*)(a.ws + WS_CS256);
        for (int ch = gt; ch < 256 * 64; ch += NGT) {
            const int k = ch >> 6, col0 = (ch & 63) * 8, cs = col0 >> 8, t0 = col0 & 255; float v[8];
#pragma unroll
            for (int j = 0; j < 8; ++j) { const int mm = (k * (t0 + j)) & 255; const float x = (float)mm * (1.0f / 128.0f); v[j] = cs == 0 ? cospif(x) : -sinpif(x); }
            u32x4 o; o.x = pk2h(v[0], v[1]); o.y = pk2h(v[2], v[3]); o.z = pk2h(v[4], v[5]); o.w = pk2h(v[6], v[7]);
            *(u32x4*)(cs2 + (size_t)ch * 8) = o;
        }
        f16* w2t = (f16*)(a.ws + WS_W2T);
        for (int ch = gt; ch < 512 * 32; ch += NGT) {
            const int row = ch >> 5, c0 = (ch & 31) * 8, cs = row >> 8, q = row & 255; float v[8];
#pragma unroll
            for (int j = 0; j < 8; ++j) { const int mm = (q * (c0 + j)) & 255; const float x = (float)mm * (1.0f / 128.0f); v[j] = cs == 0 ? cospif(x) : sinpif(x); }
            u32x4 o; o.x = pk2h(v[0], v[1]); o.y = pk2h(v[2], v[3]); o.z = pk2h(v[4], v[5]); o.w = pk2h(v[6], v[7]);
            *(u32x4*)(w2t + (size_t)ch * 8) = o;
        }
    }
    {
        LAS float* scr = (LAS float*)(F.lds + F.wave * 16384);
        constexpr int I_IN = (D / 64) * (2 * DFF / 32), I_OUT = (DFF / 64) * (D / 32), I_O = (D / 64) * (D / 32), I_GLU = (D / 64) * (2 * D / 32);
        constexpr int NITEMS = 8 * I_IN + 8 * I_OUT + 2 * I_O + 2 * I_GLU;
        int it = gw;
        if (it < NITEMS) {
            TItem cur = titem_decode(a, it); f32x4 v[8], w[8]; titem_load(v, cur, F.lane);
            for (;;) {
                const int nit = it + NGW; const bool has = nit < NITEMS; TItem nx = cur;
                if (has) { nx = titem_decode(a, nit); titem_load(w, nx, F.lane); }
                titem_store(v, cur, scr, F.lane);
                if (!has) break;
#pragma unroll
                for (int i = 0; i < 8; ++i) v[i] = w[i];
                cur = nx; it = nit;
            }
        }
    }
    {
        float* pe = (float*)(a.ws + WS_PE);
        for (int e = F.vcu * NTHR + F.tid; e < 64 * 512; e += F.G * NTHR) { const int pos = e >> 9, i = e & 511;
            const float fr = exp2f(-(float)i * (13.287712379549449f / 512.0f)); const float ar = (float)pos * fr;
            pe[e] = sinf(ar); pe[64 * 512 + e] = cosf(ar); }
    }
}

__device__ __forceinline__ void p0b_phase(const Args& a, Frame& F) {
    const float* modp = (const float*)(a.ws + WS_MODP); float* mod = (float*)(a.ws + WS_MOD);
    for (int i = F.vcu * NTHR + F.tid; i < 4 * 3 * NMOD * D; i += F.G * NTHR) {
        const int n = i % (NMOD * D), lc = i / (NMOD * D), l = lc / 3;
        float s = a.b_ada[l * (NMOD * D) + n];
#pragma unroll
        for (int kc = 0; kc < 16; ++kc) s += modp[((size_t)kc * 12 + lc) * (NMOD * D) + n];
        mod[i] = s;
    }
}

__device__ __forceinline__ void norm_load_row(const Args& a, Frame& F, int m, bool first, f32x4 (&v)[4][2]) {
    f16* xh = (f16*)(a.ws + WS_XH) + (size_t)m * D;
    if (first) {
        const float* xi = m < NPROMPT ? a.x_prompt + (size_t)m * D : a.x_sample + (size_t)(m - NPROMPT) * D;
        const int t = (m - NPROMPT) & (SEQ_S - 1); const float* pe = (const float*)(a.ws + WS_PE);
#pragma unroll
        for (int q = 0; q < 4; ++q) {
#pragma unroll
            for (int e = 0; e < 2; ++e) { const int c = q * 512 + F.lane * 8 + e * 4; f32x4 x = *(const f32x4*)(xi + c);
                if (m >= NPROMPT) x += *(const f32x4*)(pe + ((q & 1) * 64 + (q < 2 ? (t >> 6) : (t & 63))) * 512 + (c & 511));
                v[q][e] = x; }
            u32x4 w; w.x = pk2h(v[q][0][0], v[q][0][1]); w.y = pk2h(v[q][0][2], v[q][0][3]); w.z = pk2h(v[q][1][0], v[q][1][1]); w.w = pk2h(v[q][1][2], v[q][1][3]);
            *(u32x4*)(xh + q * 512 + F.lane * 8) = w; }
    } else {
#pragma unroll
        for (int q = 0; q < 4; ++q) { const f16x8 h = *(const f16x8*)(xh + q * 512 + F.lane * 8);
            v[q][0] = (f32x4){(float)h[0], (float)h[1], (float)h[2], (float)h[3]}; v[q][1] = (f32x4){(float)h[4], (float)h[5], (float)h[6], (float)h[7]}; }
    }
}
__device__ __forceinline__ float norm_rstd(Frame& F, const f32x4 (&v)[4][2]) {
    float ss = 0.f;
#pragma unroll
    for (int q = 0; q < 4; ++q)
#pragma unroll
        for (int e = 0; e < 2; ++e) { const f32x4 t = v[q][e] * v[q][e]; ss += (t[0] + t[1]) + (t[2] + t[3]); }
    return 1.0f / sqrtf(wave_sum(ss, F.lane) * (1.0f / D) + RMS_EPS);
}
__device__ __forceinline__ void norm_store_row(f16* dst, Frame& F, const f32x4 (&o)[4][2], bool bf = false) {
#pragma unroll
    for (int q = 0; q < 4; ++q) { u32x4 w; w.x = pk2x(o[q][0][0], o[q][0][1], bf); w.y = pk2x(o[q][0][2], o[q][0][3], bf); w.z = pk2x(o[q][1][0], o[q][1][1], bf); w.w = pk2x(o[q][1][2], o[q][1][3], bf);
        *(u32x4*)(dst + q * 512 + F.lane * 8) = w; }
}
__device__ __forceinline__ void norm_store_row_grp(f16* Hg, int m, Frame& F, const f32x4 (&o)[4][2]) {
#pragma unroll
    for (int q = 0; q < 4; ++q) { u32x4 w; w.x = pk2h(o[q][0][0], o[q][0][1]); w.y = pk2h(o[q][0][2], o[q][0][3]); w.z = pk2h(o[q][1][0], o[q][1][1]); w.w = pk2h(o[q][1][2], o[q][1][3]);
        *(u32x4*)(Hg + (size_t)(q * 32 + (F.lane >> 1)) * (MTOK * 16) + (size_t)m * 16 + (F.lane & 1) * 8) = w; }
}
__device__ __forceinline__ void norm_phase(const Args& a, Frame& F, int l, int j, bool first, bool fold, bool grp) {
    const int gw = F.vcu * NWAVES + F.wave; const int row0 = gw * 8;
    const int cond = cond_of_panel(row0 >> 8);
    const float* gp = a.norm_g + (size_t)(l * 3 + j) * D;
    const float* sh = (const float*)(a.ws + WS_MOD) + ((size_t)(l * 3 + cond) * NMOD + 3 * j) * D;
    const float* scl = sh + D;
    f32x4 gs[4][2], sv[4][2];
#pragma unroll
    for (int q = 0; q < 4; ++q)
#pragma unroll
        for (int e = 0; e < 2; ++e) { const int c = q * 512 + F.lane * 8 + e * 4; gs[q][e] = *(const f32x4*)(gp + c) * (*(const f32x4*)(scl + c) + 1.0f); sv[q][e] = *(const f32x4*)(sh + c); }
    f16* H = (f16*)(a.ws + WS_H);
    if (!(fold && row0 >= NPROMPT)) {
        const f16* xh0 = (const f16*)(a.ws + WS_XH) + (size_t)row0 * D + F.lane * 8;
        u32x4 nx[4];
        if (!first) {
#pragma unroll
            for (int q = 0; q < 4; ++q) nx[q] = *(const u32x4*)(xh0 + q * 512);
        }
        for (int r = 0; r < 8; ++r) {
            const int m = row0 + r;
            f32x4 v[4][2];
            if (first) norm_load_row(a, F, m, true, v);
            else {
#pragma unroll
                for (int q = 0; q < 4; ++q) { const f16x8 h = __builtin_bit_cast(f16x8, nx[q]);
                    v[q][0] = (f32x4){(float)h[0], (float)h[1], (float)h[2], (float)h[3]}; v[q][1] = (f32x4){(float)h[4], (float)h[5], (float)h[6], (float)h[7]}; }
                if (r < 7) {
#pragma unroll
                    for (int q = 0; q < 4; ++q) nx[q] = *(const u32x4*)(xh0 + (size_t)(r + 1) * D + q * 512);
                }
            }
            const float rstd = norm_rstd(F, v);
#pragma unroll
            for (int q = 0; q < 4; ++q)
#pragma unroll
                for (int e = 0; e < 2; ++e) v[q][e] = v[q][e] * rstd * gs[q][e] + sv[q][e];
            if (grp) norm_store_row_grp(H, m, F, v);
            else norm_store_row(H + (size_t)m * D, F, v, (FFN_BF16 != 0) && j != 1);
        }
    } else {
        f16* G2 = (f16*)(a.ws + WS_G);
        const int i = gw - NPROMPT / 8, b = i >> 9, t0 = (i & 511) * 4, rb = NPROMPT + SEQ_S * b;
        for (int r = 0; r < 4; ++r) {
            const int t = t0 + r, ma = rb + t, mb = rb + (t == 0 ? SEQ_S / 2 : SEQ_S - t);
            f32x4 va[4][2], vb[4][2]; norm_load_row(a, F, ma, false, va); norm_load_row(a, F, mb, false, vb);
            const float ra = norm_rstd(F, va), rbv = norm_rstd(F, vb);
#pragma unroll
            for (int q = 0; q < 4; ++q)
#pragma unroll
                for (int e = 0; e < 2; ++e) { va[q][e] = va[q][e] * ra * gs[q][e] + sv[q][e]; vb[q][e] = vb[q][e] * rbv * gs[q][e] + sv[q][e]; }
            if (t == 0) {
                norm_store_row(H + (size_t)ma * D, F, va); norm_store_row(H + (size_t)mb * D, F, vb);
#pragma unroll
                for (int q = 0; q < 4; ++q)
#pragma unroll
                    for (int e = 0; e < 2; ++e) vb[q][e] = (f32x4){0.f, 0.f, 0.f, 0.f};
                norm_store_row(G2 + (size_t)ma * D, F, vb);
            } else {
                f32x4 se[4][2], so[4][2];
#pragma unroll
                for (int q = 0; q < 4; ++q)
#pragma unroll
                    for (int e = 0; e < 2; ++e) { se[q][e] = va[q][e] + vb[q][e]; so[q][e] = va[q][e] - vb[q][e]; }
                norm_store_row(H + (size_t)ma * D, F, se); norm_store_row(G2 + (size_t)ma * D, F, so);
            }
        }
    }
    if (fold && gw < 64) {
        const int b = gw >> 5, m = NPROMPT + SEQ_S * b + SEQ_S / 2;
        const float* sh2 = (const float*)(a.ws + WS_MOD) + ((size_t)(l * 3 + 1 + b) * NMOD + 3 * j) * D; const float* scl2 = sh2 + D;
        f32x4 v[4][2]; norm_load_row(a, F, m, false, v);
        const float rstd = norm_rstd(F, v);
        LAS float* hl = (LAS float*)(F.lds + F.wave * 16384);
#pragma unroll
        for (int q = 0; q < 4; ++q)
#pragma unroll
            for (int e = 0; e < 2; ++e) { const int c = q * 512 + F.lane * 8 + e * 4;
                const f32x4 o = v[q][e] * rstd * (*(const f32x4*)(gp + c) * (*(const f32x4*)(scl2 + c) + 1.0f)) + *(const f32x4*)(sh2 + c);
                *(LAS f32x4*)(hl + c) = o; }
        LDS_WAIT(); asm volatile("" ::: "memory");
        const int o = (gw & 31) * 64 + F.lane, g = o >> 8, q = o & 255;
        float s = 0.f;
        for (int c = 0; c < 256; ++c) s += hl[256 * g + c] * __builtin_amdgcn_cosf((float)((q * c) & 255) * (1.0f / 256.0f));
        ((float*)(a.ws + WS_HCN))[(size_t)b * D + o] = s;
        LDS_WAIT(); asm volatile("" ::: "memory");
    }
}

__device__ __forceinline__ void final_phase(const Args& a, Frame& F) {
    const int gw = F.vcu * NWAVES + F.wave; const int row0 = gw * 8;
    f32x4 gs[4][2];
#pragma unroll
    for (int q = 0; q < 4; ++q)
#pragma unroll
        for (int e = 0; e < 2; ++e) gs[q][e] = *(const f32x4*)(a.final_g + q * 512 + F.lane * 8 + e * 4);
    for (int r = 0; r < 8; ++r) {
        const int m = row0 + r;
        f32x4 v[4][2]; norm_load_row(a, F, m, false, v);
        const float rstd = norm_rstd(F, v);
        float* xr = a.out + (size_t)m * D;
#pragma unroll
        for (int q = 0; q < 4; ++q)
#pragma unroll
            for (int e = 0; e < 2; ++e) *(f32x4*)(xr + q * 512 + F.lane * 8 + e * 4) = v[q][e] * rstd * gs[q][e];
    }
}

__device__ __forceinline__ void scan_phase(const Args& a, Frame& F, int kk) {
    const int gw = F.vcu * NWAVES + F.wave, NGW = F.G * NWAVES;
    const f16* S = (const f16*)(a.ws + WS_S); f16* CC = (f16*)(a.ws + WS_CC);
    const f32x2* AL = (const f32x2*)(a.ws + WS_AL);
    float* ns = a.out + (size_t)MTOK * D;
    const int p = F.lane, w = F.wave;
    LAS f32x2* Lx = (LAS f32x2*)F.lds;
    for (int item = F.vcu; item < 2 * SSM_G; item += F.G) {
        const int sq = item >> 7, g = item & 127, c0 = 512 + 256 * sq;
        const size_t gb = (size_t)g * 1024 * 256;
#pragma unroll
        for (int d = 0; d < 2; ++d) {
            const f32x2 al = AL[((size_t)(kk * 2 + d) * SSM_G + g) * SSM_P + p];
            float cr = 0.f, ci = 0.f;
            for (int s8 = 0; s8 < 32; s8 += 16) {
                f16 sr[16], si[16];
#pragma unroll
                for (int j = 0; j < 16; ++j) { const int i = 32 * w + s8 + j, c = d == 0 ? c0 + i : c0 + 255 - i; const f16* q = S + gb + (size_t)c * 256 + d * 128 + p; sr[j] = q[0]; si[j] = q[64]; }
#pragma unroll
                for (int j = 0; j < 16; ++j) { const float nr = al.x * cr - al.y * ci + (float)sr[j], ni = al.x * ci + al.y * cr + (float)si[j]; cr = nr; ci = ni; }
            }
            Lx[(d * 8 + w) * 64 + p] = (f32x2){cr, ci};
        }
        __syncthreads();
#pragma unroll
        for (int d = 0; d < 2; ++d) {
            const f32x2 al = AL[((size_t)(kk * 2 + d) * SSM_G + g) * SSM_P + p];
            f32x2 a32 = al;
#pragma unroll
            for (int k = 0; k < 5; ++k) a32 = (f32x2){a32.x * a32.x - a32.y * a32.y, 2.f * a32.x * a32.y};
            const float* sp = a.state_ssm + (((((size_t)sq * 2 + kk) * 2 + d) * SSM_G + g) * SSM_P + p) * 2;
            float cr = sp[0], ci = sp[1];
            for (int v = 0; v < w; ++v) { const f32x2 L = Lx[(d * 8 + v) * 64 + p]; const float nr = a32.x * cr - a32.y * ci + L.x, ni = a32.x * ci + a32.y * cr + L.y; cr = nr; ci = ni; }
            for (int s8 = 0; s8 < 32; s8 += 16) {
                f16 sr[16], si[16];
#pragma unroll
                for (int j = 0; j < 16; ++j) { const int i = 32 * w + s8 + j, c = d == 0 ? c0 + i : c0 + 255 - i; const f16* q = S + gb + (size_t)c * 256 + d * 128 + p; sr[j] = q[0]; si[j] = q[64]; }
#pragma unroll
                for (int j = 0; j < 16; ++j) { const int i = 32 * w + s8 + j, c = d == 0 ? c0 + i : c0 + 255 - i;
                    f16* o = CC + gb + (size_t)c * 256 + d * 128 + p; o[0] = (f16)cr; o[64] = (f16)ci;
                    const float nr = al.x * cr - al.y * ci + (float)sr[j], ni = al.x * ci + al.y * cr + (float)si[j]; cr = nr; ci = ni; }
            }
        }
        __syncthreads();
    }
    for (int it = gw; it < NB_P * SSM_G * 2; it += NGW) {
        const int sq = it >> 8, g = (it >> 1) & 127, d = it & 1, c0 = sq * 16;
        const size_t gb = (size_t)g * 1024 * 256;
        const f32x2 al = AL[((size_t)(kk * 2 + d) * SSM_G + g) * SSM_P + p];
        float cr = 0.f, ci = 0.f;
        f16 sr[16], si[16];
#pragma unroll
        for (int j = 0; j < 16; ++j) { const int c = d == 0 ? c0 + j : c0 + 15 - j; const f16* q = S + gb + (size_t)c * 256 + d * 128 + p; sr[j] = q[0]; si[j] = q[64]; }
#pragma unroll
        for (int j = 0; j < 16; ++j) { const int c = d == 0 ? c0 + j : c0 + 15 - j;
            f16* o = CC + gb + (size_t)c * 256 + d * 128 + p; o[0] = (f16)cr; o[64] = (f16)ci;
            const float nr = al.x * cr - al.y * ci + (float)sr[j], ni = al.x * ci + al.y * cr + (float)si[j]; cr = nr; ci = ni; }
        float* o = ns + (((((size_t)sq * 2 + kk) * 2 + d) * SSM_G + g) * SSM_P + p) * 2; *(f32x2*)o = (f32x2){cr, ci};
    }
}

constexpr int N_PHASES = 45;
#ifndef MK_PER_PHASE
#define MK_PER_PHASE 0
#endif

#ifndef EN_MASK
#define EN_MASK 0xFFFF
#endif
#ifndef PROBE
#define PROBE 0
#endif
#ifndef PROBE_SEL
#define PROBE_SEL 31
#endif
#if PROBE
#define EN(bit) pkind_ = (bit); if constexpr (((EN_MASK) >> (bit)) & 1)
#else
#define EN(bit) if constexpr (((EN_MASK) >> (bit)) & 1)
#endif
#ifndef G_SP2
#define G_SP2 true
#endif
#ifndef G_ALIGN
#define G_ALIGN true
#endif
#ifndef REP_MASK
#define REP_MASK 0
#endif
#define REPCNT(bit) ((((REP_MASK) >> (bit)) & 1) ? 2 : 1)
#define REP(bit) for (int rep_ = 0; rep_ < REPCNT(bit); ++rep_)
typedef pg8::Prob<false> ProbStd;
typedef pg8::Prob<true> ProbGrp;

__device__ __forceinline__ ProbStd make_std(const void* A, unsigned lda2, size_t a_t, size_t a_z, const void* B, unsigned ldb2, size_t b_t, size_t b_z, int nt) {
    ProbStd p; p.A = (const char*)A; p.A2 = (const char*)A; p.B = (const char*)B; p.nt = nt; p.ksplit = nt; p.lda2 = lda2; p.ldb2 = ldb2; p.a_t = a_t; p.a_z = a_z; p.b_t = b_t; p.b_z = b_z; p.a_k = 128u; p.b_k = 128u; return p;
}

struct ArgsK {
    const GAS float* x_prompt; const GAS float* x_sample; const GAS float* state_ssm; const GAS float* c; const GAS float* c_ctx;
    const GAS float* w_ada; const GAS float* b_ada; const GAS float* norm_g; const GAS float* ffn_w_in; const GAS float* ffn_w_out;
    const GAS float* fourier_w_o; const GAS float* ssm_a_re; const GAS float* ssm_a_im; const GAS float* ssm_log_dt;
    const GAS float* ssm_b; const GAS float* ssm_c; const GAS float* ssm_d; const GAS float* ssm_w_glu; const GAS float* final_g;
    GAS float* out; GAS unsigned char* ws; int ph_lo, ph_hi;
};
static_assert(sizeof(ArgsK) == sizeof(Args), "ArgsK mirrors Args");
__device__ __forceinline__ Args kargs() {
    const __attribute__((address_space(4))) ArgsK* p = (const __attribute__((address_space(4))) ArgsK*)__builtin_amdgcn_kernarg_segment_ptr(); asm volatile("" : "+s"(p));
    Args a;
    a.x_prompt = (const float*)p->x_prompt; a.x_sample = (const float*)p->x_sample; a.state_ssm = (const float*)p->state_ssm; a.c = (const float*)p->c; a.c_ctx = (const float*)p->c_ctx;
    a.w_ada = (const float*)p->w_ada; a.b_ada = (const float*)p->b_ada; a.norm_g = (const float*)p->norm_g; a.ffn_w_in = (const float*)p->ffn_w_in; a.ffn_w_out = (const float*)p->ffn_w_out;
    a.fourier_w_o = (const float*)p->fourier_w_o; a.ssm_a_re = (const float*)p->ssm_a_re; a.ssm_a_im = (const float*)p->ssm_a_im; a.ssm_log_dt = (const float*)p->ssm_log_dt;
    a.ssm_b = (const float*)p->ssm_b; a.ssm_c = (const float*)p->ssm_c; a.ssm_d = (const float*)p->ssm_d; a.ssm_w_glu = (const float*)p->ssm_w_glu; a.final_g = (const float*)p->final_g;
    a.out = (float*)p->out; a.ws = (unsigned char*)p->ws; a.ph_lo = p->ph_lo; a.ph_hi = p->ph_hi;
    return a;
}

__device__ __forceinline__ void set_b_tm(ProbStd& p, int nkt) { p.ldb2 = 128u; p.b_k = 32768u; p.b_t = (size_t)nkt * 32768; }
__device__ __forceinline__ void set_a_tm(ProbStd& p, int nkt) { p.lda2 = 128u; p.a_k = 32768u; p.a_t = (size_t)nkt * 32768; }

__global__ void __launch_bounds__(NTHR, 2) fwd_kernel(ArgsK a_unused) {
    extern __shared__ __attribute__((aligned(16))) unsigned char lds_raw[];
    Frame F0;
    F0.lds = (LAS unsigned char*)lds_raw;
    F0.tid = threadIdx.x; F0.lane = F0.tid & 63; F0.wave = __builtin_amdgcn_readfirstlane(F0.tid >> 6);
    F0.G = gridDim.x; F0.bx = blockIdx.x; { const int bx = blockIdx.x; F0.vcu = (F0.G % 8 == 0) ? (bx % 8) * (F0.G / 8) + bx / 8 : bx; }
    volatile LAS unsigned* MISC = (volatile LAS unsigned*)(F0.lds + MISC_OFF);
    if (F0.tid < 64) MISC[F0.tid] = 0u;
    __syncthreads();
    unsigned bar_x; int lo, hi;
    { const Args a = kargs(); unsigned* ctl = (unsigned*)(a.ws + WS_CTL); const XcdBarrier b0 = xcd_barrier_post(ctl + CW_BAR, MISC + 8); bar_x = b0.x; lo = a.ph_lo; hi = a.ph_hi; }
#define GRID_BAR() do { const Args ab = kargs(); XcdBarrier bb; bb.bar = (unsigned*)(ab.ws + WS_CTL) + CW_BAR; unsigned bx_ = bar_x; asm volatile("" : "+s"(bx_)); bb.x = bx_; bb.st = MISC + 8; xcd_barrier(bb); } while (0)
    int ph = 0;
#define PH_BEGIN if (ph >= lo && ph < hi) { const Args a = kargs(); unsigned char* ws = a.ws; \
    Frame F = F0; asm volatile("" : "+s"(F.vcu), "+s"(F.wave), "+s"(F.G), "+s"(F.bx)); asm volatile("" : "+v"(F.tid)); F.lane = F.tid & 63;   \
    f16* H = (f16*)(ws + WS_H); f16* ACT = (f16*)(ws + WS_ACT); f16* HT = (f16*)(ws + WS_HT); f16* Fm = (f16*)(ws + WS_F); \
    f16* Sm = (f16*)(ws + WS_S); f16* CC = (f16*)(ws + WS_CC); f16* Gm = (f16*)(ws + WS_G); \
    const float* modl = (const float*)(ws + WS_MOD) + (size_t)l * 3 * NMOD * D; \
    (void)H; (void)ACT; (void)HT; (void)Fm; (void)Sm; (void)CC; (void)Gm; (void)modl; PROBE_T0
#if PROBE
#define PROBE_T0 unsigned long long pt0_ = __builtin_amdgcn_s_memrealtime(); int pkind_ = 0; (void)pkind_;
#define PROBE_T1 { const unsigned long long pt1_ = __builtin_amdgcn_s_memrealtime(); if (threadIdx.x == 0) atomicAdd((unsigned long long*)(ws + WS_CTL + 262144) + pkind_, pt1_ - pt0_); pt0_ = pt1_; }
#define PROBE_T2 { const unsigned long long pt2_ = __builtin_amdgcn_s_memrealtime(); if (threadIdx.x == 0) { atomicAdd((unsigned long long*)(ws + WS_CTL + 262144) + 31, pt2_ - pt0_); atomicAdd((unsigned long long*)(ws + WS_CTL + 262144) + 16 + pkind_, pt2_ - pt0_); } }
#else
#define PROBE_T0
#define PROBE_T1
#define PROBE_T2
#endif
#define PH_END   PROBE_T1 if (ph + 1 < hi) { GRID_BAR(); PROBE_T2 } } ++ph;

    { const int l = 0;
    PH_BEGIN EN(0) REP(0) p0a_phase(a, F); PH_END
    PH_BEGIN EN(1) REP(1) p0b_phase(a, F); PH_END
    }
    for (int l = 0; l < DEPTH; ++l) {
        for (int s = 0; s < 2; ++s) {
            PH_BEGIN EN(2) REP(2) norm_phase(a, F, l, 2 * s, l == 0 && s == 0, false, false); PH_END
            PH_BEGIN EN(3) REP(3) {
                const f16* Wt = (const f16*)(ws + WS_WIN) + (size_t)(l * 2 + s) * D * 2 * DFF;
                ProbStd p = make_std(H, D * 2, (size_t)256 * D * 2, 0, Wt, D * 2, (size_t)256 * D * 2, 0, D / 64); set_b_tm(p, D / 64);
                pg8::StaticOrder S; S.init(MTOK, 2 * DFF, F.G, F.bx);
                EpiSwiGLU E{ACT};
                pg8::gemm_phase<ProbStd, EpiSwiGLU, pg8::StaticOrder, G_ALIGN, G_SP2>(F.lds, p, S, E);
            } PH_END
            PH_BEGIN EN(4) REP(4) {
                const f16* Wt = (const f16*)(ws + WS_WOUT) + (size_t)(l * 2 + s) * DFF * D;
                ProbStd p = make_std(ACT, DFF * 2, (size_t)256 * DFF * 2, 0, Wt, DFF * 2, (size_t)256 * DFF * 2, 0, DFF / 64); set_a_tm(p, DFF / 64); set_b_tm(p, DFF / 64);
                pg8::StaticOrder S; S.init(MTOK, D, F.G, F.bx);
                EpiResidT<(FFN_BF16 != 0)> E{(f16*)(ws + WS_XH), modl + (size_t)(2 + 6 * s) * D, 0.5f / REPCNT(4)};
                pg8::gemm_phase<ProbStd, EpiResidT<(FFN_BF16 != 0)>, pg8::StaticOrder, G_ALIGN, G_SP2>(F.lds, p, S, E);
            } PH_END
            if (s == 0) {
                PH_BEGIN EN(2) REP(2) norm_phase(a, F, l, 1, false, (l & 1) == 0, (l & 1) != 0); PH_END
                const int kk = l >> 1;
                if ((l & 1) == 0) {
                    PH_BEGIN EN(5) REP(5) {
                        pg8::ProbFA p; (ProbStd&)p = make_std(ws + WS_W2T, 512, (size_t)256 * 512, 0, H, D * 2, (size_t)256 * D * 2, 512, 4);
                        p.b_m = (size_t)((const char*)Gm - (const char*)H);
                        SchedFA S{F.vcu}; EpiFA E{HT};
                        pg8::gemm_phase<pg8::ProbFA, EpiFA, SchedFA, true, true>(F.lds, p, S, E);
                    } PH_END
                    PH_BEGIN EN(6) REP(6) {
                        {
                            ProbStd p = make_std(ws + WS_CS4096, 8192, (size_t)256 * 8192, 0, HT + (size_t)NB_P * D * 2 * SEQ_P, 8192, (size_t)256 * 8192, (size_t)D * 8192, 64);
                            SchedFBs S{F.vcu}; EpiFB E{Fm, NPROMPT, SEQ_S, 1.0f / 1024.0f, (const float*)(ws + WS_HCN)};
                            pg8::gemm_phase<ProbStd, EpiFB, SchedFBs, false, true>(F.lds, p, S, E);
                        }
                        {
                            ProbStd p = make_std(ws + WS_CS256, 1024, (size_t)256 * 1024, 0, HT, 1024, (size_t)256 * 1024, (size_t)D * 1024, 8);
                            SchedFBp S{F.vcu}; EpiFB E{Fm, 0, SEQ_P, 1.0f / 256.0f, nullptr};
                            pg8::gemm_phase<ProbStd, EpiFB, SchedFBp, false, true>(F.lds, p, S, E);
                        }
                    } PH_END
                    PH_BEGIN EN(7) REP(7) {
                        const f16* Wt = (const f16*)(ws + WS_WO) + (size_t)kk * D * D;
                        ProbStd p = make_std(Fm, D * 2, (size_t)256 * D * 2, 0, Wt, D * 2, (size_t)256 * D * 2, 0, D / 64); set_b_tm(p, D / 64);
                        pg8::StaticOrder S; S.init(MTOK, D, F.G, F.bx);
                        EpiResidT<(FFN_BF16 != 0)> E{(f16*)(ws + WS_XH), modl + (size_t)5 * D, 1.0f / REPCNT(7)};
                        pg8::gemm_phase<ProbStd, EpiResidT<(FFN_BF16 != 0)>, pg8::StaticOrder, G_ALIGN, G_SP2>(F.lds, p, S, E);
                    } PH_END
                } else {
                    PH_BEGIN EN(8) REP(8) {
                        ProbStd p = make_std(H, 512, (size_t)256 * 512, pg8::PLANE_B, ws + WS_W1 + (size_t)kk * SSM_G * 256 * 512, 512, 0, (size_t)256 * 512, 4);
                        SchedS S{F.vcu}; EpiS1 E{Sm};
                        pg8::gemm_phase<ProbStd, EpiS1, SchedS, true, true>(F.lds, p, S, E);
                    } PH_END
                    PH_BEGIN EN(9) REP(9) scan_phase(a, F, kk); PH_END
                    PH_BEGIN EN(10) REP(10) {
                        ProbStd p = make_std(H, 512, (size_t)256 * 512, pg8::PLANE_B, ws + WS_TW + (size_t)kk * SSM_G * 256 * 1024, 1024, 0, (size_t)256 * 1024, 8);
                        p.A2 = (const char*)CC; p.ksplit = 4;
                        SchedS S{F.vcu}; EpiS3 E{Gm};
                        pg8::gemm_phase<ProbStd, EpiS3, SchedS, true, true>(F.lds, p, S, E);
                    } PH_END
                    PH_BEGIN EN(11) REP(11) {
                        const f16* Wt = (const f16*)(ws + WS_WGLU) + (size_t)kk * D * 2 * D;
                        ProbGrp p; { const ProbStd q = make_std(Gm, 32, (size_t)256 * 32, 0, Wt, D * 2, (size_t)256 * D * 2, 0, D / 64); p.A = q.A; p.A2 = q.A2; p.B = q.B; p.nt = q.nt; p.ksplit = q.ksplit; p.lda2 = q.lda2; p.a_t = q.a_t; p.a_z = 0; p.b_z = 0; }
                        p.a_k = 4u * pg8::PLANE_B; p.ldb2 = 128u; p.b_k = 32768u; p.b_t = (size_t)(D / 64) * 32768;
                        pg8::StaticOrder S; S.init(MTOK, 2 * D, F.G, F.bx);
                        EpiGLUResid E{(f16*)(ws + WS_XH), modl + (size_t)5 * D, 1.0f / REPCNT(11)};
                        pg8::gemm_phase<ProbGrp, EpiGLUResid, pg8::StaticOrder, G_ALIGN, G_SP2>(F.lds, p, S, E);
                    } PH_END
                }
            }
        }
    }
    { const int l = 0;
    PH_BEGIN EN(12) REP(12) final_phase(a, F); PH_END
    }
#if PROBE
    {
        GRID_BAR();
        if (blockIdx.x == 0) {
            if (threadIdx.x == 0) { const Args ap = kargs(); const unsigned long long v = __hip_atomic_load((unsigned long long*)(ap.ws + WS_CTL + 262144) + PROBE_SEL, __ATOMIC_RELAXED, __HIP_MEMORY_SCOPE_AGENT) / gridDim.x;
                const unsigned long long t0 = __builtin_amdgcn_s_memrealtime(); while (__builtin_amdgcn_s_memrealtime() - t0 < v) __builtin_amdgcn_s_sleep(8); }
            __syncthreads();
        }
    }
#endif
#undef PH_BEGIN
#undef PH_END
}

extern "C" void kernel_launch(void* const* d_in, const int* in_sizes, int n_in, void* d_out, int out_size, void* d_ws, size_t ws_size, hipStream_t stream) {
    static int grid = 0;
    if (grid == 0) {
        if (n_in != 19 || ws_size < WS_END) { fprintf(stderr, "kernel_launch: unexpected n_in %d or ws_size %zu (need %zu)\n", n_in, ws_size, (size_t)WS_END); grid = -1; return; }
        int dev = 0, cus = 0, per_cu = 0;
        if (hipGetDevice(&dev) != hipSuccess || hipDeviceGetAttribute(&cus, hipDeviceAttributeMultiprocessorCount, dev) != hipSuccess) { grid = -1; return; }
        if (hipFuncSetAttribute((const void*)fwd_kernel, hipFuncAttributeMaxDynamicSharedMemorySize, LDS_BYTES) != hipSuccess) { fprintf(stderr, "kernel_launch: hipFuncSetAttribute failed\n"); grid = -1; return; }
        if (hipOccupancyMaxActiveBlocksPerMultiprocessor(&per_cu, (const void*)fwd_kernel, NTHR, LDS_BYTES) != hipSuccess || per_cu < 1) fprintf(stderr, "kernel_launch: occupancy query reports %d\n", per_cu);
        (void)hipGetLastError();
        grid = cus < 256 ? cus : 256;
    }
    if (grid < 0) return;
    (void)hipMemsetAsync((char*)d_ws + WS_CTL, 0, CTL_ZERO_BYTES, stream);
    ArgsK a{};
    a.x_prompt = (const GAS float*)d_in[0]; a.x_sample = (const GAS float*)d_in[1]; a.state_ssm = (const GAS float*)d_in[2]; a.c = (const GAS float*)d_in[3]; a.c_ctx = (const GAS float*)d_in[4];
    a.w_ada = (const GAS float*)d_in[5]; a.b_ada = (const GAS float*)d_in[6]; a.norm_g = (const GAS float*)d_in[7]; a.ffn_w_in = (const GAS float*)d_in[8]; a.ffn_w_out = (const GAS float*)d_in[9];
    a.fourier_w_o = (const GAS float*)d_in[10]; a.ssm_a_re = (const GAS float*)d_in[11]; a.ssm_a_im = (const GAS float*)d_in[12]; a.ssm_log_dt = (const GAS float*)d_in[13];
    a.ssm_b = (const GAS float*)d_in[14]; a.ssm_c = (const GAS float*)d_in[15]; a.ssm_d = (const GAS float*)d_in[16]; a.ssm_w_glu = (const GAS float*)d_in[17]; a.final_g = (const GAS float*)d_in[18];
    a.out = (GAS float*)d_out; a.ws = (GAS unsigned char*)d_ws;
#if MK_PER_PHASE
    for (int i = 0; i < N_PHASES; ++i) { a.ph_lo = i; a.ph_hi = i + 1; hipLaunchKernelGGL(fwd_kernel, dim3(grid), dim3(NTHR), LDS_BYTES, stream, a); }
#else
    a.ph_lo = 0; a.ph_hi = N_PHASES;
    hipLaunchKernelGGL(fwd_kernel, dim3(grid), dim3(NTHR), LDS_BYTES, stream, a);
#endif
    const hipError_t le = hipPeekAtLastError();
    if (le != hipSuccess) fprintf(stderr, "kernel_launch: launch failed: %s\n", hipGetErrorName(le));
}
```

```cpp
#include <hip/hip_runtime.h>
#include <cstdio>
#include <cstdint>

#define LAS __attribute__((address_space(3)))
#define GAS __attribute__((address_space(1)))
typedef _Float16 f16;
typedef _Float16 f16x8 __attribute__((ext_vector_type(8)));
typedef _Float16 f16x4 __attribute__((ext_vector_type(4)));
typedef _Float16 f16x2 __attribute__((ext_vector_type(2)));
typedef float f32x4 __attribute__((ext_vector_type(4)));
typedef float f32x2 __attribute__((ext_vector_type(2)));
typedef short s16x8 __attribute__((ext_vector_type(8)));
typedef __bf16 bf16x2_t __attribute__((ext_vector_type(2)));
typedef unsigned u32x4 __attribute__((ext_vector_type(4)));
typedef unsigned u32x2 __attribute__((ext_vector_type(2)));

constexpr int D = 2048, DFF = 5632, MTOK = 16384, NPROMPT = 8192, SEQ_P = 256, SEQ_S = 4096, NB_P = 32, NB_S = 2;
constexpr int DEPTH = 4, NMOD = 9, SSM_G = 128, SSM_P = 64, SSM_H = 16;
constexpr float RMS_EPS = 1e-6f;
constexpr int NWAVES = 8, NTHR = 512;

constexpr size_t MiB = 1u << 20;
constexpr size_t WS_CTL = 0, CTL_ZERO_BYTES = 1 * MiB;
constexpr size_t WS_MOD = 1 * MiB;
constexpr size_t WS_MODP = 2 * MiB;
constexpr size_t WS_AL = 18 * MiB;
constexpr size_t WS_W2T = 19 * MiB;
constexpr size_t WS_CS256 = 19 * MiB + 512 * 1024;
constexpr size_t WS_PE = 19 * MiB + 768 * 1024;
constexpr size_t WS_HCN = 18 * MiB + 512 * 1024;
constexpr size_t WS_CS4096 = 20 * MiB;
constexpr size_t WS_W1 = 84 * MiB;
constexpr size_t WS_TW = 116 * MiB;
constexpr size_t WS_WO = 180 * MiB;
constexpr size_t WS_WGLU = 196 * MiB;
constexpr size_t WS_WIN = 228 * MiB;
constexpr size_t WS_WOUT = 580 * MiB;
constexpr size_t WS_H = 756 * MiB;
constexpr size_t WS_ACT = 820 * MiB;
constexpr size_t WS_HT = 820 * MiB;
constexpr size_t WS_F = 948 * MiB;
constexpr size_t WS_S = 820 * MiB;
constexpr size_t WS_CC = 948 * MiB;
constexpr size_t WS_G = 1012 * MiB;
constexpr size_t WS_XH = 1076 * MiB;
constexpr size_t WS_SLOT = 1140 * MiB;
constexpr size_t WS_GS = 1147 * MiB;
constexpr size_t WS_END = 1148 * MiB;
constexpr int CW_PANEL = 196608;
constexpr int CW_BAR = 4096;

constexpr int STAGE_BYTES = 131072;
constexpr int MISC_OFF = STAGE_BYTES;
constexpr int LDS_BYTES = 147456;

namespace pg8 {
constexpr int BM = 256, BK = 64, HALF = 128, HTB = HALF * BK * 2, NXCD = 8, WGM = 4;
__host__ __device__ __forceinline__ int lds_byte(int r, int c) { const int st = (r >> 4) * 2 + (c >> 5), rr = r & 15, cc = c & 31, ob = rr * 64 + cc * 2; return st * 1024 + (ob ^ (((ob >> 9) & 1) << 5)); }
__host__ __device__ __forceinline__ void stage_rc(int b, int& R, int& C) { const int st = b / 1024, sb = b % 1024, swz = sb ^ (((sb >> 9) & 1) << 5); R = (st >> 1) * 16 + swz / 64; C = (st & 1) * 32 + (swz % 64) / 2; }
__host__ __device__ __forceinline__ int perm32(int rho) { const int n = rho >> 4, i = rho & 15; return 8 * (i >> 2) + 4 * n + (i & 3); }

struct Unit { int pm, pn, z; };

constexpr unsigned PLANE_B = 16384u * 32u;
template <bool GRP> struct Prob {
    const char* A; const char* A2; const char* B; int nt, ksplit; unsigned lda2, ldb2; size_t a_t, a_z, b_t, b_z; unsigned a_k, b_k;
    __device__ __forceinline__ const char* a_ptr(const Unit& u, int t) const { const char* p = (t < ksplit) ? A + (size_t)t * a_k : A2 + (size_t)(t - ksplit) * a_k; return p + (size_t)u.pm * a_t + (size_t)u.z * a_z; }
    __device__ __forceinline__ const char* b_ptr(const Unit& u, int t) const { return B + (size_t)t * b_k + (size_t)u.pn * b_t + (size_t)u.z * b_z; }
    __device__ __forceinline__ unsigned a_off(int R, int C) const { return GRP ? (unsigned)R * lda2 + (unsigned)(C >> 4) * PLANE_B + (unsigned)(C & 15) * 2u : (unsigned)R * lda2 + (unsigned)C * 2u; }
    __device__ __forceinline__ unsigned b_off(int R, int C) const { return (unsigned)R * ldb2 + (unsigned)C * 2u; }
};

struct ProbFA : Prob<false> {
    size_t b_m;
    __device__ __forceinline__ const char* b_ptr(const Unit& u, int t) const { return B + (size_t)t * b_k + (size_t)u.pn * b_t + (size_t)u.z * b_z + ((u.pn >= 32 && u.pm == 1) ? b_m : (size_t)0); }
};

struct StaticOrder {
    int nM, nN, nwg, G, c;
    __device__ void init(int M, int N, int G_, int c_) { nM = M / BM; nN = N / BM; nwg = nM * nN; G = G_; c = c_; }
    __device__ bool next(int i, Unit& u) const {
        const long L = (long)i * G + c; if (L >= nwg) return false;
        int wgid = (int)L; { const int q = nwg / NXCD, r = nwg % NXCD, xcd = wgid % NXCD, off = wgid / NXCD; wgid = (xcd < r ? xcd * (q + 1) : r * (q + 1) + (xcd - r) * q) + off; }
        const int nig = WGM * nN, gid = wgid / nig, fm = gid * WGM, gsz = (nM - fm) < WGM ? (nM - fm) : WGM;
        u.pm = fm + ((wgid % nig) % gsz); u.pn = (wgid % nig) / gsz; u.z = 0; return true;
    }
};

template <class P, class Epi, class Sched, bool ALIGN_EPI, bool SP2>
__device__ __forceinline__ void gemm_phase(LAS unsigned char* lds, const P& p, const Sched& S, const Epi& E) {
    int tid_ = threadIdx.x; asm volatile("" : "+v"(tid_));
    const int tid = tid_, wid = __builtin_amdgcn_readfirstlane(tid >> 6), lane = tid & 63, wr = wid >> 2, wc = wid & 3, fr = lane & 15, fq = lane >> 4;
    int nt = p.nt; asm volatile("" : "+s"(nt));
    unsigned voffA[2], voffB[2];
#pragma unroll
    for (int i = 0; i < 2; ++i) { int R, C; stage_rc(tid * 16 + i * 8192, R, C); const int Rb = Epi::PERM ? ((R & ~31) + perm32(R & 31)) : R;
        voffA[i] = p.a_off(R, C); voffB[i] = p.b_off(Rb, C); }
    const size_t ahs = (size_t)HALF * p.lda2, bhs = (size_t)HALF * p.ldb2;
    const unsigned ldsw = (unsigned)wid * 1024u;
    const int aoff = lds_byte(wr * 64 + fr, fq * 8), boff = lds_byte(wc * 32 + fr, fq * 8);
#define PG8_SA(b, h) (((b) * 2 + (h)) * HTB)
#define PG8_SB(b, h) ((4 + (b) * 2 + (h)) * HTB)
    const unsigned ldsb = (unsigned)(size_t)lds + ldsw;
#define PG8_STAGE(bufoff, gbase, voff) do { _Pragma("unroll") for (int _i = 0; _i < 2; ++_i) { const unsigned m0v_ = ldsb + (unsigned)((bufoff) + _i * 8192); \
        asm volatile("s_mov_b32 m0, %0\n\ts_nop 0\n\tglobal_load_lds_dwordx4 %1, %2" :: "s"(m0v_), "v"((voff)[_i]), "s"((const char*)(gbase)) : "memory", "m0"); } } while (0)
#define PG8_LDA(dst, b, h) do { _Pragma("unroll") for (int m = 0; m < 4; ++m) _Pragma("unroll") for (int k = 0; k < 2; ++k) dst[m][k] = *(const LAS f16x8*)(lds + PG8_SA(b, h) + aoff + m * 2048 + k * 1024); } while (0)
#define PG8_LDB(dst, b, h) do { _Pragma("unroll") for (int n = 0; n < 2; ++n) _Pragma("unroll") for (int k = 0; k < 2; ++k) dst[n][k] = *(const LAS f16x8*)(lds + PG8_SB(b, h) + boff + n * 2048 + k * 1024); } while (0)
#define PG8_MMA(ai, bj, At, Bt) do { __builtin_amdgcn_s_setprio(1); _Pragma("unroll") for (int m = 0; m < 4; ++m) _Pragma("unroll") for (int n = 0; n < 2; ++n) _Pragma("unroll") for (int k = 0; k < 2; ++k) \
        { if constexpr (Epi::BF16) acc[ai][bj][m][n] = __builtin_amdgcn_mfma_f32_16x16x32_bf16(__builtin_bit_cast(s16x8, Bt[n][k]), __builtin_bit_cast(s16x8, At[m][k]), acc[ai][bj][m][n], 0, 0, 0); \
          else acc[ai][bj][m][n] = __builtin_amdgcn_mfma_f32_16x16x32_f16(Bt[n][k], At[m][k], acc[ai][bj][m][n], 0, 0, 0); } __builtin_amdgcn_s_setprio(0); } while (0)
#define PG8_WAIT_V(n) asm volatile("s_waitcnt vmcnt(" #n ")" ::: "memory")
#define PG8_WAIT_L(n) asm volatile("s_waitcnt lgkmcnt(" #n ")" ::: "memory")
#define PG8_BAR __builtin_amdgcn_s_barrier()
#define PG8_SCHED __builtin_amdgcn_sched_barrier(0)
    Unit cur, nxt; int ui = 0;
    if (!S.next(0, cur)) return;
    f32x4 acc[2][2][4][2];
#pragma unroll
    for (int a = 0; a < 2; ++a)
#pragma unroll
        for (int b = 0; b < 2; ++b)
#pragma unroll
            for (int m = 0; m < 4; ++m)
#pragma unroll
                for (int n = 0; n < 2; ++n) acc[a][b][m][n] = (f32x4){0.f, 0.f, 0.f, 0.f};
    f16x8 At[4][2], B0[2][2], B1[2][2];
    {
        const char* cA0 = p.a_ptr(cur, 0); const char* cB0 = p.b_ptr(cur, 0); const char* cA1 = p.a_ptr(cur, 1); const char* cB1 = p.b_ptr(cur, 1);
        if constexpr (SP2) {
            PG8_STAGE(PG8_SB(0, 0), cB0, voffB); PG8_STAGE(PG8_SB(0, 1), cB0 + bhs, voffB); PG8_STAGE(PG8_SA(0, 0), cA0, voffA); PG8_STAGE(PG8_SA(0, 1), cA0 + ahs, voffA);
            if (wr == 1) PG8_BAR;
            PG8_WAIT_V(2); PG8_BAR;
            PG8_STAGE(PG8_SB(1, 0), cB1, voffB); PG8_STAGE(PG8_SA(1, 0), cA1, voffA); PG8_STAGE(PG8_SB(1, 1), cB1 + bhs, voffB);
            PG8_WAIT_V(6); PG8_BAR;
        } else {
            PG8_STAGE(PG8_SB(0, 0), cB0, voffB); PG8_STAGE(PG8_SA(0, 0), cA0, voffA); PG8_STAGE(PG8_SB(0, 1), cB0 + bhs, voffB); PG8_STAGE(PG8_SA(0, 1), cA0 + ahs, voffA);
            if (wr == 1) PG8_BAR;
            PG8_WAIT_V(4); PG8_BAR;
            PG8_STAGE(PG8_SB(1, 0), cB1, voffB); PG8_STAGE(PG8_SA(1, 0), cA1, voffA); PG8_STAGE(PG8_SB(1, 1), cB1 + bhs, voffB);
            PG8_WAIT_V(6); PG8_BAR;
        }
    }
    for (;;) {
        const bool has_next = S.next(ui + 1, nxt);
        const Unit nu = has_next ? nxt : cur;
#pragma nounroll
        for (int t = 0; t < nt; t += 2) {
            const bool last = (t == nt - 2);
            const char* a1 = p.a_ptr(cur, t + 1);
            const char* a2 = last ? p.a_ptr(nu, 0) : p.a_ptr(cur, t + 2); const char* b2 = last ? p.b_ptr(nu, 0) : p.b_ptr(cur, t + 2);
            const char* a3 = last ? p.a_ptr(nu, 1) : p.a_ptr(cur, t + 3); const char* b3 = last ? p.b_ptr(nu, 1) : p.b_ptr(cur, t + 3);
            if constexpr (SP2) {
            PG8_LDB(B0, 0, 0); PG8_LDB(B1, 0, 1); PG8_SCHED; PG8_LDA(At, 0, 0); PG8_STAGE(PG8_SA(1, 1), a1 + ahs, voffA);
            PG8_WAIT_V(8); PG8_WAIT_L(0); PG8_BAR; PG8_MMA(0, 0, At, B0); PG8_MMA(0, 1, At, B1); PG8_BAR; PG8_SCHED;
            PG8_LDA(At, 0, 1); PG8_STAGE(PG8_SB(0, 0), b2, voffB); PG8_STAGE(PG8_SB(0, 1), b2 + bhs, voffB); PG8_STAGE(PG8_SA(0, 0), a2, voffA);
            PG8_WAIT_V(8); PG8_WAIT_L(0); PG8_BAR; PG8_MMA(1, 0, At, B0); PG8_MMA(1, 1, At, B1); PG8_BAR; PG8_SCHED;
            PG8_LDB(B0, 1, 0); PG8_LDB(B1, 1, 1); PG8_SCHED; PG8_LDA(At, 1, 0); PG8_STAGE(PG8_SA(0, 1), a2 + ahs, voffA);
            PG8_WAIT_V(8); PG8_WAIT_L(0); PG8_BAR; PG8_MMA(0, 0, At, B0); PG8_MMA(0, 1, At, B1); PG8_BAR; PG8_SCHED;
            PG8_LDA(At, 1, 1); PG8_STAGE(PG8_SB(1, 0), b3, voffB); PG8_STAGE(PG8_SB(1, 1), b3 + bhs, voffB); PG8_STAGE(PG8_SA(1, 0), a3, voffA);
            PG8_WAIT_V(8); PG8_WAIT_L(0); PG8_BAR; PG8_MMA(1, 0, At, B0); PG8_MMA(1, 1, At, B1); PG8_BAR; PG8_SCHED;
            } else {
            PG8_LDB(B0, 0, 0); PG8_SCHED; PG8_LDA(At, 0, 0); PG8_STAGE(PG8_SA(1, 1), a1 + ahs, voffA);
            PG8_WAIT_L(8); PG8_BAR; PG8_WAIT_L(0); PG8_MMA(0, 0, At, B0); PG8_BAR; PG8_SCHED;
            PG8_LDB(B1, 0, 1); PG8_STAGE(PG8_SB(0, 0), b2, voffB);
            PG8_BAR; PG8_WAIT_L(0); PG8_MMA(0, 1, At, B1); PG8_BAR;
            PG8_LDA(At, 0, 1); PG8_STAGE(PG8_SA(0, 0), a2, voffA);
            PG8_BAR; PG8_WAIT_L(0); PG8_MMA(1, 0, At, B0); PG8_BAR; PG8_SCHED;
            PG8_STAGE(PG8_SB(0, 1), b2 + bhs, voffB);
            PG8_WAIT_V(6); PG8_BAR; PG8_MMA(1, 1, At, B1); PG8_BAR;
            PG8_LDB(B0, 1, 0); PG8_SCHED; PG8_LDA(At, 1, 0); PG8_STAGE(PG8_SA(0, 1), a2 + ahs, voffA);
            PG8_WAIT_L(8); PG8_BAR; PG8_WAIT_L(0); PG8_MMA(0, 0, At, B0); PG8_BAR; PG8_SCHED;
            PG8_LDB(B1, 1, 1); PG8_STAGE(PG8_SB(1, 0), b3, voffB);
            PG8_BAR; PG8_WAIT_L(0); PG8_MMA(0, 1, At, B1); PG8_BAR;
            PG8_LDA(At, 1, 1); PG8_STAGE(PG8_SA(1, 0), a3, voffA);
            PG8_BAR; PG8_WAIT_L(0); PG8_MMA(1, 0, At, B0); PG8_BAR; PG8_SCHED;
            PG8_STAGE(PG8_SB(1, 1), b3 + bhs, voffB);
            PG8_WAIT_V(6); PG8_BAR; PG8_MMA(1, 1, At, B1); PG8_BAR;
            }
        }
        if constexpr (ALIGN_EPI) { if (wr == 0) PG8_BAR; }
        E(acc, cur, wr, wc, fr, fq);
        if (!has_next) break;
#pragma unroll
        for (int a = 0; a < 2; ++a)
#pragma unroll
            for (int b = 0; b < 2; ++b)
#pragma unroll
                for (int m = 0; m < 4; ++m)
#pragma unroll
                    for (int n = 0; n < 2; ++n) acc[a][b][m][n] = (f32x4){0.f, 0.f, 0.f, 0.f};
        cur = nxt; ++ui;
        if constexpr (ALIGN_EPI) { if (wr == 1) PG8_BAR; }
    }
    PG8_WAIT_V(0);
    if constexpr (!ALIGN_EPI) { if (wr == 0) PG8_BAR; }
    PG8_BAR;
#undef PG8_SA
#undef PG8_SB
#undef PG8_STAGE
#undef PG8_LDA
#undef PG8_LDB
#undef PG8_MMA
#undef PG8_WAIT_V
#undef PG8_WAIT_L
#undef PG8_BAR
#undef PG8_SCHED
}
}
using pg8::Unit;

#define RLX_AGENT __ATOMIC_RELAXED, __HIP_MEMORY_SCOPE_AGENT
#define LDS_WAIT() asm volatile("s_waitcnt lgkmcnt(0)" ::: "memory")
#define VM_WAIT() asm volatile("s_waitcnt vmcnt(0)" ::: "memory")
__device__ __forceinline__ unsigned pk2h_(float lo, float hi) { f32x2 v = {lo, hi}; f16x2 h = __builtin_convertvector(v, f16x2); return __builtin_bit_cast(unsigned, h); }
__device__ __forceinline__ unsigned pk2b(float lo, float hi) { f32x2 v = {lo, hi}; bf16x2_t b = __builtin_convertvector(v, bf16x2_t); return __builtin_bit_cast(unsigned, b); }
#ifndef FFN_BF16
#define FFN_BF16 1
#endif
__device__ __forceinline__ unsigned pk2x(float lo, float hi, bool bf) { return bf ? pk2b(lo, hi) : pk2h_(lo, hi); }
__device__ __forceinline__ unsigned pk2h(float lo, float hi) { f32x2 v = {lo, hi}; f16x2 h = __builtin_convertvector(v, f16x2); return __builtin_bit_cast(unsigned, h); }
__device__ __forceinline__ float wave_sum(float v, int lane) {
#pragma unroll
    for (int o = 1; o < 64; o <<= 1) v += __builtin_bit_cast(float, __builtin_amdgcn_ds_bpermute((lane ^ o) << 2, __builtin_bit_cast(int, v)));
    return v;
}
__device__ __forceinline__ float sigmoid_f(float x) { return __builtin_amdgcn_rcpf(1.0f + __builtin_amdgcn_exp2f(-1.4426950408889634f * x)); }
__device__ __forceinline__ float gelu_tanh_f(float x) {
    const float u2 = 1.5957691216057308f * (x + 0.044715f * x * x * x);
    return x * sigmoid_f(u2);
}
__device__ __forceinline__ int cond_of_panel(int pm) { return pm < 32 ? 0 : (pm < 48 ? 1 : 2); }

#define XB_TMO      128
#define XB_XCNT(j)  (256  + 64 * (j))
#define XB_XSUB(j)  (1280 + 64 * (j))
#define XB_XGEN(j)  (2304 + 64 * (j))
#define XB_TOP      3328
#define XB_TOPGEN   3392
#define XCD_BAR_WORDS 3456
#define XB_SPIN_CAP (1u << 18)
__device__ __forceinline__ unsigned xb_ld(unsigned* p)              { return __hip_atomic_load(p, __ATOMIC_RELAXED, __HIP_MEMORY_SCOPE_AGENT); }
__device__ __forceinline__ unsigned xb_add(unsigned* p, unsigned v) { return __hip_atomic_fetch_add(p, v, __ATOMIC_RELAXED, __HIP_MEMORY_SCOPE_AGENT); }
__device__ __forceinline__ unsigned xb_xcc_id() { return (unsigned)__builtin_amdgcn_s_getreg((3 << 11) | 20) & 0xFu; }
#define XB_SPIN(cond, bar) do { unsigned _sp = 0; while (cond) { __builtin_amdgcn_s_sleep(1); \
    if ((++_sp & 255u) == 0u) { if (xb_ld(&(bar)[XB_TMO])) break; if (_sp > XB_SPIN_CAP) { atomicAdd(&(bar)[XB_TMO], 1u); break; } } } } while (0)
struct XcdBarrier { unsigned* bar; unsigned x; volatile LAS unsigned* st; };
__device__ __forceinline__ XcdBarrier xcd_barrier_post(unsigned* bar, volatile LAS unsigned* st) {
    XcdBarrier b; b.bar = bar; b.x = xb_xcc_id(); b.st = st;
    if (threadIdx.x == 0) st[4] = xb_add(&bar[XB_XCNT(b.x)], 1u);
    return b;
}
__device__ __forceinline__ void xcd_barrier_complete(unsigned* bar, unsigned x, unsigned& nloc, unsigned& nx, unsigned& even32) {
    const unsigned G = gridDim.x * gridDim.y * gridDim.z;
    unsigned sum, cnt, mine, sp = 0u;
    for (;;) {
        sum = 0u; cnt = 0u; mine = 0u;
        unsigned n32 = 0u;
#pragma unroll
        for (unsigned j = 0; j < 16; ++j) { const unsigned c = xb_ld(&bar[XB_XCNT(j)]); sum += c; cnt += (c > 0u) ? 1u : 0u; n32 += (c == 32u && j < 8u) ? 1u : 0u; mine = (j == x) ? c : mine; }
        even32 = (n32 == 8u && sum == 256u) ? 1u : 0u;
        if (sum == G) break;
        __builtin_amdgcn_s_sleep(1);
        if ((++sp & 255u) == 0u) { if (xb_ld(&bar[XB_TMO])) break; if (sp > XB_SPIN_CAP) { atomicAdd(&bar[XB_TMO], 1u); break; } }
    }
    nloc = mine > 0u ? mine : 1u; nx = cnt > 0u ? cnt : 1u;
}
__device__ __forceinline__ void xcd_barrier(const XcdBarrier& b, bool local = false) {
    asm volatile("s_waitcnt vmcnt(0)" ::: "memory");
    __syncthreads();
    if (threadIdx.x == 0) {
        unsigned* bar = b.bar;
        __builtin_amdgcn_s_waitcnt(0);
        unsigned nloc = b.st[0], nx = b.st[1];
        if (nloc == 0u) { unsigned e32; xcd_barrier_complete(bar, b.x, nloc, nx, e32); b.st[0] = nloc; b.st[1] = nx; b.st[2] = e32; }
        const unsigned old = xb_add(&bar[XB_XSUB(b.x)], 1u);
        const unsigned gen = old / nloc;
        if (old + 1u == (gen + 1u) * nloc) {
            if (!local) {
                __builtin_amdgcn_fence(__ATOMIC_RELEASE, "agent");
                asm volatile("s_waitcnt vmcnt(0)" ::: "memory");
                const unsigned og = xb_add(&bar[XB_TOP], 1u);
                const unsigned tg = og / nx;
                if (og + 1u == (tg + 1u) * nx) xb_add(&bar[XB_TOPGEN], 1u);
                else XB_SPIN(xb_ld(&bar[XB_TOPGEN]) == tg, bar);
            }
            __builtin_amdgcn_fence(__ATOMIC_ACQUIRE, "agent");
            xb_add(&bar[XB_XGEN(b.x)], 1u);
            asm volatile("s_waitcnt vmcnt(0)" ::: "memory");
        } else {
            XB_SPIN(xb_ld(&bar[XB_XGEN(b.x)]) == gen, bar);
            __builtin_amdgcn_fence(__ATOMIC_ACQUIRE, "agent");
            asm volatile("s_waitcnt vmcnt(0)" ::: "memory");
        }
    }
    __syncthreads();
}

struct Args {
    const float* x_prompt; const float* x_sample; const float* state_ssm; const float* c; const float* c_ctx;
    const float* w_ada; const float* b_ada; const float* norm_g; const float* ffn_w_in; const float* ffn_w_out;
    const float* fourier_w_o; const float* ssm_a_re; const float* ssm_a_im; const float* ssm_log_dt;
    const float* ssm_b; const float* ssm_c; const float* ssm_d; const float* ssm_w_glu; const float* final_g;
    float* out; unsigned char* ws; int ph_lo, ph_hi;
};
struct Frame {
    LAS unsigned char* lds; int tid, lane, wave, vcu, G, bx;
};

#define GL4S(dst, voff, sbase, off) "global_load_dwordx4 %" #dst ", %" #voff ", %" #sbase " offset:" #off "\n\t"
__device__ __forceinline__ void load_resid_tile(u32x4 (&x)[8][2], f32x4 (&g)[4], const f16* xb, unsigned o0, unsigned o1, unsigned o2, unsigned o3, unsigned o4, unsigned o5, unsigned o6, unsigned o7, const float* mb, unsigned om) {
    asm volatile(GL4S(0, 20, 29, 0) GL4S(1, 20, 29, 256) GL4S(2, 21, 29, 0) GL4S(3, 21, 29, 256) GL4S(4, 22, 29, 0) GL4S(5, 22, 29, 256) GL4S(6, 23, 29, 0) GL4S(7, 23, 29, 256)
                 GL4S(8, 24, 29, 0) GL4S(9, 24, 29, 256) GL4S(10, 25, 29, 0) GL4S(11, 25, 29, 256) GL4S(12, 26, 29, 0) GL4S(13, 26, 29, 256) GL4S(14, 27, 29, 0) GL4S(15, 27, 29, 256)
                 GL4S(16, 28, 30, 0) GL4S(17, 28, 30, 16) GL4S(18, 28, 30, 512) GL4S(19, 28, 30, 528)
                 "s_waitcnt vmcnt(0)"
                 : "=&v"(x[0][0]), "=&v"(x[0][1]), "=&v"(x[1][0]), "=&v"(x[1][1]), "=&v"(x[2][0]), "=&v"(x[2][1]), "=&v"(x[3][0]), "=&v"(x[3][1]),
                   "=&v"(x[4][0]), "=&v"(x[4][1]), "=&v"(x[5][0]), "=&v"(x[5][1]), "=&v"(x[6][0]), "=&v"(x[6][1]), "=&v"(x[7][0]), "=&v"(x[7][1]),
                   "=&v"(g[0]), "=&v"(g[1]), "=&v"(g[2]), "=&v"(g[3])
                 : "v"(o0), "v"(o1), "v"(o2), "v"(o3), "v"(o4), "v"(o5), "v"(o6), "v"(o7), "v"(om), "s"(xb), "s"(mb) : "memory");
}
__device__ __forceinline__ void load_resid_tile1(u32x4 (&x)[8], f32x4 (&g)[2], const f16* xb, unsigned o0, unsigned o1, unsigned o2, unsigned o3, unsigned o4, unsigned o5, unsigned o6, unsigned o7, const float* mb, unsigned om) {
    asm volatile(GL4S(0, 10, 19, 0) GL4S(1, 11, 19, 0) GL4S(2, 12, 19, 0) GL4S(3, 13, 19, 0) GL4S(4, 14, 19, 0) GL4S(5, 15, 19, 0) GL4S(6, 16, 19, 0) GL4S(7, 17, 19, 0)
                 GL4S(8, 18, 20, 0) GL4S(9, 18, 20, 16)
                 "s_waitcnt vmcnt(0)"
                 : "=&v"(x[0]), "=&v"(x[1]), "=&v"(x[2]), "=&v"(x[3]), "=&v"(x[4]), "=&v"(x[5]), "=&v"(x[6]), "=&v"(x[7]), "=&v"(g[0]), "=&v"(g[1])
                 : "v"(o0), "v"(o1), "v"(o2), "v"(o3), "v"(o4), "v"(o5), "v"(o6), "v"(o7), "v"(om), "s"(xb), "s"(mb) : "memory");
}
__device__ __forceinline__ void load_vec8(f32x4 (&g)[4], f32x4 (&s)[4], const float* ga, const float* sa, unsigned om) {
    asm volatile(GL4S(0, 8, 9, 0) GL4S(1, 8, 9, 16) GL4S(2, 8, 9, 512) GL4S(3, 8, 9, 528)
                 GL4S(4, 8, 10, 0) GL4S(5, 8, 10, 16) GL4S(6, 8, 10, 512) GL4S(7, 8, 10, 528)
                 "s_waitcnt vmcnt(0)"
                 : "=&v"(g[0]), "=&v"(g[1]), "=&v"(g[2]), "=&v"(g[3]), "=&v"(s[0]), "=&v"(s[1]), "=&v"(s[2]), "=&v"(s[3])
                 : "v"(om), "s"(ga), "s"(sa) : "memory");
}
__device__ __forceinline__ f32x2 h2f(unsigned u) { const f16x2 h = __builtin_bit_cast(f16x2, u); return (f32x2){(float)h[0], (float)h[1]}; }

struct EpiSwiGLU {
    static constexpr bool PERM = true, BF16 = (FFN_BF16 != 0);
    f16* O;
    __device__ __forceinline__ void operator()(const f32x4 (&acc)[2][2][4][2], const Unit& u, int wr, int wc, int fr, int fq) const {
        const int rip = wr * 64 + fr, col0 = u.pn * 128 + wc * 32 + 8 * fq;
#pragma unroll
        for (int ai = 0; ai < 2; ++ai)
#pragma unroll
            for (int m = 0; m < 4; ++m) {
                const f32x4 g0 = acc[ai][0][m][0], g1 = acc[ai][0][m][1], u0 = acc[ai][1][m][0], u1 = acc[ai][1][m][1];
                float r[8];
#pragma unroll
                for (int j = 0; j < 4; ++j) { r[j] = g0[j] * sigmoid_f(g0[j]) * u0[j]; r[4 + j] = g1[j] * sigmoid_f(g1[j]) * u1[j]; }
                u32x4 w; w.x = pk2x(r[0], r[1], BF16); w.y = pk2x(r[2], r[3], BF16); w.z = pk2x(r[4], r[5], BF16); w.w = pk2x(r[6], r[7], BF16);
                *(u32x4*)(O + ((size_t)u.pm * (DFF / 64) + (col0 >> 6)) * 16384 + (size_t)(rip + ai * 128 + m * 16) * 64 + (col0 & 63)) = w;
            }
    }
};
template <bool BF> struct EpiResidT {
    static constexpr bool PERM = true, BF16 = BF;
    f16* X; const float* modv; float coef;
    __device__ __forceinline__ void operator()(const f32x4 (&acc)[2][2][4][2], const Unit& u, int wr, int wc, int fr, int fq) const {
        const int row0 = u.pm * 256 + wr * 64 + fr, col0 = u.pn * 256 + wc * 32 + 8 * fq;
        const float* mb = modv + (size_t)cond_of_panel(u.pm) * (NMOD * D);
        const unsigned e0 = (unsigned)row0 * D + col0;
#define EO(r) (e0 + (unsigned)((((r) >> 2) * 128 + ((r) & 3) * 16) * D))
        u32x4 x[8][2]; f32x4 gv[4];
        load_resid_tile(x, gv, X, EO(0) * 2u, EO(1) * 2u, EO(2) * 2u, EO(3) * 2u, EO(4) * 2u, EO(5) * 2u, EO(6) * 2u, EO(7) * 2u, mb, (unsigned)col0 * 4u);
#pragma unroll
        for (int i = 0; i < 4; ++i) gv[i] = gv[i] * coef;
#pragma unroll
        for (int ai = 0; ai < 2; ++ai)
#pragma unroll
            for (int m = 0; m < 4; ++m)
#pragma unroll
                for (int bj = 0; bj < 2; ++bj) { const u32x4 xv = x[ai * 4 + m][bj];
                    const f32x2 a0 = h2f(xv.x), a1 = h2f(xv.y), a2 = h2f(xv.z), a3 = h2f(xv.w);
                    const f32x4 v0 = (f32x4){a0.x, a0.y, a1.x, a1.y} + gv[2 * bj] * acc[ai][bj][m][0], v1 = (f32x4){a2.x, a2.y, a3.x, a3.y} + gv[2 * bj + 1] * acc[ai][bj][m][1];
                    u32x4 w; w.x = pk2h(v0[0], v0[1]); w.y = pk2h(v0[2], v0[3]); w.z = pk2h(v1[0], v1[1]); w.w = pk2h(v1[2], v1[3]);
                    *(u32x4*)(X + EO(ai * 4 + m) + bj * 128) = w; }
#undef EO
    }
};
template <bool BF, int MODE, int CNUM, int CDEN> struct EpiResidNormT {
    static constexpr bool PERM = true, BF16 = BF; static constexpr float coef = (float)CNUM / (float)CDEN;
    unsigned char* ws; float* out; const float* modv; const float* fg; int inst, tl, tj; LAS unsigned char* lt;
    __device__ __forceinline__ void operator()(f32x4 (&acc)[2][2][4][2], const Unit& u, int wr, int wc, int fr, int fq) const {
        f16* X = (f16*)(ws + WS_XH);
        const int cond = cond_of_panel(u.pm), rt = wr * 64 + fr, lane = fq * 16 + fr, wid = wr * 4 + wc;
        const int row0 = u.pm * 256 + rt, col0 = u.pn * 256 + wc * 32 + 8 * fq;
        const float* mb = modv + (size_t)cond * (NMOD * D);
        const unsigned e0 = (unsigned)row0 * D + col0;
#define EO(r) (e0 + (unsigned)((((r) >> 2) * 128 + ((r) & 3) * 16) * D))
        float ps[8];
        {
            u32x4 x[8][2]; f32x4 gv[4];
            load_resid_tile(x, gv, X, EO(0) * 2u, EO(1) * 2u, EO(2) * 2u, EO(3) * 2u, EO(4) * 2u, EO(5) * 2u, EO(6) * 2u, EO(7) * 2u, mb, (unsigned)col0 * 4u);
#pragma unroll
            for (int i = 0; i < 4; ++i) gv[i] = gv[i] * coef;
#pragma unroll
            for (int ai = 0; ai < 2; ++ai)
#pragma unroll
                for (int m = 0; m < 4; ++m) { float s = 0.f;
#pragma unroll
                    for (int bj = 0; bj < 2; ++bj) { const u32x4 xv = x[ai * 4 + m][bj];
                        const f32x2 a0 = h2f(xv.x), a1 = h2f(xv.y), a2 = h2f(xv.z), a3 = h2f(xv.w);
                        const f32x4 v0 = (f32x4){a0.x, a0.y, a1.x, a1.y} + gv[2 * bj] * acc[ai][bj][m][0], v1 = (f32x4){a2.x, a2.y, a3.x, a3.y} + gv[2 * bj + 1] * acc[ai][bj][m][1];
                        acc[ai][bj][m][0] = v0; acc[ai][bj][m][1] = v1;
                        const f32x4 q0 = v0 * v0, q1 = v1 * v1; s += ((q0[0] + q0[1]) + (q0[2] + q0[3])) + ((q1[0] + q1[1]) + (q1[2] + q1[3])); }
                    ps[ai * 4 + m] = s; }
        }
        LAS float* P = (LAS float*)lt; LAS float* S = (LAS float*)(lt + 4096);
#pragma unroll
        for (int r = 0; r < 8; ++r) { float s = ps[r];
            s += __builtin_bit_cast(float, __builtin_amdgcn_ds_bpermute((lane ^ 16) << 2, __builtin_bit_cast(int, s)));
            s += __builtin_bit_cast(float, __builtin_amdgcn_ds_bpermute((lane ^ 32) << 2, __builtin_bit_cast(int, s)));
            if (fq == 0) P[(rt + (r >> 2) * 128 + (r & 3) * 16) * 4 + wc] = s; }
        asm volatile("s_waitcnt lgkmcnt(0)" ::: "memory"); __builtin_amdgcn_s_barrier(); asm volatile("" ::: "memory");
        const int prow = wid * 32 + (lane & 31);
        unsigned long long* slots = (unsigned long long*)(ws + WS_SLOT) + (size_t)u.pm * 2048;
        const unsigned tag = (unsigned)inst + 1u;
        if (lane < 32) { const f32x4 p4 = *(const LAS f32x4*)(P + prow * 4);
            const float sm = (p4[0] + p4[1]) + (p4[2] + p4[3]);
            __hip_atomic_store(slots + u.pn * 256 + prow, ((unsigned long long)tag << 32) | (unsigned long long)__builtin_bit_cast(unsigned, sm), __ATOMIC_RELAXED, __HIP_MEMORY_SCOPE_AGENT); }
        { float t = 0.f; unsigned spins = 0;
            for (;;) { bool ok = true; t = 0.f;
#pragma unroll
                for (int k = 0; k < 8; ++k) { const unsigned long long g = __hip_atomic_load(slots + k * 256 + prow, __ATOMIC_RELAXED, __HIP_MEMORY_SCOPE_AGENT);
                    ok = ok && ((unsigned)(g >> 32) == tag); t += __builtin_bit_cast(float, (unsigned)g); }
                if (__builtin_amdgcn_ballot_w64(!ok) == 0ull) break;
                if (++spins > 20000u) break;
                __builtin_amdgcn_s_sleep(2); }
            if (lane < 32) S[prow] = 1.0f / sqrtf(t * (1.0f / D) + RMS_EPS); }
        asm volatile("s_waitcnt vmcnt(0) lgkmcnt(0)" ::: "memory"); __builtin_amdgcn_s_barrier(); asm volatile("" ::: "memory");
        const LAS float* V = (const LAS float*)(lt + 5120);
        const int cl = wc * 32 + 8 * fq;
#pragma unroll
        for (int bj = 0; bj < 2; ++bj) {
            const f32x4 g0 = *(const LAS f32x4*)(V + cl + bj * 128), g1 = *(const LAS f32x4*)(V + cl + bj * 128 + 4);
            const f32x4 s0 = *(const LAS f32x4*)(V + 256 + cl + bj * 128), s1 = *(const LAS f32x4*)(V + 256 + cl + bj * 128 + 4);
#pragma unroll
            for (int ai = 0; ai < 2; ++ai)
#pragma unroll
                for (int m = 0; m < 4; ++m) { const float rstd = S[rt + ai * 128 + m * 16];
                    if (MODE != 2) { const f32x4 v0 = acc[ai][bj][m][0], v1 = acc[ai][bj][m][1];
                        u32x4 w; w.x = pk2h(v0[0], v0[1]); w.y = pk2h(v0[2], v0[3]); w.z = pk2h(v1[0], v1[1]); w.w = pk2h(v1[2], v1[3]); *(u32x4*)(X + EO(ai * 4 + m) + bj * 128) = w; }
                    f32x4 h0 = acc[ai][bj][m][0] * rstd * g0, h1 = acc[ai][bj][m][1] * rstd * g1;
                    if (MODE != 2) { h0 = h0 + s0; h1 = h1 + s1; }
                    if (MODE == 0) { constexpr bool OB = (FFN_BF16 != 0);
                        u32x4 w; w.x = pk2x(h0[0], h0[1], OB); w.y = pk2x(h0[2], h0[3], OB); w.z = pk2x(h1[0], h1[1], OB); w.w = pk2x(h1[2], h1[3], OB);
                        *(u32x4*)((f16*)(ws + WS_H) + EO(ai * 4 + m) + bj * 128) = w; }
                    else if (MODE == 1) { const int c = col0 + bj * 128, tok = u.pm * 256 + rt + ai * 128 + m * 16;
                        u32x4 w; w.x = pk2h(h0[0], h0[1]); w.y = pk2h(h0[2], h0[3]); w.z = pk2h(h1[0], h1[1]); w.w = pk2h(h1[2], h1[3]);
                        *(u32x4*)((f16*)(ws + WS_H) + (size_t)(c >> 4) * (MTOK * 16) + (size_t)tok * 16 + ((c >> 3) & 1) * 8) = w; }
                    else { float* o = out + EO(ai * 4 + m) + bj * 128; *(f32x4*)o = h0; *(f32x4*)(o + 4) = h1; } }
        }
#undef EO
    }
};
__device__ __forceinline__ void fused_norm_vectors(unsigned char* ws, const float* fg, LAS unsigned char* lt, const pg8::StaticOrder& S, int tl, int tj, bool mode2, int tid) {
    Unit u0; if (!S.next(0, u0)) return;
    const int cond = cond_of_panel(u0.pm);
    LAS float* V = (LAS float*)(lt + 5120);
    if (tid < 256) { const int col = u0.pn * 256 + tid;
        V[tid] = mode2 ? fg[col] : ((const float*)(ws + WS_GS))[((size_t)(tl * 3 + tj) * 3 + cond) * D + col];
        V[256 + tid] = mode2 ? 0.f : ((const float*)(ws + WS_MOD))[((size_t)(tl * 3 + cond) * NMOD + 3 * tj) * D + col]; }
    __syncthreads();
}
struct EpiGLUResid {
    static constexpr bool PERM = true, BF16 = (FFN_BF16 != 0);
    f16* X; const float* modv; float coef;
    __device__ __forceinline__ void operator()(const f32x4 (&acc)[2][2][4][2], const Unit& u, int wr, int wc, int fr, int fq) const {
        const int row0 = u.pm * 256 + wr * 64 + fr, col0 = u.pn * 128 + wc * 32 + 8 * fq;
        const float* mb = modv + (size_t)cond_of_panel(u.pm) * (NMOD * D);
        const unsigned e0 = (unsigned)row0 * D + col0;
#define EO(r) (e0 + (unsigned)((((r) >> 2) * 128 + ((r) & 3) * 16) * D))
        u32x4 x[8]; f32x4 mm[2];
        load_resid_tile1(x, mm, X, EO(0) * 2u, EO(1) * 2u, EO(2) * 2u, EO(3) * 2u, EO(4) * 2u, EO(5) * 2u, EO(6) * 2u, EO(7) * 2u, mb, (unsigned)col0 * 4u);
        const f32x4 m0 = mm[0] * coef, m1 = mm[1] * coef;
#pragma unroll
        for (int ai = 0; ai < 2; ++ai)
#pragma unroll
            for (int m = 0; m < 4; ++m) {
                const f32x4 v0 = acc[ai][0][m][0], v1 = acc[ai][0][m][1], g0 = acc[ai][1][m][0], g1 = acc[ai][1][m][1];
                f32x4 o0, o1;
#pragma unroll
                for (int j = 0; j < 4; ++j) { o0[j] = v0[j] * sigmoid_f(g0[j]); o1[j] = v1[j] * sigmoid_f(g1[j]); }
                const u32x4 xv = x[ai * 4 + m]; const f32x2 a0 = h2f(xv.x), a1 = h2f(xv.y), a2 = h2f(xv.z), a3 = h2f(xv.w);
                const f32x4 n0 = (f32x4){a0.x, a0.y, a1.x, a1.y} + m0 * o0, n1 = (f32x4){a2.x, a2.y, a3.x, a3.y} + m1 * o1;
                u32x4 w; w.x = pk2h(n0[0], n0[1]); w.y = pk2h(n0[2], n0[3]); w.z = pk2h(n1[0], n1[1]); w.w = pk2h(n1[2], n1[3]);
                *(u32x4*)(X + EO(ai * 4 + m)) = w; }
#undef EO
    }
};
struct EpiFA {
    static constexpr bool PERM = true, BF16 = false;
    f16* HT;
    __device__ __forceinline__ void operator()(const f32x4 (&acc)[2][2][4][2], const Unit& u, int wr, int wc, int fr, int fq) const {
        const int P = u.pn; const int n = P < 32 ? SEQ_P : SEQ_S / 2;
        const size_t hb = P < 32 ? (size_t)P * (D * 2 * SEQ_P) : (size_t)NB_P * (D * 2 * SEQ_P) + (size_t)((P - 32) >> 4) * ((size_t)D * SEQ_S);
        const int t0 = (P < 32 ? 0 : ((P - 32) & 15) * 256) + wc * 32 + 8 * fq;
        const int q0 = wr * 64 + fr;
#pragma unroll
        for (int ai = 0; ai < 2; ++ai)
#pragma unroll
            for (int m = 0; m < 4; ++m) { const int q = q0 + ai * 128 + m * 16;
                f16* rowp = HT + hb + ((size_t)(u.z * 256 + q) * 2 + u.pm) * n + t0;
#pragma unroll
                for (int bj = 0; bj < 2; ++bj) { const f32x4 v0 = acc[ai][bj][m][0], v1 = acc[ai][bj][m][1];
                    u32x4 w; w.x = pk2h(v0[0], v0[1]); w.y = pk2h(v0[2], v0[3]); w.z = pk2h(v1[0], v1[1]); w.w = pk2h(v1[2], v1[3]);
                    *(u32x4*)(rowp + bj * 128) = w; } }
    }
};
struct EpiFB {
    static constexpr bool PERM = true, BF16 = false;
    f16* F; int row0, zrows; float scale; const float* hcn;
    __device__ __forceinline__ void operator()(const f32x4 (&acc)[2][2][4][2], const Unit& u, int wr, int wc, int fr, int fq) const {
        const int r0 = row0 + u.z * zrows + u.pm * 256 + wr * 64 + fr, col0 = u.pn * 256 + wc * 32 + 8 * fq;
        f32x4 nq[2][2];
#pragma unroll
        for (int bj = 0; bj < 2; ++bj)
#pragma unroll
            for (int n = 0; n < 2; ++n) { nq[bj][n] = (f32x4){0.f, 0.f, 0.f, 0.f};
                if (hcn) { const f32x4 h = *(const f32x4*)(hcn + (size_t)u.z * D + col0 + bj * 128 + n * 4); nq[bj][n] = (fr & 1) ? -h : h; } }
#pragma unroll
        for (int ai = 0; ai < 2; ++ai)
#pragma unroll
            for (int m = 0; m < 4; ++m) { f16* rowp = F + (size_t)(r0 + ai * 128 + m * 16) * D + col0;
#pragma unroll
                for (int bj = 0; bj < 2; ++bj) { const f32x4 v0 = (acc[ai][bj][m][0] + nq[bj][0]) * scale, v1 = (acc[ai][bj][m][1] + nq[bj][1]) * scale;
                    constexpr bool OB = (FFN_BF16 != 0);
                    u32x4 w; w.x = pk2x(v0[0], v0[1], OB); w.y = pk2x(v0[2], v0[3], OB); w.z = pk2x(v1[0], v1[1], OB); w.w = pk2x(v1[2], v1[3], OB);
                    *(u32x4*)(rowp + bj * 128) = w; } }
    }
};
struct EpiS1 {
    static constexpr bool PERM = true, BF16 = false;
    f16* S;
    __device__ __forceinline__ void operator()(const f32x4 (&acc)[2][2][4][2], const Unit& u, int wr, int wc, int fr, int fq) const {
        const int r0 = u.pm * 256 + wr * 64 + fr, col0 = wc * 32 + 8 * fq;
#pragma unroll
        for (int ai = 0; ai < 2; ++ai)
#pragma unroll
            for (int m = 0; m < 4; ++m) { f16* rowp = S + ((size_t)u.z * 1024 + (r0 + ai * 128 + m * 16)) * 256 + col0;
#pragma unroll
                for (int bj = 0; bj < 2; ++bj) { const f32x4 v0 = acc[ai][bj][m][0], v1 = acc[ai][bj][m][1];
                    u32x4 w; w.x = pk2h(v0[0], v0[1]); w.y = pk2h(v0[2], v0[3]); w.z = pk2h(v1[0], v1[1]); w.w = pk2h(v1[2], v1[3]);
                    *(u32x4*)(rowp + bj * 128) = w; } }
    }
};
struct EpiS3 {
    static constexpr bool PERM = true, BF16 = false;
    f16* Gg;
    __device__ __forceinline__ void operator()(const f32x4 (&acc)[2][2][4][2], const Unit& u, int wr, int wc, int fr, int fq) const {
        const int r0 = u.pm * 256 + wr * 64 + fr, col0 = wc * 32 + 8 * fq;
#pragma unroll
        for (int ai = 0; ai < 2; ++ai)
#pragma unroll
            for (int m = 0; m < 4; ++m) { f16* rowp = Gg + ((size_t)u.z * 1024 + (r0 + ai * 128 + m * 16)) * 256 + col0;
#pragma unroll
                for (int bj = 0; bj < 2; ++bj) { const f32x4 v0 = acc[ai][bj][m][0], v1 = acc[ai][bj][m][1];
                    float rr[8];
#pragma unroll
                    for (int k = 0; k < 4; ++k) { rr[k] = gelu_tanh_f(v0[k]); rr[4 + k] = gelu_tanh_f(v1[k]); }
                    constexpr bool OB = (FFN_BF16 != 0);
                    u32x4 w; w.x = pk2x(rr[0], rr[1], OB); w.y = pk2x(rr[2], rr[3], OB); w.z = pk2x(rr[4], rr[5], OB); w.w = pk2x(rr[6], rr[7], OB);
                    *(u32x4*)(rowp + bj * 128) = w; } }
    }
};

struct SchedFA {
    int vcu;
    __device__ bool next(int i, Unit& u) const { const int idx = i * 256 + vcu; if (idx >= 768) return false; u.pm = idx & 1; u.z = (idx >> 1) & 7;
        if (idx < 512) u.pn = idx >> 4; else { const int j = idx - 512; u.pn = 32 + 16 * (j >> 7) + ((j >> 4) & 7); } return true; }
};
struct SchedFBs {
    int vcu;
    __device__ bool next(int i, Unit& u) const { if (i > 0) return false; u.z = vcu >> 7; u.pm = (vcu >> 3) & 15; u.pn = vcu & 7; return true; }
};
struct SchedFBp {
    int vcu;
    __device__ bool next(int i, Unit& u) const { if (i > 0) return false; u.z = vcu >> 3; u.pm = 0; u.pn = vcu & 7; return true; }
};
struct SchedS {
    int vcu;
    __device__ bool next(int i, Unit& u) const { const int idx = i * 256 + vcu; if (idx >= 512) return false; u.pm = idx & 3; u.z = idx >> 2; u.pn = 0; return true; }
};

struct TItem { const float* src; f16* dst; int N, K; bool bf; };
__device__ __forceinline__ TItem titem_make(const float* W, int K, int N, f16* WT, int half, int item) {
    const int nblk = N / 32, kb = item / nblk, nb = item % nblk, k0 = 64 * kb, n0 = 32 * nb;
    int d0 = n0;
    if (half > 0) { const int bj = n0 / half, rem = n0 % half; d0 = (rem / 128) * 256 + bj * 128 + (rem % 128); }
    TItem t; t.src = W + (size_t)k0 * N + n0; t.dst = WT + ((size_t)(d0 >> 8) * (K / 64) + (k0 >> 6)) * 16384 + (size_t)(d0 & 255) * 64; t.N = N; t.K = 64; t.bf = false; return t;
}
__device__ __forceinline__ TItem titem_decode(const Args& a, int it) {
    constexpr int I_IN = (D / 64) * (2 * DFF / 32), I_OUT = (DFF / 64) * (D / 32), I_O = (D / 64) * (D / 32), I_GLU = (D / 64) * (2 * D / 32);
    int r = it;
    if (r < 8 * I_IN) { const int mi = r / I_IN; TItem t = titem_make(a.ffn_w_in + (size_t)mi * D * 2 * DFF, D, 2 * DFF, (f16*)(a.ws + WS_WIN) + (size_t)mi * D * 2 * DFF, DFF, r % I_IN); t.bf = (FFN_BF16 != 0); return t; } r -= 8 * I_IN;
    if (r < 8 * I_OUT) { const int mi = r / I_OUT; TItem t = titem_make(a.ffn_w_out + (size_t)mi * DFF * D, DFF, D, (f16*)(a.ws + WS_WOUT) + (size_t)mi * DFF * D, 0, r % I_OUT); t.bf = (FFN_BF16 != 0); return t; } r -= 8 * I_OUT;
    if (r < 2 * I_O) { const int mi = r / I_O; TItem t = titem_make(a.fourier_w_o + (size_t)mi * D * D, D, D, (f16*)(a.ws + WS_WO) + (size_t)mi * D * D, 0, r % I_O); t.bf = (FFN_BF16 != 0); return t; } r -= 2 * I_O;
    { const int mi = r / I_GLU; TItem t = titem_make(a.ssm_w_glu + (size_t)mi * D * 2 * D, D, 2 * D, (f16*)(a.ws + WS_WGLU) + (size_t)mi * D * 2 * D, D, r % I_GLU); t.bf = (FFN_BF16 != 0); return t; }
}
__device__ __forceinline__ void titem_load(f32x4 (&v)[8], const TItem& t, int lane) {
    const float* p = t.src + (size_t)(lane >> 3) * t.N + (lane & 7) * 4;
#pragma unroll
    for (int i = 0; i < 8; ++i) v[i] = __builtin_nontemporal_load((const f32x4*)(p + (size_t)(8 * i) * t.N));
}
__device__ __forceinline__ void titem_store(const f32x4 (&v)[8], const TItem& t, LAS float* scr, int lane) {
#pragma unroll
    for (int i = 0; i < 8; ++i) { LAS float* s = scr + (8 * i + (lane >> 3)) * 33 + (lane & 7) * 4; s[0] = v[i][0]; s[1] = v[i][1]; s[2] = v[i][2]; s[3] = v[i][3]; }
    LDS_WAIT(); asm volatile("" ::: "memory");
    const int c = lane & 7;
#pragma unroll
    for (int j = 0; j < 4; ++j) { const int n = (lane >> 3) + 8 * j; const LAS float* s = scr + (8 * c) * 33 + n;
        u32x4 o; o.x = pk2x(s[0 * 33], s[1 * 33], t.bf); o.y = pk2x(s[2 * 33], s[3 * 33], t.bf); o.z = pk2x(s[4 * 33], s[5 * 33], t.bf); o.w = pk2x(s[6 * 33], s[7 * 33], t.bf);
        *(u32x4*)(t.dst + (size_t)n * t.K + 8 * c) = o; }
    LDS_WAIT(); asm volatile("" ::: "memory");
}

__device__ __forceinline__ void ssm_tables_item(const Args& a, int kk, int g, LAS unsigned char* sl, int tid) {
    LAS f32x2* apow = (LAS f32x2*)sl;
    LAS f32x2* bbar = (LAS f32x2*)(sl + 17408);
    LAS f32x2* cc   = (LAS f32x2*)(sl + 17408 + 16384);
    LAS float* klag = (LAS float*)(sl + 17408 + 32768);
    if (tid < 128) {
        const int d = tid >> 6, p = tid & 63;
        const size_t ia = ((size_t)(kk * 2 + d) * SSM_G + g) * SSM_P + p;
        const double are = (double)a.ssm_a_re[ia], aim = (double)a.ssm_a_im[ia];
        const double dt = exp((double)a.ssm_log_dt[(kk * 2 + d) * SSM_G + g]);
        const double mag = exp(are * dt), ang = aim * dt;
        const double abr = mag * cos(ang), abi = mag * sin(ang);
        double cr = 1.0, ci = 0.0;
        for (int m = 0; m <= 16; ++m) {
            apow[(d * 64 + p) * 17 + m] = (f32x2){(float)cr, (float)ci};
            if (m == 16) ((f32x2*)(a.ws + WS_AL))[((size_t)(kk * 2 + d) * SSM_G + g) * SSM_P + p] = (f32x2){(float)cr, (float)ci};
            const double nr = cr * abr - ci * abi, ni = cr * abi + ci * abr; cr = nr; ci = ni;
        }
        const double nr = abr - 1.0, ni = abi, den = are * are + aim * aim;
        const double qr = (nr * are + ni * aim) / den, qi = (ni * are - nr * aim) / den;
        const float* bp = a.ssm_b + (ia * SSM_H) * 2;
        for (int h = 0; h < 16; ++h) { const double br = (double)bp[2 * h], bi = (double)bp[2 * h + 1];
            bbar[(d * 64 + p) * 16 + h] = (f32x2){(float)(qr * br - qi * bi), (float)(qr * bi + qi * br)}; }
    }
    for (int i = tid; i < 2048; i += NTHR) {
        const int d = i >> 10, r = i & 1023;
        const float* cp = a.ssm_c + ((((size_t)(kk * 2 + d) * SSM_G + g) * SSM_H) * SSM_P + r) * 2;
        cc[i] = (f32x2){cp[0], cp[1]};
    }
    __syncthreads();
    {
        const int hc = tid & 3, hb = (tid >> 2) & 3, lag = (tid >> 4) & 15, d = tid >> 8;
        float acc[4][4];
#pragma unroll
        for (int i = 0; i < 4; ++i)
#pragma unroll
            for (int j = 0; j < 4; ++j) acc[i][j] = 0.f;
        for (int p = 0; p < 64; ++p) {
            const f32x2 ap = apow[(d * 64 + p) * 17 + lag];
            f32x2 ab[4], c[4];
#pragma unroll
            for (int j = 0; j < 4; ++j) { const f32x2 bb = bbar[(d * 64 + p) * 16 + 4 * hc + j]; ab[j] = (f32x2){ap.x * bb.x - ap.y * bb.y, ap.x * bb.y + ap.y * bb.x}; }
#pragma unroll
            for (int i = 0; i < 4; ++i) c[i] = cc[(d * 16 + 4 * hb + i) * 64 + p];
#pragma unroll
            for (int i = 0; i < 4; ++i)
#pragma unroll
                for (int j = 0; j < 4; ++j) acc[i][j] += c[i].x * ab[j].x - c[i].y * ab[j].y;
        }
#pragma unroll
        for (int i = 0; i < 4; ++i)
#pragma unroll
            for (int j = 0; j < 4; ++j) klag[((d * 16 + lag) * 16 + 4 * hb + i) * 16 + 4 * hc + j] = acc[i][j];
    }
    __syncthreads();
    f16* W1 = (f16*)(a.ws + WS_W1) + ((size_t)(kk * SSM_G + g) << 16);
    for (int e = tid; e < 65536; e += NTHR) {
        const int k = e & 255, np = e >> 8, h = k & 15, j = k >> 4, p = np & 63, ri = (np >> 6) & 1, d = np >> 7;
        const f32x2 ap = apow[(d * 64 + p) * 17 + (d == 0 ? 15 - j : j)], bb = bbar[(d * 64 + p) * 16 + h];
        const float zr = ap.x * bb.x - ap.y * bb.y, zi = ap.x * bb.y + ap.y * bb.x;
        W1[e] = (f16)(ri == 0 ? zr : zi);
    }
    f16* TW = (f16*)(a.ws + WS_TW) + ((size_t)(kk * SSM_G + g) << 17);
    const float* dw = a.ssm_d + kk * D + g * 16;
    for (int e = tid; e < 131072; e += NTHR) {
        const int k = e & 511, np = e >> 9, hp = np & 15, j = np >> 4;
        float v;
        if (k < 256) { const int h = k & 15, j2 = k >> 4;
            v = (j2 == j && h == hp) ? dw[h] : 0.f;
            if (j2 <= j) v += klag[((0 * 16 + (j - j2)) * 16 + hp) * 16 + h];
            if (j2 >= j) v += klag[((1 * 16 + (j2 - j)) * 16 + hp) * 16 + h];
        } else { const int k2 = k - 256, p = k2 & 63, ri = (k2 >> 6) & 1, d = k2 >> 7;
            const f32x2 c = cc[(d * 16 + hp) * 64 + p], ap = apow[(d * 64 + p) * 17 + (d == 0 ? j + 1 : 16 - j)];
            const float zr = c.x * ap.x - c.y * ap.y, zi = c.x * ap.y + c.y * ap.x;
            v = ri == 0 ? zr : -zi;
        }
        TW[e] = (f16)v;
    }
    __syncthreads();
}

__device__ __forceinline__ void p0a_phase(const Args& a, Frame& F) {
    __syncthreads();
    LAS float* sc = (LAS float*)F.lds;
    for (int i = F.tid; i < 3 * D; i += NTHR) { const int c = i >> 11, k = i & (D - 1); const float v = (c == 0) ? a.c_ctx[k] : a.c[(c - 1) * D + k]; sc[i] = v * sigmoid_f(v); }
    __syncthreads();
    for (int it = F.vcu; it < 2 * SSM_G; it += F.G) ssm_tables_item(a, it >> 7, it & 127, F.lds + 24576, F.tid);
    const int gw = F.vcu * NWAVES + F.wave, NGW = F.G * NWAVES;
    float* modp = (float*)(a.ws + WS_MODP);
    for (int it = gw; it < 4 * 16 * 72; it += NGW) {
        const int nc = it % 72, kc = (it / 72) & 15, l = it / 1152;
        const float* wp = a.w_ada + ((size_t)(l * D + kc * 128)) * (NMOD * D) + nc * 256 + F.lane * 4;
        f32x4 s0 = {0.f, 0.f, 0.f, 0.f}, s1 = s0, s2 = s0;
        for (int k8 = 0; k8 < 128; k8 += 8) {
            f32x4 w[8];
#pragma unroll
            for (int j = 0; j < 8; ++j) w[j] = __builtin_nontemporal_load((const f32x4*)(wp + (size_t)(k8 + j) * (NMOD * D)));
#pragma unroll
            for (int j = 0; j < 8; ++j) { const int k = kc * 128 + k8 + j; s0 += w[j] * sc[k]; s1 += w[j] * sc[D + k]; s2 += w[j] * sc[2 * D + k]; }
        }
        float* op = modp + ((size_t)(kc * 4 + l) * 3) * (NMOD * D) + nc * 256 + F.lane * 4;
        *(f32x4*)op = s0; *(f32x4*)(op + NMOD * D) = s1; *(f32x4*)(op + 2 * NMOD * D) = s2;
    }
    __syncthreads();
    {
        const int gt = F.vcu * NTHR + F.tid, NGT = F.G * NTHR;
        f16* cs4 = (f16*)(a.ws + WS_CS4096);
        for (int ch = gt; ch < 4096 * 512; ch += NGT) {
            const int k = ch >> 9, col0 = (ch & 511) * 8, cs = col0 >> 11, t0 = col0 & 2047; float v[8];
#pragma unroll
            for (int j = 0; j < 8; ++j) { const int mm = (k * (t0 + j)) & 4095; const float x = (float)mm * (1.0f / 2048.0f); v[j] = cs == 0 ? cospif(x) : -sinpif(x); }
            u32x4 o; o.x = pk2h(v[0], v[1]); o.y = pk2h(v[2], v[3]); o.z = pk2h(v[4], v[5]); o.w = pk2h(v[6], v[7]);
            *(u32x4*)(cs4 + (size_t)ch * 8) = o;
        }
        f16* cs2 = (f16*)(a.ws + WS_CS256);
        for (int ch = gt; ch < 256 * 64; ch += NGT) {
            const int k = ch >> 6, col0 = (ch & 63) * 8, cs = col0 >> 8, t0 = col0 & 255; float v[8];
#pragma unroll
            for (int j = 0; j < 8; ++j) { const int mm = (k * (t0 + j)) & 255; const float x = (float)mm * (1.0f / 128.0f); v[j] = cs == 0 ? cospif(x) : -sinpif(x); }
            u32x4 o; o.x = pk2h(v[0], v[1]); o.y = pk2h(v[2], v[3]); o.z = pk2h(v[4], v[5]); o.w = pk2h(v[6], v[7]);
            *(u32x4*)(cs2 + (size_t)ch * 8) = o;
        }
        f16* w2t = (f16*)(a.ws + WS_W2T);
        for (int ch = gt; ch < 512 * 32; ch += NGT) {
            const int row = ch >> 5, c0 = (ch & 31) * 8, cs = row >> 8, q = row & 255; float v[8];
#pragma unroll
            for (int j = 0; j < 8; ++j) { const int mm = (q * (c0 + j)) & 255; const float x = (float)mm * (1.0f / 128.0f); v[j] = cs == 0 ? cospif(x) : sinpif(x); }
            u32x4 o; o.x = pk2h(v[0], v[1]); o.y = pk2h(v[2], v[3]); o.z = pk2h(v[4], v[5]); o.w = pk2h(v[6], v[7]);
            *(u32x4*)(w2t + (size_t)ch * 8) = o;
        }
    }
    {
        LAS float* scr = (LAS float*)(F.lds + F.wave * 16384);
        constexpr int I_IN = (D / 64) * (2 * DFF / 32), I_OUT = (DFF / 64) * (D / 32), I_O = (D / 64) * (D / 32), I_GLU = (D / 64) * (2 * D / 32);
        constexpr int NITEMS = 8 * I_IN + 8 * I_OUT + 2 * I_O + 2 * I_GLU;
        int it = gw;
        if (it < NITEMS) {
            TItem cur = titem_decode(a, it); f32x4 v[8], w[8]; titem_load(v, cur, F.lane);
            for (;;) {
                const int nit = it + NGW; const bool has = nit < NITEMS; TItem nx = cur;
                if (has) { nx = titem_decode(a, nit); titem_load(w, nx, F.lane); }
                titem_store(v, cur, scr, F.lane);
                if (!has) break;
#pragma unroll
                for (int i = 0; i < 8; ++i) v[i] = w[i];
                cur = nx; it = nit;
            }
        }
    }
    {
        float* pe = (float*)(a.ws + WS_PE);
        for (int e = F.vcu * NTHR + F.tid; e < 64 * 512; e += F.G * NTHR) { const int pos = e >> 9, i = e & 511;
            const float fr = exp2f(-(float)i * (13.287712379549449f / 512.0f)); const float ar = (float)pos * fr;
            pe[e] = sinf(ar); pe[64 * 512 + e] = cosf(ar); }
    }
}

__device__ __forceinline__ void p0b_phase(const Args& a, Frame& F) {
    const float* modp = (const float*)(a.ws + WS_MODP); float* mod = (float*)(a.ws + WS_MOD);
    for (int i = F.vcu * NTHR + F.tid; i < 4 * 3 * NMOD * D; i += F.G * NTHR) {
        const int n = i % (NMOD * D), lc = i / (NMOD * D), l = lc / 3;
        float s = a.b_ada[l * (NMOD * D) + n];
#pragma unroll
        for (int kc = 0; kc < 16; ++kc) s += modp[((size_t)kc * 12 + lc) * (NMOD * D) + n];
        mod[i] = s;
        const int q = n / D;
        if (q % 3 == 1) { const int j = q / 3, col = n % D; ((float*)(a.ws + WS_GS))[((size_t)(l * 3 + j) * 3 + (lc % 3)) * D + col] = a.norm_g[(size_t)(l * 3 + j) * D + col] * (1.0f + s); }
    }
}

__device__ __forceinline__ void norm_load_row(const Args& a, Frame& F, int m, bool first, f32x4 (&v)[4][2]) {
    f16* xh = (f16*)(a.ws + WS_XH) + (size_t)m * D;
    if (first) {
        const float* xi = m < NPROMPT ? a.x_prompt + (size_t)m * D : a.x_sample + (size_t)(m - NPROMPT) * D;
        const int t = (m - NPROMPT) & (SEQ_S - 1); const float* pe = (const float*)(a.ws + WS_PE);
#pragma unroll
        for (int q = 0; q < 4; ++q) {
#pragma unroll
            for (int e = 0; e < 2; ++e) { const int c = q * 512 + F.lane * 8 + e * 4; f32x4 x = *(const f32x4*)(xi + c);
                if (m >= NPROMPT) x += *(const f32x4*)(pe + ((q & 1) * 64 + (q < 2 ? (t >> 6) : (t & 63))) * 512 + (c & 511));
                v[q][e] = x; }
            u32x4 w; w.x = pk2h(v[q][0][0], v[q][0][1]); w.y = pk2h(v[q][0][2], v[q][0][3]); w.z = pk2h(v[q][1][0], v[q][1][1]); w.w = pk2h(v[q][1][2], v[q][1][3]);
            *(u32x4*)(xh + q * 512 + F.lane * 8) = w; }
    } else {
#pragma unroll
        for (int q = 0; q < 4; ++q) { const f16x8 h = *(const f16x8*)(xh + q * 512 + F.lane * 8);
            v[q][0] = (f32x4){(float)h[0], (float)h[1], (float)h[2], (float)h[3]}; v[q][1] = (f32x4){(float)h[4], (float)h[5], (float)h[6], (float)h[7]}; }
    }
}
__device__ __forceinline__ float norm_rstd(Frame& F, const f32x4 (&v)[4][2]) {
    float ss = 0.f;
#pragma unroll
    for (int q = 0; q < 4; ++q)
#pragma unroll
        for (int e = 0; e < 2; ++e) { const f32x4 t = v[q][e] * v[q][e]; ss += (t[0] + t[1]) + (t[2] + t[3]); }
    return 1.0f / sqrtf(wave_sum(ss, F.lane) * (1.0f / D) + RMS_EPS);
}
__device__ __forceinline__ void norm_store_row(f16* dst, Frame& F, const f32x4 (&o)[4][2], bool bf = false) {
#pragma unroll
    for (int q = 0; q < 4; ++q) { u32x4 w; w.x = pk2x(o[q][0][0], o[q][0][1], bf); w.y = pk2x(o[q][0][2], o[q][0][3], bf); w.z = pk2x(o[q][1][0], o[q][1][1], bf); w.w = pk2x(o[q][1][2], o[q][1][3], bf);
        *(u32x4*)(dst + q * 512 + F.lane * 8) = w; }
}
__device__ __forceinline__ void norm_store_row_grp(f16* Hg, int m, Frame& F, const f32x4 (&o)[4][2]) {
#pragma unroll
    for (int q = 0; q < 4; ++q) { u32x4 w; w.x = pk2h(o[q][0][0], o[q][0][1]); w.y = pk2h(o[q][0][2], o[q][0][3]); w.z = pk2h(o[q][1][0], o[q][1][1]); w.w = pk2h(o[q][1][2], o[q][1][3]);
        *(u32x4*)(Hg + (size_t)(q * 32 + (F.lane >> 1)) * (MTOK * 16) + (size_t)m * 16 + (F.lane & 1) * 8) = w; }
}
__device__ __forceinline__ void norm_phase(const Args& a, Frame& F, int l, int j, bool first, bool fold, bool grp) {
    const int gw = F.vcu * NWAVES + F.wave; const int row0 = gw * 8;
    const int cond = cond_of_panel(row0 >> 8);
    const float* gp = a.norm_g + (size_t)(l * 3 + j) * D;
    const float* sh = (const float*)(a.ws + WS_MOD) + ((size_t)(l * 3 + cond) * NMOD + 3 * j) * D;
    const float* scl = sh + D;
    f32x4 gs[4][2], sv[4][2];
#pragma unroll
    for (int q = 0; q < 4; ++q)
#pragma unroll
        for (int e = 0; e < 2; ++e) { const int c = q * 512 + F.lane * 8 + e * 4; gs[q][e] = *(const f32x4*)(gp + c) * (*(const f32x4*)(scl + c) + 1.0f); sv[q][e] = *(const f32x4*)(sh + c); }
    f16* H = (f16*)(a.ws + WS_H);
    if (!(fold && row0 >= NPROMPT)) {
        const f16* xh0 = (const f16*)(a.ws + WS_XH) + (size_t)row0 * D + F.lane * 8;
        u32x4 nx[4];
        if (!first) {
#pragma unroll
            for (int q = 0; q < 4; ++q) nx[q] = *(const u32x4*)(xh0 + q * 512);
        }
        for (int r = 0; r < 8; ++r) {
            const int m = row0 + r;
            f32x4 v[4][2];
            if (first) norm_load_row(a, F, m, true, v);
            else {
#pragma unroll
                for (int q = 0; q < 4; ++q) { const f16x8 h = __builtin_bit_cast(f16x8, nx[q]);
                    v[q][0] = (f32x4){(float)h[0], (float)h[1], (float)h[2], (float)h[3]}; v[q][1] = (f32x4){(float)h[4], (float)h[5], (float)h[6], (float)h[7]}; }
                if (r < 7) {
#pragma unroll
                    for (int q = 0; q < 4; ++q) nx[q] = *(const u32x4*)(xh0 + (size_t)(r + 1) * D + q * 512);
                }
            }
            const float rstd = norm_rstd(F, v);
#pragma unroll
            for (int q = 0; q < 4; ++q)
#pragma unroll
                for (int e = 0; e < 2; ++e) v[q][e] = v[q][e] * rstd * gs[q][e] + sv[q][e];
            if (grp) norm_store_row_grp(H, m, F, v);
            else norm_store_row(H + (size_t)m * D, F, v, (FFN_BF16 != 0) && j != 1);
        }
    } else {
        f16* G2 = (f16*)(a.ws + WS_G);
        const int i = gw - NPROMPT / 8, b = i >> 9, t0 = (i & 511) * 4, rb = NPROMPT + SEQ_S * b;
        for (int r = 0; r < 4; ++r) {
            const int t = t0 + r, ma = rb + t, mb = rb + (t == 0 ? SEQ_S / 2 : SEQ_S - t);
            f32x4 va[4][2], vb[4][2]; norm_load_row(a, F, ma, false, va); norm_load_row(a, F, mb, false, vb);
            const float ra = norm_rstd(F, va), rbv = norm_rstd(F, vb);
#pragma unroll
            for (int q = 0; q < 4; ++q)
#pragma unroll
                for (int e = 0; e < 2; ++e) { va[q][e] = va[q][e] * ra * gs[q][e] + sv[q][e]; vb[q][e] = vb[q][e] * rbv * gs[q][e] + sv[q][e]; }
            if (t == 0) {
                norm_store_row(H + (size_t)ma * D, F, va); norm_store_row(H + (size_t)mb * D, F, vb);
#pragma unroll
                for (int q = 0; q < 4; ++q)
#pragma unroll
                    for (int e = 0; e < 2; ++e) vb[q][e] = (f32x4){0.f, 0.f, 0.f, 0.f};
                norm_store_row(G2 + (size_t)ma * D, F, vb);
            } else {
                f32x4 se[4][2], so[4][2];
#pragma unroll
                for (int q = 0; q < 4; ++q)
#pragma unroll
                    for (int e = 0; e < 2; ++e) { se[q][e] = va[q][e] + vb[q][e]; so[q][e] = va[q][e] - vb[q][e]; }
                norm_store_row(H + (size_t)ma * D, F, se); norm_store_row(G2 + (size_t)ma * D, F, so);
            }
        }
    }
    if (fold && gw < 64) {
        const int b = gw >> 5, m = NPROMPT + SEQ_S * b + SEQ_S / 2;
        const float* sh2 = (const float*)(a.ws + WS_MOD) + ((size_t)(l * 3 + 1 + b) * NMOD + 3 * j) * D; const float* scl2 = sh2 + D;
        f32x4 v[4][2]; norm_load_row(a, F, m, false, v);
        const float rstd = norm_rstd(F, v);
        LAS float* hl = (LAS float*)(F.lds + F.wave * 16384);
#pragma unroll
        for (int q = 0; q < 4; ++q)
#pragma unroll
            for (int e = 0; e < 2; ++e) { const int c = q * 512 + F.lane * 8 + e * 4;
                const f32x4 o = v[q][e] * rstd * (*(const f32x4*)(gp + c) * (*(const f32x4*)(scl2 + c) + 1.0f)) + *(const f32x4*)(sh2 + c);
                *(LAS f32x4*)(hl + c) = o; }
        LDS_WAIT(); asm volatile("" ::: "memory");
        const int o = (gw & 31) * 64 + F.lane, g = o >> 8, q = o & 255;
        float s = 0.f;
        for (int c = 0; c < 256; ++c) s += hl[256 * g + c] * __builtin_amdgcn_cosf((float)((q * c) & 255) * (1.0f / 256.0f));
        ((float*)(a.ws + WS_HCN))[(size_t)b * D + o] = s;
        LDS_WAIT(); asm volatile("" ::: "memory");
    }
}

__device__ __forceinline__ void final_phase(const Args& a, Frame& F) {
    const int gw = F.vcu * NWAVES + F.wave; const int row0 = gw * 8;
    f32x4 gs[4][2];
#pragma unroll
    for (int q = 0; q < 4; ++q)
#pragma unroll
        for (int e = 0; e < 2; ++e) gs[q][e] = *(const f32x4*)(a.final_g + q * 512 + F.lane * 8 + e * 4);
    for (int r = 0; r < 8; ++r) {
        const int m = row0 + r;
        f32x4 v[4][2]; norm_load_row(a, F, m, false, v);
        const float rstd = norm_rstd(F, v);
        float* xr = a.out + (size_t)m * D;
#pragma unroll
        for (int q = 0; q < 4; ++q)
#pragma unroll
            for (int e = 0; e < 2; ++e) *(f32x4*)(xr + q * 512 + F.lane * 8 + e * 4) = v[q][e] * rstd * gs[q][e];
    }
}

__device__ __forceinline__ void scan_phase(const Args& a, Frame& F, int kk) {
    const int gw = F.vcu * NWAVES + F.wave, NGW = F.G * NWAVES;
    const f16* S = (const f16*)(a.ws + WS_S); f16* CC = (f16*)(a.ws + WS_CC);
    const f32x2* AL = (const f32x2*)(a.ws + WS_AL);
    float* ns = a.out + (size_t)MTOK * D;
    const int p = F.lane, w = F.wave;
    LAS f32x2* Lx = (LAS f32x2*)F.lds;
    for (int item = F.vcu; item < 2 * SSM_G; item += F.G) {
        const int sq = item >> 7, g = item & 127, c0 = 512 + 256 * sq;
        const size_t gb = (size_t)g * 1024 * 256;
#pragma unroll
        for (int d = 0; d < 2; ++d) {
            const f32x2 al = AL[((size_t)(kk * 2 + d) * SSM_G + g) * SSM_P + p];
            float cr = 0.f, ci = 0.f;
            for (int s8 = 0; s8 < 32; s8 += 16) {
                f16 sr[16], si[16];
#pragma unroll
                for (int j = 0; j < 16; ++j) { const int i = 32 * w + s8 + j, c = d == 0 ? c0 + i : c0 + 255 - i; const f16* q = S + gb + (size_t)c * 256 + d * 128 + p; sr[j] = q[0]; si[j] = q[64]; }
#pragma unroll
                for (int j = 0; j < 16; ++j) { const float nr = al.x * cr - al.y * ci + (float)sr[j], ni = al.x * ci + al.y * cr + (float)si[j]; cr = nr; ci = ni; }
            }
            Lx[(d * 8 + w) * 64 + p] = (f32x2){cr, ci};
        }
        __syncthreads();
#pragma unroll
        for (int d = 0; d < 2; ++d) {
            const f32x2 al = AL[((size_t)(kk * 2 + d) * SSM_G + g) * SSM_P + p];
            f32x2 a32 = al;
#pragma unroll
            for (int k = 0; k < 5; ++k) a32 = (f32x2){a32.x * a32.x - a32.y * a32.y, 2.f * a32.x * a32.y};
            const float* sp = a.state_ssm + (((((size_t)sq * 2 + kk) * 2 + d) * SSM_G + g) * SSM_P + p) * 2;
            float cr = sp[0], ci = sp[1];
            for (int v = 0; v < w; ++v) { const f32x2 L = Lx[(d * 8 + v) * 64 + p]; const float nr = a32.x * cr - a32.y * ci + L.x, ni = a32.x * ci + a32.y * cr + L.y; cr = nr; ci = ni; }
            for (int s8 = 0; s8 < 32; s8 += 16) {
                f16 sr[16], si[16];
#pragma unroll
                for (int j = 0; j < 16; ++j) { const int i = 32 * w + s8 + j, c = d == 0 ? c0 + i : c0 + 255 - i; const f16* q = S + gb + (size_t)c * 256 + d * 128 + p; sr[j] = q[0]; si[j] = q[64]; }
#pragma unroll
                for (int j = 0; j < 16; ++j) { const int i = 32 * w + s8 + j, c = d == 0 ? c0 + i : c0 + 255 - i;
                    f16* o = CC + gb + (size_t)c * 256 + d * 128 + p; o[0] = (f16)cr; o[64] = (f16)ci;
                    const float nr = al.x * cr - al.y * ci + (float)sr[j], ni = al.x * ci + al.y * cr + (float)si[j]; cr = nr; ci = ni; }
            }
        }
        __syncthreads();
    }
    for (int it = gw; it < NB_P * SSM_G * 2; it += NGW) {
        const int sq = it >> 8, g = (it >> 1) & 127, d = it & 1, c0 = sq * 16;
        const size_t gb = (size_t)g * 1024 * 256;
        const f32x2 al = AL[((size_t)(kk * 2 + d) * SSM_G + g) * SSM_P + p];
        float cr = 0.f, ci = 0.f;
        f16 sr[16], si[16];
#pragma unroll
        for (int j = 0; j < 16; ++j) { const int c = d == 0 ? c0 + j : c0 + 15 - j; const f16* q = S + gb + (size_t)c * 256 + d * 128 + p; sr[j] = q[0]; si[j] = q[64]; }
#pragma unroll
        for (int j = 0; j < 16; ++j) { const int c = d == 0 ? c0 + j : c0 + 15 - j;
            f16* o = CC + gb + (size_t)c * 256 + d * 128 + p; o[0] = (f16)cr; o[64] = (f16)ci;
            const float nr = al.x * cr - al.y * ci + (float)sr[j], ni = al.x * ci + al.y * cr + (float)si[j]; cr = nr; ci = ni; }
        float* o = ns + (((((size_t)sq * 2 + kk) * 2 + d) * SSM_G + g) * SSM_P + p) * 2; *(f32x2*)o = (f32x2){cr, ci};
    }
}

constexpr int N_PHASES = 37;
#ifndef MK_PER_PHASE
#define MK_PER_PHASE 0
#endif

#ifndef EN_MASK
#define EN_MASK 0xFFFF
#endif
#ifndef PROBE
#define PROBE 0
#endif
#ifndef PROBE_SEL
#define PROBE_SEL 31
#endif
#if PROBE
#define EN(bit) pkind_ = (bit); if constexpr (((EN_MASK) >> (bit)) & 1)
#else
#define EN(bit) if constexpr (((EN_MASK) >> (bit)) & 1)
#endif
#ifndef G_SP2
#define G_SP2 true
#endif
#ifndef G_ALIGN
#define G_ALIGN true
#endif
#ifndef REP_MASK
#define REP_MASK 0
#endif
#define REPCNT(bit) ((((REP_MASK) >> (bit)) & 1) ? 2 : 1)
#define REP(bit) for (int rep_ = 0; rep_ < REPCNT(bit); ++rep_)
typedef pg8::Prob<false> ProbStd;
typedef pg8::Prob<true> ProbGrp;

__device__ __forceinline__ ProbStd make_std(const void* A, unsigned lda2, size_t a_t, size_t a_z, const void* B, unsigned ldb2, size_t b_t, size_t b_z, int nt) {
    ProbStd p; p.A = (const char*)A; p.A2 = (const char*)A; p.B = (const char*)B; p.nt = nt; p.ksplit = nt; p.lda2 = lda2; p.ldb2 = ldb2; p.a_t = a_t; p.a_z = a_z; p.b_t = b_t; p.b_z = b_z; p.a_k = 128u; p.b_k = 128u; return p;
}

struct ArgsK {
    const GAS float* x_prompt; const GAS float* x_sample; const GAS float* state_ssm; const GAS float* c; const GAS float* c_ctx;
    const GAS float* w_ada; const GAS float* b_ada; const GAS float* norm_g; const GAS float* ffn_w_in; const GAS float* ffn_w_out;
    const GAS float* fourier_w_o; const GAS float* ssm_a_re; const GAS float* ssm_a_im; const GAS float* ssm_log_dt;
    const GAS float* ssm_b; const GAS float* ssm_c; const GAS float* ssm_d; const GAS float* ssm_w_glu; const GAS float* final_g;
    GAS float* out; GAS unsigned char* ws; int ph_lo, ph_hi;
};
static_assert(sizeof(ArgsK) == sizeof(Args), "ArgsK mirrors Args");
__device__ __forceinline__ Args kargs() {
    const __attribute__((address_space(4))) ArgsK* p = (const __attribute__((address_space(4))) ArgsK*)__builtin_amdgcn_kernarg_segment_ptr(); asm volatile("" : "+s"(p));
    Args a;
    a.x_prompt = (const float*)p->x_prompt; a.x_sample = (const float*)p->x_sample; a.state_ssm = (const float*)p->state_ssm; a.c = (const float*)p->c; a.c_ctx = (const float*)p->c_ctx;
    a.w_ada = (const float*)p->w_ada; a.b_ada = (const float*)p->b_ada; a.norm_g = (const float*)p->norm_g; a.ffn_w_in = (const float*)p->ffn_w_in; a.ffn_w_out = (const float*)p->ffn_w_out;
    a.fourier_w_o = (const float*)p->fourier_w_o; a.ssm_a_re = (const float*)p->ssm_a_re; a.ssm_a_im = (const float*)p->ssm_a_im; a.ssm_log_dt = (const float*)p->ssm_log_dt;
    a.ssm_b = (const float*)p->ssm_b; a.ssm_c = (const float*)p->ssm_c; a.ssm_d = (const float*)p->ssm_d; a.ssm_w_glu = (const float*)p->ssm_w_glu; a.final_g = (const float*)p->final_g;
    a.out = (float*)p->out; a.ws = (unsigned char*)p->ws; a.ph_lo = p->ph_lo; a.ph_hi = p->ph_hi;
    return a;
}

__device__ __forceinline__ void set_b_tm(ProbStd& p, int nkt) { p.ldb2 = 128u; p.b_k = 32768u; p.b_t = (size_t)nkt * 32768; }
__device__ __forceinline__ void set_a_tm(ProbStd& p, int nkt) { p.lda2 = 128u; p.a_k = 32768u; p.a_t = (size_t)nkt * 32768; }

__global__ void __launch_bounds__(NTHR, 2) fwd_kernel(ArgsK a_unused) {
    extern __shared__ __attribute__((aligned(16))) unsigned char lds_raw[];
    Frame F0;
    F0.lds = (LAS unsigned char*)lds_raw;
    F0.tid = threadIdx.x; F0.lane = F0.tid & 63; F0.wave = __builtin_amdgcn_readfirstlane(F0.tid >> 6);
    F0.G = gridDim.x; F0.bx = blockIdx.x; { const int bx = blockIdx.x; F0.vcu = (F0.G % 8 == 0) ? (bx % 8) * (F0.G / 8) + bx / 8 : bx; }
    volatile LAS unsigned* MISC = (volatile LAS unsigned*)(F0.lds + MISC_OFF);
    if (F0.tid < 64) MISC[F0.tid] = 0u;
    __syncthreads();
    unsigned bar_x; int lo, hi;
    { const Args a = kargs(); unsigned* ctl = (unsigned*)(a.ws + WS_CTL); const XcdBarrier b0 = xcd_barrier_post(ctl + CW_BAR, MISC + 8); bar_x = b0.x; lo = a.ph_lo; hi = a.ph_hi; }
#define GRID_BAR() do { const Args ab = kargs(); XcdBarrier bb; bb.bar = (unsigned*)(ab.ws + WS_CTL) + CW_BAR; unsigned bx_ = bar_x; asm volatile("" : "+s"(bx_)); bb.x = bx_; bb.st = MISC + 8; xcd_barrier(bb, lok != 0 && seam_loc != 0); seam_loc = 0; } while (0)
    int ph = 0, lok = 0, seam_loc = 0;
#define PH_BEGIN if (ph >= lo && ph < hi) { const Args a = kargs(); unsigned char* ws = a.ws; \
    Frame F = F0; asm volatile("" : "+s"(F.vcu), "+s"(F.wave), "+s"(F.G), "+s"(F.bx)); asm volatile("" : "+v"(F.tid)); F.lane = F.tid & 63;   \
    f16* H = (f16*)(ws + WS_H); f16* ACT = (f16*)(ws + WS_ACT); f16* HT = (f16*)(ws + WS_HT); f16* Fm = (f16*)(ws + WS_F); \
    f16* Sm = (f16*)(ws + WS_S); f16* CC = (f16*)(ws + WS_CC); f16* Gm = (f16*)(ws + WS_G); \
    const float* modl = (const float*)(ws + WS_MOD) + (size_t)l * 3 * NMOD * D; \
    (void)H; (void)ACT; (void)HT; (void)Fm; (void)Sm; (void)CC; (void)Gm; (void)modl; PROBE_T0
#if PROBE
#define PROBE_T0 unsigned long long pt0_ = __builtin_amdgcn_s_memrealtime(); int pkind_ = 0; (void)pkind_;
#define PROBE_T1 { const unsigned long long pt1_ = __builtin_amdgcn_s_memrealtime(); if (threadIdx.x == 0) atomicAdd((unsigned long long*)(ws + WS_CTL + 262144) + pkind_, pt1_ - pt0_); pt0_ = pt1_; }
#define PROBE_T2 { const unsigned long long pt2_ = __builtin_amdgcn_s_memrealtime(); if (threadIdx.x == 0) { atomicAdd((unsigned long long*)(ws + WS_CTL + 262144) + 31, pt2_ - pt0_); atomicAdd((unsigned long long*)(ws + WS_CTL + 262144) + 16 + pkind_, pt2_ - pt0_); } }
#else
#define PROBE_T0
#define PROBE_T1
#define PROBE_T2
#endif
#define PH_END   PROBE_T1 if (ph + 1 < hi) { GRID_BAR(); PROBE_T2 } } ++ph;

    { const int l = 0;
    PH_BEGIN EN(0) REP(0) p0a_phase(a, F); PH_END
    if (lo == 0 && hi > 1) {
        const unsigned e32 = (unsigned)__builtin_amdgcn_readfirstlane((int)MISC[10]), rk = (unsigned)__builtin_amdgcn_readfirstlane((int)MISC[12]);
        if (e32 != 0u && rk < 32u && bar_x < 8u && F0.G == 256) { lok = 1; F0.bx = (int)(rk * 8u + bar_x); F0.vcu = (int)(bar_x * 32u + rk); }
    }
    PH_BEGIN EN(1) REP(1) p0b_phase(a, F); PH_END
    }
    for (int l = 0; l < DEPTH; ++l) {
        for (int s = 0; s < 2; ++s) {
            if ((s == 0 && l == 0) || (s == 1 && (l & 1) != 0)) {
            PH_BEGIN EN(2) REP(2) norm_phase(a, F, l, 2 * s, l == 0 && s == 0, false, false); PH_END
            }
            PH_BEGIN EN(3) REP(3) {
                const f16* Wt = (const f16*)(ws + WS_WIN) + (size_t)(l * 2 + s) * D * 2 * DFF;
                ProbStd p = make_std(H, D * 2, (size_t)256 * D * 2, 0, Wt, D * 2, (size_t)256 * D * 2, 0, D / 64); set_b_tm(p, D / 64);
                pg8::StaticOrder S; S.init(MTOK, 2 * DFF, F.G, F.bx);
                EpiSwiGLU E{ACT};
                pg8::gemm_phase<ProbStd, EpiSwiGLU, pg8::StaticOrder, G_ALIGN, G_SP2>(F.lds, p, S, E);
                seam_loc = 1;
            } PH_END
            PH_BEGIN EN(4) REP(4) {
                const f16* Wt = (const f16*)(ws + WS_WOUT) + (size_t)(l * 2 + s) * DFF * D;
                ProbStd p = make_std(ACT, DFF * 2, (size_t)256 * DFF * 2, 0, Wt, DFF * 2, (size_t)256 * DFF * 2, 0, DFF / 64); set_a_tm(p, DFF / 64); set_b_tm(p, DFF / 64);
                pg8::StaticOrder S; S.init(MTOK, D, F.G, F.bx);
                constexpr bool BF = (FFN_BF16 != 0);
                LAS unsigned char* lt = F.lds + MISC_OFF + 1024;
                const float* gate = modl + (size_t)(2 + 6 * s) * D;
                if (s == 1 && l + 1 < DEPTH) { typedef EpiResidNormT<BF, 0, 1, 2> EN0;
                    fused_norm_vectors(ws, nullptr, lt, S, l + 1, 0, false, F.tid); EN0 E{ws, a.out, gate, nullptr, l * 3 + 2, l + 1, 0, lt}; pg8::gemm_phase<ProbStd, EN0, pg8::StaticOrder, true, G_SP2>(F.lds, p, S, E); }
                else if (s == 1) { typedef EpiResidNormT<BF, 2, 1, 2> EN2;
                    fused_norm_vectors(ws, a.final_g, lt, S, 0, 0, true, F.tid); EN2 E{ws, a.out, gate, a.final_g, l * 3 + 2, 0, 0, lt}; pg8::gemm_phase<ProbStd, EN2, pg8::StaticOrder, true, G_SP2>(F.lds, p, S, E); }
                else if (l & 1) { typedef EpiResidNormT<BF, 1, 1, 2> EN1;
                    fused_norm_vectors(ws, nullptr, lt, S, l, 1, false, F.tid); EN1 E{ws, a.out, gate, nullptr, l * 3 + 0, l, 1, lt}; pg8::gemm_phase<ProbStd, EN1, pg8::StaticOrder, true, G_SP2>(F.lds, p, S, E); }
                else { EpiResidT<BF> E{(f16*)(ws + WS_XH), gate, 0.5f};
                    pg8::gemm_phase<ProbStd, EpiResidT<BF>, pg8::StaticOrder, G_ALIGN, G_SP2>(F.lds, p, S, E); }
                if (s == 1 && l + 1 < DEPTH) seam_loc = 1;
            } PH_END
            if (s == 0) {
                if ((l & 1) == 0) {
                PH_BEGIN EN(2) REP(2) norm_phase(a, F, l, 1, false, true, false); PH_END
                }
                const int kk = l >> 1;
                if ((l & 1) == 0) {
                    PH_BEGIN EN(5) REP(5) {
                        pg8::ProbFA p; (ProbStd&)p = make_std(ws + WS_W2T, 512, (size_t)256 * 512, 0, H, D * 2, (size_t)256 * D * 2, 512, 4);
                        p.b_m = (size_t)((const char*)Gm - (const char*)H);
                        SchedFA S{F.vcu}; EpiFA E{HT};
                        pg8::gemm_phase<pg8::ProbFA, EpiFA, SchedFA, true, true>(F.lds, p, S, E);
                    } PH_END
                    PH_BEGIN EN(6) REP(6) {
                        {
                            ProbStd p = make_std(ws + WS_CS4096, 8192, (size_t)256 * 8192, 0, HT + (size_t)NB_P * D * 2 * SEQ_P, 8192, (size_t)256 * 8192, (size_t)D * 8192, 64);
                            SchedFBs S{F.vcu}; EpiFB E{Fm, NPROMPT, SEQ_S, 1.0f / 1024.0f, (const float*)(ws + WS_HCN)};
                            pg8::gemm_phase<ProbStd, EpiFB, SchedFBs, false, true>(F.lds, p, S, E);
                        }
                        {
                            ProbStd p = make_std(ws + WS_CS256, 1024, (size_t)256 * 1024, 0, HT, 1024, (size_t)256 * 1024, (size_t)D * 1024, 8);
                            SchedFBp S{F.vcu}; EpiFB E{Fm, 0, SEQ_P, 1.0f / 256.0f, nullptr};
                            pg8::gemm_phase<ProbStd, EpiFB, SchedFBp, false, true>(F.lds, p, S, E);
                        }
                    } PH_END
                    PH_BEGIN EN(7) REP(7) {
                        const f16* Wt = (const f16*)(ws + WS_WO) + (size_t)kk * D * D;
                        ProbStd p = make_std(Fm, D * 2, (size_t)256 * D * 2, 0, Wt, D * 2, (size_t)256 * D * 2, 0, D / 64); set_b_tm(p, D / 64);
                        pg8::StaticOrder S; S.init(MTOK, D, F.G, F.bx);
                        typedef EpiResidNormT<(FFN_BF16 != 0), 0, 1, 1> ENC;
                        fused_norm_vectors(ws, nullptr, F.lds + MISC_OFF + 1024, S, l, 2, false, F.tid);
                        ENC E{ws, a.out, modl + (size_t)5 * D, nullptr, l * 3 + 1, l, 2, F.lds + MISC_OFF + 1024};
                        pg8::gemm_phase<ProbStd, ENC, pg8::StaticOrder, true, G_SP2>(F.lds, p, S, E);
                        seam_loc = 1;
                    } PH_END
                } else {
                    PH_BEGIN EN(8) REP(8) {
                        ProbStd p = make_std(H, 512, (size_t)256 * 512, pg8::PLANE_B, ws + WS_W1 + (size_t)kk * SSM_G * 256 * 512, 512, 0, (size_t)256 * 512, 4);
                        SchedS S{F.vcu}; EpiS1 E{Sm};
                        pg8::gemm_phase<ProbStd, EpiS1, SchedS, true, true>(F.lds, p, S, E);
                    } PH_END
                    PH_BEGIN EN(9) REP(9) scan_phase(a, F, kk); PH_END
                    PH_BEGIN EN(10) REP(10) {
                        ProbStd p = make_std(H, 512, (size_t)256 * 512, pg8::PLANE_B, ws + WS_TW + (size_t)kk * SSM_G * 256 * 1024, 1024, 0, (size_t)256 * 1024, 8);
                        p.A2 = (const char*)CC; p.ksplit = 4;
                        SchedS S{F.vcu}; EpiS3 E{Gm};
                        pg8::gemm_phase<ProbStd, EpiS3, SchedS, true, true>(F.lds, p, S, E);
                    } PH_END
                    PH_BEGIN EN(11) REP(11) {
                        const f16* Wt = (const f16*)(ws + WS_WGLU) + (size_t)kk * D * 2 * D;
                        ProbGrp p; { const ProbStd q = make_std(Gm, 32, (size_t)256 * 32, 0, Wt, D * 2, (size_t)256 * D * 2, 0, D / 64); p.A = q.A; p.A2 = q.A2; p.B = q.B; p.nt = q.nt; p.ksplit = q.ksplit; p.lda2 = q.lda2; p.a_t = q.a_t; p.a_z = 0; p.b_z = 0; }
                        p.a_k = 4u * pg8::PLANE_B; p.ldb2 = 128u; p.b_k = 32768u; p.b_t = (size_t)(D / 64) * 32768;
                        pg8::StaticOrder S; S.init(MTOK, 2 * D, F.G, F.bx);
                        EpiGLUResid E{(f16*)(ws + WS_XH), modl + (size_t)5 * D, 1.0f / REPCNT(11)};
                        pg8::gemm_phase<ProbGrp, EpiGLUResid, pg8::StaticOrder, G_ALIGN, G_SP2>(F.lds, p, S, E);
                    } PH_END
                }
            }
        }
    }
#if PROBE
    {
        GRID_BAR();
        if (blockIdx.x == 0) {
            if (threadIdx.x == 0) { const Args ap = kargs(); const unsigned long long v = __hip_atomic_load((unsigned long long*)(ap.ws + WS_CTL + 262144) + PROBE_SEL, __ATOMIC_RELAXED, __HIP_MEMORY_SCOPE_AGENT) / gridDim.x;
                const unsigned long long t0 = __builtin_amdgcn_s_memrealtime(); while (__builtin_amdgcn_s_memrealtime() - t0 < v) __builtin_amdgcn_s_sleep(8); }
            __syncthreads();
        }
    }
#endif
#undef PH_BEGIN
#undef PH_END
}

extern "C" void kernel_launch(void* const* d_in, const int* in_sizes, int n_in, void* d_out, int out_size, void* d_ws, size_t ws_size, hipStream_t stream) {
    static int grid = 0;
    if (grid == 0) {
        if (n_in != 19 || ws_size < WS_END) { fprintf(stderr, "kernel_launch: unexpected n_in %d or ws_size %zu (need %zu)\n", n_in, ws_size, (size_t)WS_END); grid = -1; return; }
        int dev = 0, cus = 0, per_cu = 0;
        if (hipGetDevice(&dev) != hipSuccess || hipDeviceGetAttribute(&cus, hipDeviceAttributeMultiprocessorCount, dev) != hipSuccess) { grid = -1; return; }
        if (hipFuncSetAttribute((const void*)fwd_kernel, hipFuncAttributeMaxDynamicSharedMemorySize, LDS_BYTES) != hipSuccess) { fprintf(stderr, "kernel_launch: hipFuncSetAttribute failed\n"); grid = -1; return; }
        if (hipOccupancyMaxActiveBlocksPerMultiprocessor(&per_cu, (const void*)fwd_kernel, NTHR, LDS_BYTES) != hipSuccess || per_cu < 1) fprintf(stderr, "kernel_launch: occupancy query reports %d\n", per_cu);
        (void)hipGetLastError();
        grid = cus < 256 ? cus : 256;
    }
    if (grid < 0) return;
    (void)hipMemsetAsync((char*)d_ws + WS_CTL, 0, CTL_ZERO_BYTES, stream);
    ArgsK a{};
    a.x_prompt = (const GAS float*)d_in[0]; a.x_sample = (const GAS float*)d_in[1]; a.state_ssm = (const GAS float*)d_in[2]; a.c = (const GAS float*)d_in[3]; a.c_ctx = (const GAS float*)d_in[4];
    a.w_ada = (const GAS float*)d_in[5]; a.b_ada = (const GAS float*)d_in[6]; a.norm_g = (const GAS float*)d_in[7]; a.ffn_w_in = (const GAS float*)d_in[8]; a.ffn_w_out = (const GAS float*)d_in[9];
    a.fourier_w_o = (const GAS float*)d_in[10]; a.ssm_a_re = (const GAS float*)d_in[11]; a.ssm_a_im = (const GAS float*)d_in[12]; a.ssm_log_dt = (const GAS float*)d_in[13];
    a.ssm_b = (const GAS float*)d_in[14]; a.ssm_c = (const GAS float*)d_in[15]; a.ssm_d = (const GAS float*)d_in[16]; a.ssm_w_glu = (const GAS float*)d_in[17]; a.final_g = (const GAS float*)d_in[18];
    a.out = (GAS float*)d_out; a.ws = (GAS unsigned char*)d_ws;
#if MK_PER_PHASE
    for (int i = 0; i < N_PHASES; ++i) { a.ph_lo = i; a.ph_hi = i + 1; hipLaunchKernelGGL(fwd_kernel, dim3(grid), dim3(NTHR), LDS_BYTES, stream, a); }
#else
    a.ph_lo = 0; a.ph_hi = N_PHASES;
    hipLaunchKernelGGL(fwd_kernel, dim3(grid), dim3(NTHR), LDS_BYTES, stream, a);
#endif
    const hipError_t le = hipPeekAtLastError();
    if (le != hipSuccess) fprintf(stderr, "kernel_launch: launch failed: %s\n", hipGetErrorName(le));
}
```
